# Optimizing an MI355X kernel written in HIP

```python
import jax
import jax.numpy as jnp
from jax import lax
import numpy as np


D_MODEL = 2048
BATCH = 4
SEQ = 8192
DEPTH = 4

GRID_W = 64
CTX_LEN = 256
D_FF = 4 * D_MODEL
ROPE_BASE = 10000.0
NORM_EPS = 1e-6
Q_BLOCK = 128

MLA_HEADS = 4
MLA_Q_RANK = 512
MLA_KV_RANK = 256
MLA_NOPE = 128
MLA_ROPE = 64
MLA_V = 128

SWA_HEADS = 16
SWA_KV_HEADS = 2
SWA_HEAD_DIM = 64
WINDOW = 128
SWA_BLOCK = 128

MLSTM_HEADS = 4
MLSTM_QK = 64
MLSTM_V = 128
MLSTM_CHUNK = 64

D_MIX = MLA_HEADS * MLA_V + SWA_HEADS * SWA_HEAD_DIM + MLSTM_HEADS * MLSTM_V
IN_WIDTHS = (MLA_Q_RANK, MLA_KV_RANK, MLA_ROPE,
             SWA_HEADS * SWA_HEAD_DIM, SWA_KV_HEADS * SWA_HEAD_DIM, SWA_KV_HEADS * SWA_HEAD_DIM,
             MLSTM_HEADS * MLSTM_QK, MLSTM_HEADS * MLSTM_QK, MLSTM_HEADS * MLSTM_V,
             4 * MLSTM_HEADS, MLSTM_HEADS * MLSTM_V)
D_IN = sum(IN_WIDTHS)

kernel_name = 'hybrid_mla_swa_mlstm_dit_trunk'

F32 = jnp.float32


def rmsnorm(x, g):
    xf = x.astype(F32)
    y = xf * lax.rsqrt(jnp.mean(xf * xf, axis=-1, keepdims=True) + NORM_EPS)
    return y.astype(x.dtype) * g


def modulate_norm(x, g, shift, scale):
    return rmsnorm(x, g) * (1 + scale) + shift


def split_in(z):
    offs = [int(o) for o in np.cumsum(IN_WIDTHS)[:-1]]
    return jnp.split(z, offs, axis=-1)


def rope_tables(row, col, dim):
    half = dim // 2
    inv = ROPE_BASE ** (-jnp.arange(0, half, 2, dtype=F32) / half)
    ar = row[:, None].astype(F32) * inv
    ac = col[:, None].astype(F32) * inv
    ang = jnp.concatenate([ar, ar, ac, ac], axis=-1)
    return jnp.cos(ang), jnp.sin(ang)


def apply_rope(x, cos, sin):
    x1, x2, x3, x4 = jnp.split(x, 4, axis=-1)
    rot = jnp.concatenate([-x2, x1, -x4, x3], axis=-1)
    return x * cos[:, None].astype(x.dtype) + rot * sin[:, None].astype(x.dtype)


def softmax_with_sink(logits, sink):
    sink = jnp.broadcast_to(sink, logits.shape[:-1] + (1,))
    return jax.nn.softmax(jnp.concatenate([sink, logits], axis=-1), axis=-1)[..., 1:]


def mla_qkv(zq, zkv, zr, g_q, w_uq, g_kv, w_ukv, rope):
    B, T, _ = zq.shape
    q = (rmsnorm(zq, g_q) @ w_uq).reshape(B, T, MLA_HEADS, MLA_NOPE + MLA_ROPE)
    q_nope, q_rope = q[..., :MLA_NOPE], q[..., MLA_NOPE:]
    kv = (rmsnorm(zkv, g_kv) @ w_ukv).reshape(B, T, MLA_HEADS, MLA_NOPE + MLA_V)
    k_nope, v = kv[..., :MLA_NOPE], kv[..., MLA_NOPE:]
    k_rope = zr[:, :, None, :]
    if rope is not None:
        cos, sin = rope
        q_rope = apply_rope(q_rope, cos, sin)
        k_rope = apply_rope(k_rope, cos, sin)
    return q_nope, q_rope, k_nope, k_rope, v


def mla_attend(q_nope, q_rope, k_nope, k_rope, v):
    B, T, H, _ = q_nope.shape
    nb = T // Q_BLOCK
    scale = (MLA_NOPE + MLA_ROPE) ** -0.5
    kr = k_rope[:, :, 0]

    def blk(args):
        qn, qr = args
        s = jnp.einsum('bqhd,bkhd->bhqk', qn, k_nope) + jnp.einsum('bqhd,bkd->bhqk', qr, kr)
        p = jax.nn.softmax(s.astype(F32) * scale, axis=-1).astype(v.dtype)
        return jnp.einsum('bhqk,bkhd->bqhd', p, v)

    qn_b = q_nope.reshape(B, nb, Q_BLOCK, H, MLA_NOPE).swapaxes(0, 1)
    qr_b = q_rope.reshape(B, nb, Q_BLOCK, H, MLA_ROPE).swapaxes(0, 1)
    out = lax.map(blk, (qn_b, qr_b))
    return out.swapaxes(0, 1).reshape(B, T, H * MLA_V)


def gqa_sink_dense(q, k, v, sink):
    B, T, Hq, d = q.shape
    G = k.shape[2]
    R = Hq // G
    qg = q.reshape(B, T, G, R, d)
    s = jnp.einsum('bqgrd,bkgd->bgrqk', qg, k).astype(F32) * (d ** -0.5)
    p = softmax_with_sink(s, sink.reshape(G, R)[None, :, :, None, None].astype(F32)).astype(v.dtype)
    return jnp.einsum('bgrqk,bkgd->bqgrd', p, v).reshape(B, T, Hq * d)


def swa_latent(q, k, v, kc, vc, sink):
    B, S, Hq, d = q.shape
    G = SWA_KV_HEADS
    R = Hq // G
    Lc = kc.shape[1]
    nb = S // SWA_BLOCK
    span = SWA_BLOCK + 2 * WINDOW
    pad = ((0, 0), (WINDOW, WINDOW), (0, 0), (0, 0))
    kp = jnp.pad(k, pad)
    vp = jnp.pad(v, pad)
    qb = q.reshape(B, nb, SWA_BLOCK, G, R, d).swapaxes(0, 1)
    qi = jnp.arange(SWA_BLOCK)[:, None]
    ki = jnp.arange(span)[None, :]
    rel = ki - WINDOW - qi
    scale = d ** -0.5
    sink_b = sink.reshape(G, R)[None, :, :, None, None].astype(F32)

    def blk(args):
        j, qj = args
        kj = lax.dynamic_slice_in_dim(kp, j * SWA_BLOCK, span, axis=1)
        vj = lax.dynamic_slice_in_dim(vp, j * SWA_BLOCK, span, axis=1)
        u = j * SWA_BLOCK - WINDOW + ki
        valid = (jnp.abs(rel) <= WINDOW) & (u >= 0) & (u < S)
        s_loc = jnp.einsum('bqgrd,bkgd->bgrqk', qj, kj).astype(F32) * scale
        s_loc = jnp.where(valid, s_loc, -jnp.inf)
        s_ctx = jnp.einsum('bqgrd,bkgd->bgrqk', qj, kc).astype(F32) * scale
        p = softmax_with_sink(jnp.concatenate([s_ctx, s_loc], axis=-1), sink_b).astype(v.dtype)
        return (jnp.einsum('bgrqk,bkgd->bqgrd', p[..., :Lc], vc)
                + jnp.einsum('bgrqk,bkgd->bqgrd', p[..., Lc:], vj))

    out = lax.map(blk, (jnp.arange(nb), qb))
    return out.swapaxes(0, 1).reshape(B, S, Hq * d)


def mlstm_heads(zq, zk, zv, zg, gate_bias):
    B, T, _ = zq.shape
    q = zq.reshape(B, T, MLSTM_HEADS, MLSTM_QK).transpose(0, 2, 1, 3).astype(F32) * (MLSTM_QK ** -0.5)
    k = zk.reshape(B, T, MLSTM_HEADS, MLSTM_QK).transpose(0, 2, 1, 3).astype(F32)
    v = zv.reshape(B, T, MLSTM_HEADS, MLSTM_V).transpose(0, 2, 1, 3).astype(F32)
    g = (zg.reshape(B, T, 4, MLSTM_HEADS).astype(F32) + gate_bias.astype(F32)).transpose(2, 0, 3, 1)
    return q, k, v, g


def mlstm_zero_state(B):
    return (jnp.zeros((B, MLSTM_HEADS, MLSTM_QK, MLSTM_V), F32),
            jnp.zeros((B, MLSTM_HEADS, MLSTM_QK), F32),
            jnp.zeros((B, MLSTM_HEADS), F32))


def mlstm_chunkwise(q, k, v, i_pre, f_pre, state):
    B, H, T, dk = q.shape
    dv = v.shape[-1]
    L = MLSTM_CHUNK
    N = T // L
    qc = q.reshape(B, H, N, L, dk)
    kc = k.reshape(B, H, N, L, dk)
    vc = v.reshape(B, H, N, L, dv)
    ig = i_pre.reshape(B, H, N, L)
    b = jnp.cumsum(jax.nn.log_sigmoid(f_pre).reshape(B, H, N, L), axis=-1)
    g = b[..., -1]
    a = g[..., None] - b + ig
    a_max = jnp.max(a, axis=-1)
    w = jnp.exp(a - a_max[..., None])
    dC = jnp.einsum('bhnl,bhnld,bhnle->bhnde', w, kc, vc)
    dn = jnp.einsum('bhnl,bhnld->bhnd', w, kc)

    def step(carry, inp):
        C, n, m = carry
        g_c, am_c, dC_c, dn_c = inp
        m_new = jnp.maximum(g_c + m, am_c)
        decay = jnp.exp(g_c + m - m_new)
        grow = jnp.exp(am_c - m_new)
        C_new = decay[..., None, None] * C + grow[..., None, None] * dC_c
        n_new = decay[..., None] * n + grow[..., None] * dn_c
        return (C_new, n_new, m_new), (C, n, m)

    to_t = lambda t: jnp.moveaxis(t, 2, 0)
    final, (C_in, n_in, m_in) = lax.scan(step, state, (to_t(g), to_t(a_max), to_t(dC), to_t(dn)))
    C_in = jnp.moveaxis(C_in, 0, 2)
    n_in = jnp.moveaxis(n_in, 0, 2)
    m_in = jnp.moveaxis(m_in, 0, 2)
    causal = jnp.tril(jnp.ones((L, L), dtype=bool))
    d_log = jnp.where(causal, b[..., :, None] - b[..., None, :] + ig[..., None, :], -jnp.inf)
    inter_log = b + m_in[..., None]
    m_t = jnp.maximum(inter_log, jnp.max(d_log, axis=-1))
    s = jnp.einsum('bhnld,bhnsd->bhnls', qc, kc) * jnp.exp(d_log - m_t[..., None])
    inter_w = jnp.exp(inter_log - m_t)
    num = (jnp.einsum('bhnls,bhnse->bhnle', s, vc)
           + inter_w[..., None] * jnp.einsum('bhnld,bhnde->bhnle', qc, C_in))
    den = jnp.sum(s, axis=-1) + inter_w * jnp.einsum('bhnld,bhnd->bhnl', qc, n_in)
    h = num / jnp.maximum(jnp.abs(den), jnp.exp(-m_t))[..., None]
    return h.reshape(B, H, T, dv), final


def mlstm_bidir(q, k, v, g, init_f, init_b):
    h_f, st_f = mlstm_chunkwise(q, k, v, g[0], g[1], init_f)
    fl = lambda t: jnp.flip(t, axis=2)
    h_b, st_b = mlstm_chunkwise(fl(q), fl(k), fl(v), jnp.flip(g[2], axis=-1), jnp.flip(g[3], axis=-1), init_b)
    return h_f + fl(h_b), st_f, st_b


def mlstm_out(hm, zo, g_h, dtype):
    B, H, T, dv = hm.shape
    hn = rmsnorm(hm.transpose(0, 2, 1, 3), g_h.astype(F32))
    return (hn.reshape(B, T, H * dv) * jax.nn.sigmoid(zo.astype(F32))).astype(dtype)


def token_mixers(h, hc, w_in, mla_g_q, mla_w_uq, mla_g_kv, mla_w_ukv, swa_sink,
                 mlstm_gate_bias, mlstm_g_h, rope_mla, rope_swa, need_ctx):
    B = h.shape[0]
    z = split_in(h @ w_in)
    zc = split_in(hc @ w_in)

    qn, qr, kn, kr, vv = mla_qkv(z[0], z[1], z[2], mla_g_q, mla_w_uq, mla_g_kv, mla_w_ukv, rope_mla)
    qnc, qrc, knc, krc, vvc = mla_qkv(zc[0], zc[1], zc[2], mla_g_q, mla_w_uq, mla_g_kv, mla_w_ukv, None)
    y_mla = mla_attend(qn, qr, jnp.concatenate([knc, kn], axis=1),
                       jnp.concatenate([krc, kr], axis=1), jnp.concatenate([vvc, vv], axis=1))

    heads = lambda t, n: t.reshape(t.shape[0], t.shape[1], n, SWA_HEAD_DIM)
    cos_s, sin_s = rope_swa
    qs = apply_rope(heads(z[3], SWA_HEADS), cos_s, sin_s)
    ks = apply_rope(heads(z[4], SWA_KV_HEADS), cos_s, sin_s)
    vs = heads(z[5], SWA_KV_HEADS)
    qsc, ksc, vsc = heads(zc[3], SWA_HEADS), heads(zc[4], SWA_KV_HEADS), heads(zc[5], SWA_KV_HEADS)
    y_swa = swa_latent(qs, ks, vs, ksc, vsc, swa_sink)

    qm, km, vm, gm = mlstm_heads(z[6], z[7], z[8], z[9], mlstm_gate_bias)
    qmc, kmc, vmc, gmc = mlstm_heads(zc[6], zc[7], zc[8], zc[9], mlstm_gate_bias)
    zero = mlstm_zero_state(B)
    hmc, st_f, st_b = mlstm_bidir(qmc, kmc, vmc, gmc, zero, zero)
    hm, _, _ = mlstm_bidir(qm, km, vm, gm, st_f, st_b)
    y_mlstm = mlstm_out(hm, z[10], mlstm_g_h, h.dtype)

    y = jnp.concatenate([y_mla, y_swa, y_mlstm], axis=-1)
    if need_ctx:
        yc = jnp.concatenate([mla_attend(qnc, qrc, knc, krc, vvc),
                              gqa_sink_dense(qsc, ksc, vsc, swa_sink),
                              mlstm_out(hmc, zc[10], mlstm_g_h, hc.dtype)], axis=-1)
    else:
        yc = None
    return y, yc


def squared_relu_mlp(h, w1, w2):
    return jnp.square(jax.nn.relu(h @ w1)) @ w2


def setup_inputs(seed: int = 0) -> dict:
    key = jax.random.key(seed)
    ks = jax.random.split(key, 24)
    nrm = lambda k, shape, s: jax.random.normal(k, shape, F32) * s
    L, D = DEPTH, D_MODEL
    f_sel = jnp.array([0.0, 1.0, 0.0, 1.0], F32)[None, :, None]
    gate_bias = nrm(ks[14], (L, 4, MLSTM_HEADS), 0.1) + f_sel * jax.random.uniform(
        ks[15], (L, 4, MLSTM_HEADS), F32, minval=3.0, maxval=6.0)
    return {
        'x': nrm(ks[0], (BATCH, SEQ, D), 1.0),
        'c': nrm(ks[1], (BATCH, D), 1.0),
        'ctx': nrm(ks[2], (BATCH, CTX_LEN, D), 1.0),
        'c_ctx': nrm(ks[3], (D,), 1.0),
        'w_mod': nrm(ks[4], (L, D, 6 * D), 0.5 * D ** -0.5),
        'b_mod': nrm(ks[5], (L, 6 * D), 0.01),
        'g_norm1': 1.0 + nrm(ks[6], (L, D), 0.02),
        'g_norm2': 1.0 + nrm(ks[7], (L, D), 0.02),
        'w_in': nrm(ks[8], (L, D, D_IN), D ** -0.5),
        'mla_g_q': 1.0 + nrm(ks[9], (L, MLA_Q_RANK), 0.02),
        'mla_w_uq': nrm(ks[10], (L, MLA_Q_RANK, MLA_HEADS * (MLA_NOPE + MLA_ROPE)), MLA_Q_RANK ** -0.5),
        'mla_g_kv': 1.0 + nrm(ks[11], (L, MLA_KV_RANK), 0.02),
        'mla_w_ukv': nrm(ks[12], (L, MLA_KV_RANK, MLA_HEADS * (MLA_NOPE + MLA_V)), MLA_KV_RANK ** -0.5),
        'swa_sink': nrm(ks[13], (L, SWA_HEADS), 0.5),
        'mlstm_gate_bias': gate_bias,
        'mlstm_g_h': 1.0 + nrm(ks[16], (L, MLSTM_HEADS, MLSTM_V), 0.02),
        'w_out': nrm(ks[17], (L, D_MIX, D), D_MIX ** -0.5),
        'w_ff1': nrm(ks[18], (L, D, D_FF), D ** -0.5),
        'w_ff2': nrm(ks[19], (L, D_FF, D), D_FF ** -0.5),
        'g_final': 1.0 + nrm(ks[20], (D,), 0.02),
    }


def reference(x, c, ctx, c_ctx, w_mod, b_mod, g_norm1, g_norm2, w_in, mla_g_q, mla_w_uq,
              mla_g_kv, mla_w_ukv, swa_sink, mlstm_gate_bias, mlstm_g_h, w_out, w_ff1, w_ff2, g_final):
    B, S, D = x.shape
    rows = S // GRID_W
    row = jnp.repeat(jnp.arange(rows), GRID_W)
    col = jnp.tile(jnp.arange(GRID_W), rows)
    rope_mla = rope_tables(row, col, MLA_ROPE)
    rope_swa = rope_tables(row, col, SWA_HEAD_DIM)
    silu_c = jax.nn.silu(c)
    silu_cc = jax.nn.silu(c_ctx)
    xc = ctx
    for l in range(DEPTH):
        need_ctx = l < DEPTH - 1
        mod = silu_c @ w_mod[l] + b_mod[l]
        modc = silu_cc @ w_mod[l] + b_mod[l]
        sh1, sc1, gt1, sh2, sc2, gt2 = [m[:, None, :] for m in jnp.split(mod, 6, axis=-1)]
        sh1c, sc1c, gt1c, sh2c, sc2c, gt2c = jnp.split(modc, 6, axis=-1)
        h = modulate_norm(x, g_norm1[l], sh1, sc1)
        hc = modulate_norm(xc, g_norm1[l], sh1c, sc1c)
        y, yc = token_mixers(h, hc, w_in[l], mla_g_q[l], mla_w_uq[l], mla_g_kv[l], mla_w_ukv[l],
                             swa_sink[l], mlstm_gate_bias[l], mlstm_g_h[l], rope_mla, rope_swa, need_ctx)
        x = x + gt1 * (y @ w_out[l])
        x = x + gt2 * squared_relu_mlp(modulate_norm(x, g_norm2[l], sh2, sc2), w_ff1[l], w_ff2[l])
        if need_ctx:
            xc = xc + gt1c * (yc @ w_out[l])
            xc = xc + gt2c * squared_relu_mlp(modulate_norm(xc, g_norm2[l], sh2c, sc2c), w_ff1[l], w_ff2[l])
    return rmsnorm(x, g_final)
```

```cpp
#include <hip/hip_runtime.h>
#include <cstdio>
#include <cstdint>
#include <cmath>


namespace pg8 {
#define PG8_LAS __attribute__((address_space(3)))
typedef unsigned short bf16_t;
typedef short bf16x8 __attribute__((ext_vector_type(8)));
typedef float f32x4 __attribute__((ext_vector_type(4)));
typedef unsigned u32x4 __attribute__((ext_vector_type(4)));
constexpr int BM = 256, BK = 64, HALF = 128, HTB = HALF * BK * 2  , STAGE_BYTES = 8 * HTB, NXCD = 8, WGM = 8;

__host__ __device__ __forceinline__ int lds_byte(int r, int c) { const int st = (r >> 4) * 2 + (c >> 5), rr = r & 15, cc = c & 31, ob = rr * 64 + cc * 2; return st * 1024 + (ob ^ (((ob >> 9) & 1) << 5)); }
__host__ __device__ __forceinline__ void stage_rc(int b, int& R, int& C) { const int st = b / 1024, sb = b % 1024, swz = sb ^ (((sb >> 9) & 1) << 5); R = (st >> 1) * 16 + swz / 64; C = (st & 1) * 32 + (swz % 64) / 2; }
__host__ __device__ __forceinline__ int perm32(int rho) { const int n = rho >> 4, i = rho & 15; return 8 * (i >> 2) + 4 * n + (i & 3); }

struct Unit { int pm, pn, k0, nt; };
struct Gemm { const bf16_t* A; const bf16_t* Bt; int M, N, K; };

struct StaticOrder {
    int nM, nN, nwg, G, c, fullnt;
    __host__ __device__ void init(int M, int N, int K, int G_, int c_) { nM = M / BM; nN = N / BM; nwg = nM * nN; G = G_; c = c_; fullnt = K / BK; }
    __host__ __device__ bool next(int i, Unit& u) const {
        const long L = (long)i * G + c; if (L >= nwg) return false;
        int wgid = (int)L; { const int q = nwg / NXCD, r = nwg % NXCD, xcd = wgid % NXCD, off = wgid / NXCD; wgid = (xcd < r ? xcd * (q + 1) : r * (q + 1) + (xcd - r) * q) + off; }
        const int nig = WGM * nN, gid = wgid / nig, fm = gid * WGM, gsz = (nM - fm) < WGM ? (nM - fm) : WGM;
        u.pm = fm + ((wgid % nig) % gsz); u.pn = (wgid % nig) / gsz; u.k0 = 0; u.nt = fullnt; return true;
    }
    __device__ __forceinline__ void a_ready(const Unit&) const {}
    __device__ __forceinline__ void done(const Unit&) const {}
};

struct LatentOrder {
    StaticOrder so; int nN, mode;
    __host__ __device__ void init(int N, int K, int G_, int c_, int mode_) { so.init(128 * BM, N, K, G_, c_); nN = N / BM; mode = mode_; }
    __host__ __device__ bool next(int i, Unit& u) const {
        if (so.next(i, u)) { u.pm = u.pm + u.pm / 32 + 1; return true; }
        const long L = (long)i * so.G + so.c - so.nwg;
        if (mode == 1) { if (L >= 4 * nN) return false; u.pm = 33 * (int)(L / nN); u.pn = (int)(L % nN); u.k0 = 0; u.nt = so.fullnt; return true; }
        if (mode == 2) { if (L >= 32 * nN) return false; const int tile = (int)(L >> 3), ks = (int)(L & 7); u.pm = 33 * (tile / nN); u.pn = tile % nN; u.nt = so.fullnt >> 3; u.k0 = ks * u.nt; return true; }
        return false;
    }
    __device__ __forceinline__ void a_ready(const Unit&) const {}
    __device__ __forceinline__ void done(const Unit&) const {}
};

__device__ __forceinline__ unsigned cvt_pk_bf16(float lo, float hi) { unsigned r; asm volatile("v_cvt_pk_bf16_f32 %0, %1, %2" : "=v"(r) : "v"(lo), "v"(hi)); return r; }
typedef float f32x2 __attribute__((ext_vector_type(2)));

typedef float f32x2v __attribute__((ext_vector_type(2))); typedef __bf16 bf16x2v __attribute__((ext_vector_type(2)));
__device__ __forceinline__ unsigned pkbf(float lo, float hi) { f32x2v v = {lo, hi}; bf16x2v b = __builtin_convertvector(v, bf16x2v); return __builtin_bit_cast(unsigned, b); }

template <int ACT, bool GATES, bool NORMED> struct EpiBf16 {
    static constexpr bool PERM = true, AFTER_DRAIN = false;
    bf16_t* O; int ldc; float* gates; const unsigned long long* rowss; const long long* bias; int ldb;
    __device__ __forceinline__ void operator()(const f32x4 (&acc)[2][2][4][2], const Unit& u, int wr, int wc, int fr, int fq) const {
        const int row0 = u.pm * BM + wr * 64 + fr; const int col0 = u.pn * BM + wc * 32 + 8 * fq;
        f32x4 bv[2][2];
        if (NORMED) { const int bb = u.pm / 33, bp = (u.pm - bb * 33 == 0) ? 4 : bb; const long long* bptr = bias + (size_t)bp * ldb + col0;
#pragma unroll
            for (int bj = 0; bj < 2; ++bj)
#pragma unroll
                for (int n = 0; n < 2; ++n)
#pragma unroll
                    for (int e = 0; e < 4; ++e) bv[bj][n][e] = (float)bptr[bj * HALF + 4 * n + e] * 2.3283064365386963e-10f; }
#pragma unroll
        for (int ai = 0; ai < 2; ++ai)
#pragma unroll
            for (int m = 0; m < 4; ++m) { const int row = row0 + ai * HALF + m * 16; bf16_t* rowp = O + (size_t)row * ldc + col0;
                float rstd = 1.f; if (NORMED) rstd = __builtin_amdgcn_rsqf((float)rowss[row] * (1.f / 2048.f / 16777216.f) + 1e-6f);
#pragma unroll
                for (int bj = 0; bj < 2; ++bj) { f32x4 v0 = acc[ai][bj][m][0], v1 = acc[ai][bj][m][1];
                    if (NORMED) { v0 = v0 * rstd + bv[bj][0]; v1 = v1 * rstd + bv[bj][1]; }
                    if (GATES) { if (bj == 0 && u.pn == 12 && wc == 2 && fq < 2) { float* gp = gates + (size_t)row * 16 + 8 * fq; *(f32x4*)gp = v0; *(f32x4*)(gp + 4) = v1; } }
                    if (ACT == 2) {
#pragma unroll
                        for (int e = 0; e < 4; ++e) { float a = v0[e] > 0.f ? v0[e] : 0.f; v0[e] = a * a; float b = v1[e] > 0.f ? v1[e] : 0.f; v1[e] = b * b; } }
                    u32x4 w; w.x = pkbf(v0[0], v0[1]); w.y = pkbf(v0[2], v0[3]); w.z = pkbf(v1[0], v1[1]); w.w = pkbf(v1[2], v1[3]);
                    *(u32x4*)(rowp + bj * HALF) = w; } }
    }
};
struct EpiResid {
    static constexpr bool PERM = false, AFTER_DRAIN = false;
    bf16_t* X; const float* modl; int goff; float* slab; int fullnt;
    bf16_t* hx; const float* ng; const float* nsc; unsigned long long* rowss;
    __device__ __forceinline__ void operator()(const f32x4 (&acc)[2][2][4][2], const Unit& u, int wr, int wc, int fr, int fq) const {
        const int bb = u.pm / 33, bp = (u.pm - bb * 33 == 0) ? 4 : bb;
        const int col0 = u.pn * BM + wc * 32 + 4 * fq;
        if (u.nt != fullnt) {
            float* sp0 = slab + ((size_t)(u.k0 / u.nt) * 1024 + bb * 256 + wr * 64 + fr) * 2048 + col0;
#pragma unroll
            for (int ai = 0; ai < 2; ++ai)
#pragma unroll
                for (int m = 0; m < 4; ++m) { float* sp = sp0 + (size_t)(ai * HALF + m * 16) * 2048;
#pragma unroll
                    for (int bj = 0; bj < 2; ++bj)
#pragma unroll
                        for (int n = 0; n < 2; ++n) *(f32x4*)(sp + bj * HALF + n * 16) = acc[ai][bj][m][n]; }
            return;
        }
        const float* gate = modl + (size_t)bp * 12288 + goff;
        f32x4 gv[2][2], gm[2][2];
#pragma unroll
        for (int bj = 0; bj < 2; ++bj)
#pragma unroll
            for (int n = 0; n < 2; ++n) { gv[bj][n] = *(const f32x4*)(gate + col0 + bj * HALF + n * 16);
                if (hx) { const f32x4 g4 = *(const f32x4*)(ng + col0 + bj * HALF + n * 16), s4 = *(const f32x4*)(nsc + (size_t)bp * 12288 + col0 + bj * HALF + n * 16); gm[bj][n] = g4 * (s4 + 1.f); } }
        const int hc = u.pn * BM + wc * 32 + ((fq & 1) ? 16 + 4 * (fq - 1) : 4 * fq);
        u32x4 xr[4][2]; float tots[4];
#define ER_LOAD(g) do { const bf16_t* xp_ = X + (size_t)(u.pm * BM + ((g) >> 2) * HALF + wr * 64 + ((g) & 3) * 16 + fr) * 2048 + hc; \
        _Pragma("unroll") for (int bj = 0; bj < 2; ++bj) xr[(g) & 3][bj] = *(const u32x4*)(xp_ + bj * HALF); } while (0)
        ER_LOAD(0); ER_LOAD(1); ER_LOAD(2); ER_LOAD(3);
        asm volatile("" ::: "memory");
#pragma unroll
        for (int g = 0; g < 8; ++g) { const int ai = g >> 2, m = g & 3; const int row = u.pm * BM + ai * HALF + wr * 64 + m * 16 + fr; float ss = 0.f;
#pragma unroll
            for (int bj = 0; bj < 2; ++bj) { const u32x4 raw = xr[g & 3][bj];
                const auto lx = __builtin_amdgcn_permlane16_swap(raw[0], raw[2], false, false); const auto ly = __builtin_amdgcn_permlane16_swap(raw[1], raw[3], false, false);
                unsigned xw[2][2], hw[2][2];
#pragma unroll
                for (int n = 0; n < 2; ++n) { const unsigned wx = lx[n], wy = ly[n];
                    f32x4 xv = {__uint_as_float(wx << 16), __uint_as_float(wx & 0xffff0000u), __uint_as_float(wy << 16), __uint_as_float(wy & 0xffff0000u)};
                    xv = xv + gv[bj][n] * acc[ai][bj][m][n]; xw[n][0] = pkbf(xv[0], xv[1]); xw[n][1] = pkbf(xv[2], xv[3]);
                    if (hx) { ss += (xv[0] * xv[0] + xv[1] * xv[1]) + (xv[2] * xv[2] + xv[3] * xv[3]); const f32x4 hv = xv * gm[bj][n]; hw[n][0] = pkbf(hv[0], hv[1]); hw[n][1] = pkbf(hv[2], hv[3]); } }
                { const auto sx = __builtin_amdgcn_permlane16_swap(xw[0][0], xw[1][0], false, false); const auto sy = __builtin_amdgcn_permlane16_swap(xw[0][1], xw[1][1], false, false);
                  *(u32x4*)(X + (size_t)row * 2048 + bj * HALF + hc) = (u32x4){sx[0], sy[0], sx[1], sy[1]}; }
                if (hx) { const auto rx = __builtin_amdgcn_permlane16_swap(hw[0][0], hw[1][0], false, false); const auto ry = __builtin_amdgcn_permlane16_swap(hw[0][1], hw[1][1], false, false);
                    *(u32x4*)(hx + (size_t)row * 2048 + bj * HALF + hc) = (u32x4){rx[0], ry[0], rx[1], ry[1]}; } }
            if (hx) {
                const auto r1 = __builtin_amdgcn_permlane16_swap(__float_as_uint(ss), __float_as_uint(ss), false, false); ss = __uint_as_float(r1[0]) + __uint_as_float(r1[1]);
                const auto r2 = __builtin_amdgcn_permlane32_swap(__float_as_uint(ss), __float_as_uint(ss), false, false); tots[m] = __uint_as_float(r2[0]) + __uint_as_float(r2[1]);
                if (m == 3) { const float mine = fq == 0 ? tots[0] : fq == 1 ? tots[1] : fq == 2 ? tots[2] : tots[3];
                    atomicAdd(rowss + (u.pm * BM + ai * HALF + wr * 64 + fq * 16 + fr), (unsigned long long)(mine * 16777216.f)); } }
            asm volatile("" ::: "memory");
            if (g + 4 < 8) { ER_LOAD(g + 4); asm volatile("" ::: "memory"); } }
#undef ER_LOAD
    }
};

template <class Epi, class Sched, bool ALIGN_EPI = false, bool SP2 = false>
__device__ __forceinline__ void gemm_phase(PG8_LAS unsigned char* lds, const Gemm g, const Sched& S, const Epi& E) {
    int tid_l = threadIdx.x; asm volatile("" : "+v"(tid_l));
    const int tid = tid_l, wid = __builtin_amdgcn_readfirstlane(tid >> 6), lane = tid & 63, wr = wid >> 2, wc = wid & 3, fr = lane & 15, fq = lane >> 4;
    const int K = g.K;
    unsigned voffA[2], voffB[2];
#pragma unroll
    for (int i = 0; i < 2; ++i) { int R, C; stage_rc(tid * 16 + i * 8192, R, C); const int Rb = Epi::PERM ? ((R & ~31) + perm32(R & 31)) : R;
        voffA[i] = (unsigned)(R * K + C) * 2u; voffB[i] = (unsigned)(Rb * K + C) * 2u; }
    const size_t kstep = (size_t)(BK * 2);
    const size_t hstep = (size_t)HALF * K * 2;
    const size_t tstep = 2 * hstep;
    const unsigned ldsw = (unsigned)wid * 1024u;
    const int aoff = lds_byte(wr * 64 + fr, fq * 8), boff = lds_byte(wc * 32 + fr, fq * 8);
#define PG8_SA(b, h) (((b) * 2 + (h)) * HTB)
#define PG8_SB(b, h) ((4 + (b) * 2 + (h)) * HTB)
#define PG8_STAGE(bufoff, gbase, voff) do { _Pragma("unroll") for (int _i = 0; _i < 2; ++_i) \
        __builtin_amdgcn_global_load_lds((const unsigned*)((const char*)(gbase) + (voff)[_i]), (PG8_LAS unsigned*)(lds + (bufoff) + ldsw + _i * 8192), 16, 0, 0); } while (0)
#define PG8_LDA(dst, b, h) do { _Pragma("unroll") for (int m = 0; m < 4; ++m) _Pragma("unroll") for (int k = 0; k < 2; ++k) dst[m][k] = *(const PG8_LAS bf16x8*)(lds + PG8_SA(b, h) + aoff + m * 2048 + k * 1024); } while (0)
#define PG8_LDB(dst, b, h) do { _Pragma("unroll") for (int n = 0; n < 2; ++n) _Pragma("unroll") for (int k = 0; k < 2; ++k) dst[n][k] = *(const PG8_LAS bf16x8*)(lds + PG8_SB(b, h) + boff + n * 2048 + k * 1024); } while (0)
#define PG8_MMA(ai, bj, At, Bt) do { __builtin_amdgcn_s_setprio(1); _Pragma("unroll") for (int m = 0; m < 4; ++m) _Pragma("unroll") for (int n = 0; n < 2; ++n) _Pragma("unroll") for (int k = 0; k < 2; ++k) \
        acc[ai][bj][m][n] = __builtin_amdgcn_mfma_f32_16x16x32_bf16(Bt[n][k], At[m][k], acc[ai][bj][m][n], 0, 0, 0); __builtin_amdgcn_s_setprio(0); } while (0)
#define PG8_WAIT_V(n) asm volatile("s_waitcnt vmcnt(" #n ")" ::: "memory")
#define PG8_WAIT_L(n) asm volatile("s_waitcnt lgkmcnt(" #n ")" ::: "memory")
#define PG8_BAR __builtin_amdgcn_s_barrier()
#define PG8_SCHED __builtin_amdgcn_sched_barrier(0)
    Unit cur, nxt; int ui = 0;
    if (!S.next(0, cur)) return;
    f32x4 acc[2][2][4][2];
#pragma unroll
    for (int a = 0; a < 2; ++a)
#pragma unroll
        for (int b = 0; b < 2; ++b)
#pragma unroll
            for (int m = 0; m < 4; ++m)
#pragma unroll
                for (int n = 0; n < 2; ++n) acc[a][b][m][n] = (f32x4){0.f, 0.f, 0.f, 0.f};
    bf16x8 At[4][2], B0[2][2], B1[2][2];
    int nt = cur.nt;
    const char* cA = (const char*)g.A + (size_t)cur.pm * tstep + (size_t)cur.k0 * kstep; const char* cB = (const char*)g.Bt + (size_t)cur.pn * tstep + (size_t)cur.k0 * kstep;
    S.a_ready(cur);
    if constexpr (SP2) {
        PG8_STAGE(PG8_SB(0, 0), cB, voffB); PG8_STAGE(PG8_SB(0, 1), cB + hstep, voffB); PG8_STAGE(PG8_SA(0, 0), cA, voffA); PG8_STAGE(PG8_SA(0, 1), cA + hstep, voffA);
        if (wr == 1) PG8_BAR;
        PG8_WAIT_V(2); PG8_BAR;
        PG8_STAGE(PG8_SB(1, 0), cB + kstep, voffB); PG8_STAGE(PG8_SA(1, 0), cA + kstep, voffA); PG8_STAGE(PG8_SB(1, 1), cB + hstep + kstep, voffB);
        PG8_WAIT_V(6); PG8_BAR;
    } else {
        PG8_STAGE(PG8_SB(0, 0), cB, voffB); PG8_STAGE(PG8_SA(0, 0), cA, voffA); PG8_STAGE(PG8_SB(0, 1), cB + hstep, voffB); PG8_STAGE(PG8_SA(0, 1), cA + hstep, voffA);
        if (wr == 1) PG8_BAR;
        PG8_WAIT_V(4); PG8_BAR;
        PG8_STAGE(PG8_SB(1, 0), cB + kstep, voffB); PG8_STAGE(PG8_SA(1, 0), cA + kstep, voffA); PG8_STAGE(PG8_SB(1, 1), cB + hstep + kstep, voffB);
        PG8_WAIT_V(6); PG8_BAR;
    }
    for (;;) {
        const bool has_next = S.next(ui + 1, nxt);
        const char* nA = has_next ? (const char*)g.A + (size_t)nxt.pm * tstep + (size_t)nxt.k0 * kstep : cA; const char* nB = has_next ? (const char*)g.Bt + (size_t)nxt.pn * tstep + (size_t)nxt.k0 * kstep : cB;
        for (int t = 0; t < nt; t += 2) {
            const bool last = (t == nt - 2);
            const char* a1 = cA + (size_t)(t + 1) * kstep;
            const char* a2 = last ? nA : cA + (size_t)(t + 2) * kstep; const char* b2 = last ? nB : cB + (size_t)(t + 2) * kstep;
            const char* a3 = a2 + kstep; const char* b3 = b2 + kstep;
            if (last && has_next) S.a_ready(nxt);
            if constexpr (SP2) {
            PG8_LDB(B0, 0, 0); PG8_LDB(B1, 0, 1); PG8_SCHED; PG8_LDA(At, 0, 0); PG8_STAGE(PG8_SA(1, 1), a1 + hstep, voffA);
            PG8_WAIT_V(8); PG8_WAIT_L(0); PG8_BAR; PG8_MMA(0, 0, At, B0); PG8_MMA(0, 1, At, B1); PG8_BAR; PG8_SCHED;
            PG8_LDA(At, 0, 1); PG8_STAGE(PG8_SB(0, 0), b2, voffB); PG8_STAGE(PG8_SB(0, 1), b2 + hstep, voffB); PG8_STAGE(PG8_SA(0, 0), a2, voffA);
            PG8_WAIT_V(8); PG8_WAIT_L(0); PG8_BAR; PG8_MMA(1, 0, At, B0); PG8_MMA(1, 1, At, B1); PG8_BAR; PG8_SCHED;
            PG8_LDB(B0, 1, 0); PG8_LDB(B1, 1, 1); PG8_SCHED; PG8_LDA(At, 1, 0); PG8_STAGE(PG8_SA(0, 1), a2 + hstep, voffA);
            PG8_WAIT_V(8); PG8_WAIT_L(0); PG8_BAR; PG8_MMA(0, 0, At, B0); PG8_MMA(0, 1, At, B1); PG8_BAR; PG8_SCHED;
            PG8_LDA(At, 1, 1); PG8_STAGE(PG8_SB(1, 0), b3, voffB); PG8_STAGE(PG8_SB(1, 1), b3 + hstep, voffB); PG8_STAGE(PG8_SA(1, 0), a3, voffA);
            PG8_WAIT_V(8); PG8_WAIT_L(0); PG8_BAR; PG8_MMA(1, 0, At, B0); PG8_MMA(1, 1, At, B1); PG8_BAR; PG8_SCHED;
            } else {
            PG8_LDB(B0, 0, 0); PG8_SCHED; PG8_LDA(At, 0, 0); PG8_STAGE(PG8_SA(1, 1), a1 + hstep, voffA);
            PG8_WAIT_L(8); PG8_BAR; PG8_WAIT_L(0); PG8_MMA(0, 0, At, B0); PG8_BAR; PG8_SCHED;
            PG8_LDB(B1, 0, 1); PG8_STAGE(PG8_SB(0, 0), b2, voffB);
            PG8_BAR; PG8_WAIT_L(0); PG8_MMA(0, 1, At, B1); PG8_BAR;
            PG8_LDA(At, 0, 1); PG8_STAGE(PG8_SA(0, 0), a2, voffA);
            PG8_BAR; PG8_WAIT_L(0); PG8_MMA(1, 0, At, B0); PG8_BAR; PG8_SCHED;
            PG8_STAGE(PG8_SB(0, 1), b2 + hstep, voffB);
            PG8_WAIT_V(6); PG8_BAR; PG8_MMA(1, 1, At, B1); PG8_BAR;
            PG8_LDB(B0, 1, 0); PG8_SCHED; PG8_LDA(At, 1, 0); PG8_STAGE(PG8_SA(0, 1), a2 + hstep, voffA);
            PG8_WAIT_L(8); PG8_BAR; PG8_WAIT_L(0); PG8_MMA(0, 0, At, B0); PG8_BAR; PG8_SCHED;
            PG8_LDB(B1, 1, 1); PG8_STAGE(PG8_SB(1, 0), b3, voffB);
            PG8_BAR; PG8_WAIT_L(0); PG8_MMA(0, 1, At, B1); PG8_BAR;
            PG8_LDA(At, 1, 1); PG8_STAGE(PG8_SA(1, 0), a3, voffA);
            PG8_BAR; PG8_WAIT_L(0); PG8_MMA(1, 0, At, B0); PG8_BAR; PG8_SCHED;
            PG8_STAGE(PG8_SB(1, 1), b3 + hstep, voffB);
            PG8_WAIT_V(6); PG8_BAR; PG8_MMA(1, 1, At, B1); PG8_BAR;
            }
        }
        if constexpr (ALIGN_EPI) { if (wr == 0) PG8_BAR; }
        if constexpr (!Epi::AFTER_DRAIN) { E(acc, cur, wr, wc, fr, fq); S.done(cur); }
        if (!has_next) break;
#pragma unroll
        for (int a = 0; a < 2; ++a)
#pragma unroll
            for (int b = 0; b < 2; ++b)
#pragma unroll
                for (int m = 0; m < 4; ++m)
#pragma unroll
                    for (int n = 0; n < 2; ++n) acc[a][b][m][n] = (f32x4){0.f, 0.f, 0.f, 0.f};
        cur = nxt; cA = nA; cB = nB; nt = cur.nt; ++ui;
        if constexpr (ALIGN_EPI) { if (wr == 1) PG8_BAR; }
    }
    PG8_WAIT_V(0);
    if constexpr (!ALIGN_EPI) { if (wr == 0) PG8_BAR; }
    PG8_BAR;
    if constexpr (Epi::AFTER_DRAIN) { E.fused(acc, cur, wr, wc, fr, fq, lds, wid, lane); S.done(cur); }
#undef PG8_SA
#undef PG8_SB
#undef PG8_STAGE
#undef PG8_LDA
#undef PG8_LDB
#undef PG8_MMA
#undef PG8_WAIT_V
#undef PG8_WAIT_L
#undef PG8_BAR
#undef PG8_SCHED
}
}
#define LAS __attribute__((address_space(3)))
typedef __attribute__((address_space(1))) unsigned gu32;
#define XB_TMO      128
#define XB_XCNT(j)  (256  + 64 * (j))
#define XB_XSUB(j)  (1280 + 64 * (j))
#define XB_XGEN(j)  (2304 + 64 * (j))
#define XB_TOP      3328
#define XB_TOPGEN   3392
#define XCD_BAR_WORDS 3456
#define XB_SPIN_CAP (1u << 18)

__device__ __forceinline__ unsigned xb_ld(unsigned* p)              { return __hip_atomic_load(p, __ATOMIC_RELAXED, __HIP_MEMORY_SCOPE_AGENT); }
__device__ __forceinline__ unsigned xb_add(unsigned* p, unsigned v) { return __hip_atomic_fetch_add(p, v, __ATOMIC_RELAXED, __HIP_MEMORY_SCOPE_AGENT); }
__device__ __forceinline__ unsigned xb_xcc_id() { return (unsigned)__builtin_amdgcn_s_getreg((3 << 11) | 20) & 0xFu; }
#define XB_SPIN(cond, bar) do { unsigned _sp = 0; while (cond) { __builtin_amdgcn_s_sleep(1); \
    if ((++_sp & 255u) == 0u) { if (xb_ld(&(bar)[XB_TMO])) break; if (_sp > XB_SPIN_CAP) { atomicAdd(&(bar)[XB_TMO], 1u); break; } } } } while (0)

struct XcdBarrier {
    unsigned* bar; unsigned x;
    volatile LAS unsigned* st;
};

__device__ __forceinline__ XcdBarrier xcd_barrier_post(unsigned* bar, volatile LAS unsigned* st) {
    XcdBarrier b; b.bar = bar; b.x = xb_xcc_id(); b.st = st;
    if (threadIdx.x == 0) (void)xb_add(&bar[XB_XCNT(b.x)], 1u);
    return b;
}
__device__ __forceinline__ void xcd_barrier_complete(unsigned* bar, unsigned x, unsigned& nloc, unsigned& nx) {
    const unsigned G = gridDim.x * gridDim.y * gridDim.z;
    unsigned sum, cnt, mine, sp = 0u;
    for (;;) {
        sum = 0u; cnt = 0u; mine = 0u;
#pragma unroll
        for (unsigned j = 0; j < 16; ++j) { const unsigned c = xb_ld(&bar[XB_XCNT(j)]); sum += c; cnt += (c > 0u) ? 1u : 0u; mine = (j == x) ? c : mine; }
        if (sum == G) break;
        __builtin_amdgcn_s_sleep(1);
        if ((++sp & 255u) == 0u) { if (xb_ld(&bar[XB_TMO])) break; if (sp > XB_SPIN_CAP) { atomicAdd(&bar[XB_TMO], 1u); break; } }
    }
    nloc = mine > 0u ? mine : 1u; nx = cnt > 0u ? cnt : 1u;
}

__device__ __forceinline__ void xcd_barrier(const XcdBarrier& b) {
    asm volatile("s_waitcnt vmcnt(0)" ::: "memory");
    __syncthreads();
    if (threadIdx.x == 0) {
        unsigned* bar = b.bar;
        __builtin_amdgcn_s_waitcnt(0);
        unsigned nloc = b.st[0], nx = b.st[1];
        if (nloc == 0u) { xcd_barrier_complete(bar, b.x, nloc, nx); b.st[0] = nloc; b.st[1] = nx; }
        const unsigned old = xb_add(&bar[XB_XSUB(b.x)], 1u);
        const unsigned gen = old / nloc;
        if (old + 1u == (gen + 1u) * nloc) {
            __builtin_amdgcn_fence(__ATOMIC_RELEASE, "agent");
            asm volatile("s_waitcnt vmcnt(0)" ::: "memory");
            const unsigned og = xb_add(&bar[XB_TOP], 1u);
            const unsigned tg = og / nx;
            if (og + 1u == (tg + 1u) * nx) xb_add(&bar[XB_TOPGEN], 1u);
            else XB_SPIN(xb_ld(&bar[XB_TOPGEN]) == tg, bar);
            __builtin_amdgcn_fence(__ATOMIC_ACQUIRE, "agent");
            xb_add(&bar[XB_XGEN(b.x)], 1u);
            asm volatile("s_waitcnt vmcnt(0)" ::: "memory");
        } else {
            XB_SPIN(xb_ld(&bar[XB_XGEN(b.x)]) == gen, bar);
            __builtin_amdgcn_fence(__ATOMIC_ACQUIRE, "agent");
            asm volatile("s_waitcnt vmcnt(0)" ::: "memory");
        }
    }
    __syncthreads();
}

typedef unsigned short bf16;
typedef unsigned v4u __attribute__((ext_vector_type(4)));
typedef unsigned v2u __attribute__((ext_vector_type(2)));
typedef float f32x4 __attribute__((ext_vector_type(4)));
typedef float f32x16 __attribute__((ext_vector_type(16)));
typedef short bf16x8 __attribute__((ext_vector_type(8)));
typedef short s16x4 __attribute__((ext_vector_type(4)));
#define GAS __attribute__((address_space(1)))

constexpr int NWAVES = 8, NTHR = 512;
constexpr int NB = 4, SEQ = 8192, CTX = 256, TB = SEQ + CTX, MTOK = NB * TB, DM = 2048, DFF = 8192, DIN = 3664, DINP = 3840, DEPTH = 4;
constexpr int ZQ = 0, ZKV = 512, ZR = 768, ZSQ = 832, ZSK = 1856, ZSV = 1984, ZMQ = 2112, ZMK = 2368, ZMV = 2624, ZMG = 3136, ZMO = 3152;
constexpr int NSTEP = 132;
constexpr float NORM_EPS = 1e-6f;
constexpr float LOG2E = 1.4426950408889634f;

constexpr size_t MiB = 1u << 20;
constexpr size_t WS_CTL = 0, CTL_ZERO_BYTES = 1 * MiB;
constexpr size_t WS_MOD = 1 * MiB, WS_WIN = 2 * MiB, WS_WUQ = 17 * MiB, WS_WUKV = 18 * MiB, WS_WOUT = 19 * MiB, WS_W1 = 27 * MiB, WS_W2 = 59 * MiB;
constexpr size_t WS_X = 91 * MiB, WS_H = 355 * MiB, WS_GATES = 487 * MiB, WS_DC = 490 * MiB, WS_DN = 622 * MiB, WS_SC = 624 * MiB, WS_BIG = 625 * MiB;
constexpr size_t BG_Z = 0, BG_ZQN = 248 * MiB, BG_ZKVN = 281 * MiB, BG_KR = 298 * MiB, BG_QM = 303 * MiB, BG_KVM = 353 * MiB, BG_Y = 419 * MiB, BG_END = 551 * MiB;
constexpr size_t WS_SLAB = WS_BIG + BG_END;
constexpr size_t WS_STAT = WS_SLAB + 64 * MiB;
constexpr size_t WS_WSET1 = WS_STAT + 5 * MiB;
constexpr size_t WSET_BYTES = 89 * MiB;
constexpr size_t WS_END = WS_WSET1 + WSET_BYTES;
constexpr int BIASW = DINP + DFF;
static_assert((size_t)MTOK * DM * 4 == 264 * MiB && (size_t)MTOK * DFF * 2 <= BG_END && (size_t)MTOK * DINP * 2 <= BG_ZQN, "ws map");
constexpr int CW_BAR = 4096;

constexpr int RING_BYTES = 131072, LDSCTL_OFF = 138240  , MISC_OFF = LDSCTL_OFF + 320, LDS_BYTES = 147456;

#define LDS_WAIT() asm volatile("s_waitcnt lgkmcnt(0)" ::: "memory")
__device__ __forceinline__ float bf2f(unsigned h) { return __uint_as_float(h << 16); }
__device__ __forceinline__ unsigned pk2(float lo, float hi) { return pg8::pkbf(lo, hi); }
__device__ __forceinline__ float wave_sum(float v) {
#pragma unroll
    for (int o = 1; o < 64; o <<= 1) v += __shfl_xor(v, o);
    return v;
}
__device__ __forceinline__ float wave_max(float v) {
#pragma unroll
    for (int o = 1; o < 64; o <<= 1) v = fmaxf(v, __shfl_xor(v, o));
    return v;
}
__device__ __forceinline__ float fexp2(float x) { return __builtin_amdgcn_exp2f(x); }
__device__ __forceinline__ float fexp(float x) { return __builtin_amdgcn_exp2f(x * LOG2E); }
__device__ __forceinline__ float sigmoidf_(float x) { return 1.f / (1.f + fexp(-x)); }
__device__ __forceinline__ float sigmoid_fast(float x) { return __builtin_amdgcn_rcpf(1.f + fexp(-x)); }
__device__ __forceinline__ float row16_sum(float v) {
    v += __int_as_float(__builtin_amdgcn_mov_dpp(__float_as_int(v), 0xB1, 0xf, 0xf, true));
    v += __int_as_float(__builtin_amdgcn_mov_dpp(__float_as_int(v), 0x4E, 0xf, 0xf, true));
    v += __int_as_float(__builtin_amdgcn_mov_dpp(__float_as_int(v), 0x124, 0xf, 0xf, true));
    v += __int_as_float(__builtin_amdgcn_mov_dpp(__float_as_int(v), 0x128, 0xf, 0xf, true));
    return v;
}
__device__ __forceinline__ float logsigf_(float x) { return fminf(x, 0.f) - log1pf(expf(-fabsf(x))); }
__device__ __forceinline__ float logsig_fast(float x) { return fminf(x, 0.f) - 0.6931471805599453f * __builtin_amdgcn_logf(1.f + fexp(-fabsf(x))); }
__device__ __forceinline__ void rope_cs(int pos, int i, float& c, float& s) {
    const float inv = fexp2(-0.8304820237218406f * (float)i);
    float rev = (float)pos * inv * 0.15915494309189535f; rev -= floorf(rev);
    c = __builtin_amdgcn_cosf(rev); s = __builtin_amdgcn_sinf(rev);
}

__device__ __forceinline__ void phase_mod(const float* c, const float* c_ctx, const float* w_mod, const float* b_mod, float* MOD, LAS unsigned char* L, int wg, int G, int tid) {
    LAS float* sv = (LAS float*)L;
    LAS float* red = (LAS float*)(L + 40960);
    for (int i = tid; i < 5 * DM; i += NTHR) { const int b = i / DM, k = i - b * DM; const float v = b < 4 ? c[b * DM + k] : c_ctx[k]; sv[i] = v / (1.f + expf(-v)); }
    __syncthreads();
    const int wave = tid >> 6, lane = tid & 63;
    for (int item = wg; item < DEPTH * 192; item += G) {
        const int l = item / 192, cg = item - l * 192;
        const float* W = w_mod + (size_t)l * DM * 12288 + cg * 64 + lane;
        float a0 = 0.f, a1 = 0.f, a2 = 0.f, a3 = 0.f, a4 = 0.f;
        const int k0 = wave * 256;
#pragma unroll 8
        for (int k = k0; k < k0 + 256; ++k) { const float w = W[(size_t)k * 12288];
            a0 += sv[k] * w; a1 += sv[DM + k] * w; a2 += sv[2 * DM + k] * w; a3 += sv[3 * DM + k] * w; a4 += sv[4 * DM + k] * w; }
        red[(wave * 5 + 0) * 64 + lane] = a0; red[(wave * 5 + 1) * 64 + lane] = a1; red[(wave * 5 + 2) * 64 + lane] = a2; red[(wave * 5 + 3) * 64 + lane] = a3; red[(wave * 5 + 4) * 64 + lane] = a4;
        __syncthreads();
        if (tid < 320) { const int b = tid >> 6, ln = tid & 63; float s = 0.f;
#pragma unroll
            for (int w = 0; w < 8; ++w) s += red[(w * 5 + b) * 64 + ln];
            MOD[(size_t)(l * 5 + b) * 12288 + cg * 64 + ln] = s + b_mod[l * 12288 + cg * 64 + ln]; }
        __syncthreads();
    }
}

__device__ __forceinline__ void transpose_item(const float* W, int K, int N, int NP, bf16* WT, LAS float* scr, int item, int lane, const LAS float* tab, long long* bias, int ldb) {
    const int nblk = NP / 32, kb = item / nblk, nb = item - kb * nblk, k0 = 64 * kb, n0 = 32 * nb;
    const int n = n0 + (lane & 31); const bool okn = n < N;
    float wv_[32];
    const float* wp = W + (size_t)(k0 + (lane >> 5)) * N + (okn ? n : 0);
#pragma unroll
    for (int i = 0; i < 32; ++i) wv_[i] = wp[(size_t)(2 * i) * N];
#pragma unroll
    for (int i = 0; i < 32; ++i) { if (!okn) wv_[i] = 0.f; scr[(2 * i + (lane >> 5)) * 33 + (lane & 31)] = wv_[i]; }
    if (tab != nullptr) {
        const LAS float* tp = tab + k0 + (lane >> 5);
#pragma unroll
        for (int bp = 0; bp < 5; ++bp) { float s = 0.f;
#pragma unroll
            for (int i = 0; i < 32; ++i) s += tp[bp * 2048 + 2 * i] * wv_[i];
            s += __shfl_xor(s, 32);
            if (lane < 32) atomicAdd((unsigned long long*)(bias + (size_t)bp * ldb + n), (unsigned long long)(long long)(s * 4294967296.f)); }
    }
    LDS_WAIT(); asm volatile("" ::: "memory");
    const int c = lane & 7;
#pragma unroll
    for (int j = 0; j < 4; ++j) { const int nn = (lane >> 3) + 8 * j; const LAS float* s = scr + (8 * c) * 33 + nn;
        v4u o; o.x = pk2(s[0 * 33], s[1 * 33]); o.y = pk2(s[2 * 33], s[3 * 33]); o.z = pk2(s[4 * 33], s[5 * 33]); o.w = pk2(s[6 * 33], s[7 * 33]);
        *(v4u*)(WT + (size_t)(n0 + nn) * K + k0 + 8 * c) = o; }
    LDS_WAIT(); asm volatile("" ::: "memory");
}
struct ConvSrc { const float *w_in, *w_uq, *w_ukv, *w_out, *w1, *w2; };
struct ConvDst { bf16 *win, *wuq, *wukv, *wout, *w1, *w2; };
constexpr int CV_I1 = (DM / 64) * (DFF / 32), CV_I2 = (DFF / 64) * (DM / 32), CV_IOUT = (DM / 64) * (DM / 32), CV_IIN = (DM / 64) * (DINP / 32), CV_IUQ = (512 / 64) * (768 / 32), CV_IUKV = (256 / 64) * (1024 / 32);
constexpr int CV_A_SPLIT = 4352, CV_B_SPLIT = 6400;
__device__ __forceinline__ void conv_load_tab(LAS float* tab, const float* modl, int which  , int tid) {
    __syncthreads();
    for (int i = tid; i < 5 * DM; i += NTHR) { const int bp = i / DM, k = i - bp * DM; tab[i] = modl[(size_t)bp * 12288 + which * DM + k]; }
    __syncthreads();
}
__device__ __forceinline__ void conv_A(const ConvSrc s, const ConvDst d, int l, int lo, int hi, int worker, int nworkers, LAS float* scr, const LAS float* tab, long long* biasl, int lane) {
    for (int it = lo + worker; it < hi; it += nworkers) transpose_item(s.w1 + (size_t)l * DM * DFF, DM, DFF, DFF, d.w1, scr, it, lane, tab, biasl + DINP, BIASW);
}
__device__ __forceinline__ void conv_B(const ConvSrc s, const ConvDst d, int l, int lo, int hi, int worker, int nworkers, LAS float* scr, int lane) {
    for (int it = lo + worker; it < hi; it += nworkers) transpose_item(s.w2 + (size_t)l * DFF * DM, DFF, DM, DM, d.w2, scr, it, lane, nullptr, nullptr, 0);
}
__device__ __forceinline__ void conv_CD(const ConvSrc s, const ConvDst d, int l, int worker, int nworkers, LAS float* scr, const LAS float* tab, long long* biasl, int lane) {
    for (int it = worker; it < CV_IOUT + CV_IIN + CV_IUQ + CV_IUKV; it += nworkers) {
        int r = it;
        if (r < CV_IIN) { transpose_item(s.w_in + (size_t)l * DM * DIN, DM, DIN, DINP, d.win, scr, r, lane, tab, biasl, BIASW); continue; } r -= CV_IIN;
        if (r < CV_IOUT) { transpose_item(s.w_out + (size_t)l * DM * DM, DM, DM, DM, d.wout, scr, r, lane, nullptr, nullptr, 0); continue; } r -= CV_IOUT;
        if (r < CV_IUQ) { transpose_item(s.w_uq + (size_t)l * 512 * 768, 512, 768, 768, d.wuq, scr, r, lane, nullptr, nullptr, 0); continue; } r -= CV_IUQ;
        transpose_item(s.w_ukv + (size_t)l * 256 * 1024, 256, 1024, 1024, d.wukv, scr, r, lane, nullptr, nullptr, 0);
    }
}

__device__ __forceinline__ void phase_first(const float* xin, const float* ctxin, bf16* X, bf16* HX, unsigned long long* rowss, const float* g, const float* modl, int gw, int NGW, int lane) {
    const int rs = (int)(((long long)MTOK * gw) / NGW), re = (int)(((long long)MTOK * (gw + 1)) / NGW);
    f32x4 gm[4][2], cur[4][2], nxt[4][2]; int bpc = -1;
#define PF_LOAD(dst, r_) do { const int b_ = (r_) / TB, p_ = (r_) - b_ * TB; const float* s_ = (p_ < CTX ? ctxin + (size_t)(b_ * CTX + p_) * DM : xin + (size_t)(b_ * SEQ + p_ - CTX) * DM) + 8 * lane; \
        _Pragma("unroll") for (int j = 0; j < 4; ++j) { dst[j][0] = *(const f32x4*)(s_ + 512 * j); dst[j][1] = *(const f32x4*)(s_ + 512 * j + 4); } } while (0)
    if (rs < re) PF_LOAD(cur, rs);
    for (int r = rs; r < re; ++r) {
        if (r + 1 < re) PF_LOAD(nxt, r + 1);
        const int b = r / TB, p = r - b * TB, bp = p < CTX ? 4 : b;
        if (bp != bpc) { bpc = bp; const float* gp = g + 8 * lane; const float* scp = modl + (size_t)bp * 12288 + DM + 8 * lane;
#pragma unroll
            for (int j = 0; j < 4; ++j)
#pragma unroll
                for (int h = 0; h < 2; ++h) gm[j][h] = *(const f32x4*)(gp + 512 * j + 4 * h) * (*(const f32x4*)(scp + 512 * j + 4 * h) + 1.f); }
        float ss = 0.f;
#pragma unroll
        for (int j = 0; j < 4; ++j)
#pragma unroll
            for (int h = 0; h < 2; ++h) { const f32x4 v = cur[j][h]; ss += (v.x * v.x + v.y * v.y) + (v.z * v.z + v.w * v.w); }
        ss = wave_sum(ss); if (lane == 0) rowss[r] = (unsigned long long)(ss * 16777216.f);
        bf16* xo = X + (size_t)r * DM + 8 * lane; bf16* ho = HX + (size_t)r * DM + 8 * lane;
#pragma unroll
        for (int j = 0; j < 4; ++j) { const f32x4 v0 = cur[j][0], v1 = cur[j][1], h0 = v0 * gm[j][0], h1 = v1 * gm[j][1];
            *(v4u*)(xo + 512 * j) = (v4u){pk2(v0.x, v0.y), pk2(v0.z, v0.w), pk2(v1.x, v1.y), pk2(v1.z, v1.w)};
            *(v4u*)(ho + 512 * j) = (v4u){pk2(h0.x, h0.y), pk2(h0.z, h0.w), pk2(h1.x, h1.y), pk2(h1.z, h1.w)}; }
#pragma unroll
        for (int j = 0; j < 4; ++j) { cur[j][0] = nxt[j][0]; cur[j][1] = nxt[j][1]; }
    }
#undef PF_LOAD
}
__device__ __forceinline__ void phase_ctxfix(bf16* X, bf16* HX, unsigned long long* rowss, const float* slab, const float* fixgate, const float* g, const float* nsc, int gw, int NGW, int lane) {
    for (int cr = gw; cr < NB * CTX; cr += NGW) {
        const int b = cr / CTX, p = cr - b * CTX; const size_t r = (size_t)b * TB + p;
        unsigned long long* xr = (unsigned long long*)(X + r * DM) + lane; const f32x4* sp = (const f32x4*)(slab + (size_t)cr * DM) + lane; const f32x4* fg = (const f32x4*)fixgate + lane;
        f32x4 v[8]; float ss = 0.f;
#pragma unroll
        for (int j = 0; j < 8; ++j) { f32x4 acc = sp[64 * j];
#pragma unroll
            for (int s = 1; s < 8; ++s) acc = acc + sp[(size_t)s * (1024 * DM / 4) + 64 * j];
            const unsigned long long xw = xr[64 * j]; const unsigned w0 = (unsigned)xw, w1 = (unsigned)(xw >> 32);
            v[j] = (f32x4){__uint_as_float(w0 << 16), __uint_as_float(w0 & 0xffff0000u), __uint_as_float(w1 << 16), __uint_as_float(w1 & 0xffff0000u)} + fg[64 * j] * acc; ss += (v[j].x * v[j].x + v[j].y * v[j].y) + (v[j].z * v[j].z + v[j].w * v[j].w); }
        ss = wave_sum(ss); if (lane == 0) rowss[r] = (unsigned long long)(ss * 16777216.f);
        const f32x4* gp = (const f32x4*)g + lane; const f32x4* scp = (const f32x4*)nsc + lane;
        unsigned long long* o8 = (unsigned long long*)(HX + r * DM) + lane;
#pragma unroll
        for (int j = 0; j < 8; ++j) { xr[64 * j] = (unsigned long long)pk2(v[j].x, v[j].y) | ((unsigned long long)pk2(v[j].z, v[j].w) << 32); const f32x4 gg = gp[64 * j], sc = scp[64 * j];
            o8[64 * j] = (unsigned long long)pk2(v[j].x * gg.x * (1.f + sc.x), v[j].y * gg.y * (1.f + sc.y)) | ((unsigned long long)pk2(v[j].z * gg.z * (1.f + sc.z), v[j].w * gg.w * (1.f + sc.w)) << 32); }
    }
}
__device__ __forceinline__ void phase_final(const bf16* X, float* out, const float* g, int gw, int NGW, int lane) {
    const int qs = (int)(((long long)NB * SEQ * gw) / NGW), qe = (int)(((long long)NB * SEQ * (gw + 1)) / NGW);
    f32x4 gg[4][2]; v4u cur[4], nxt[4];
#pragma unroll
    for (int j = 0; j < 4; ++j) { gg[j][0] = *(const f32x4*)(g + 512 * j + 8 * lane); gg[j][1] = *(const f32x4*)(g + 512 * j + 8 * lane + 4); }
#define FN_LOAD(dst, q_) do { const int b_ = (q_) / SEQ; const bf16* s_ = X + ((size_t)b_ * TB + CTX + ((q_) - b_ * SEQ)) * DM + 8 * lane; \
        _Pragma("unroll") for (int j = 0; j < 4; ++j) dst[j] = *(const v4u*)(s_ + 512 * j); } while (0)
    if (qs < qe) FN_LOAD(cur, qs);
    for (int q = qs; q < qe; ++q) {
        if (q + 1 < qe) FN_LOAD(nxt, q + 1);
        f32x4 v[4][2]; float ss = 0.f;
#pragma unroll
        for (int j = 0; j < 4; ++j) { const v4u w = cur[j];
            v[j][0] = (f32x4){__uint_as_float(w.x << 16), __uint_as_float(w.x & 0xffff0000u), __uint_as_float(w.y << 16), __uint_as_float(w.y & 0xffff0000u)};
            v[j][1] = (f32x4){__uint_as_float(w.z << 16), __uint_as_float(w.z & 0xffff0000u), __uint_as_float(w.w << 16), __uint_as_float(w.w & 0xffff0000u)};
#pragma unroll
            for (int h = 0; h < 2; ++h) ss += (v[j][h].x * v[j][h].x + v[j][h].y * v[j][h].y) + (v[j][h].z * v[j][h].z + v[j][h].w * v[j][h].w); }
        const float rstd = rsqrtf(wave_sum(ss) * (1.f / DM) + NORM_EPS);
        float* o = out + (size_t)q * DM + 8 * lane;
#pragma unroll
        for (int j = 0; j < 4; ++j)
#pragma unroll
            for (int h = 0; h < 2; ++h) *(f32x4*)(o + 512 * j + 4 * h) = v[j][h] * rstd * gg[j][h];
#pragma unroll
        for (int j = 0; j < 4; ++j) cur[j] = nxt[j];
    }
#undef FN_LOAD
}

__device__ __forceinline__ void rope4(const bf16* src, bf16* dst, int i0, const float (&cr)[4], const float (&sr)[4], const float (&cc)[4], const float (&sc)[4]) {
    const v2u r1 = *(const v2u*)(src + i0), r2 = *(const v2u*)(src + 16 + i0), r3 = *(const v2u*)(src + 32 + i0), r4 = *(const v2u*)(src + 48 + i0);
    float x1[4] = {bf2f(r1.x & 0xffffu), bf2f(r1.x >> 16), bf2f(r1.y & 0xffffu), bf2f(r1.y >> 16)};
    float x2[4] = {bf2f(r2.x & 0xffffu), bf2f(r2.x >> 16), bf2f(r2.y & 0xffffu), bf2f(r2.y >> 16)};
    float x3[4] = {bf2f(r3.x & 0xffffu), bf2f(r3.x >> 16), bf2f(r3.y & 0xffffu), bf2f(r3.y >> 16)};
    float x4[4] = {bf2f(r4.x & 0xffffu), bf2f(r4.x >> 16), bf2f(r4.y & 0xffffu), bf2f(r4.y >> 16)};
    float o1[4], o2[4], o3[4], o4[4];
#pragma unroll
    for (int e = 0; e < 4; ++e) { o1[e] = x1[e] * cr[e] - x2[e] * sr[e]; o2[e] = x2[e] * cr[e] + x1[e] * sr[e]; o3[e] = x3[e] * cc[e] - x4[e] * sc[e]; o4[e] = x4[e] * cc[e] + x3[e] * sc[e]; }
    *(v2u*)(dst + i0) = (v2u){pk2(o1[0], o1[1]), pk2(o1[2], o1[3])}; *(v2u*)(dst + 16 + i0) = (v2u){pk2(o2[0], o2[1]), pk2(o2[2], o2[3])};
    *(v2u*)(dst + 32 + i0) = (v2u){pk2(o3[0], o3[1]), pk2(o3[2], o3[3])}; *(v2u*)(dst + 48 + i0) = (v2u){pk2(o4[0], o4[1]), pk2(o4[2], o4[3])};
}
__device__ __forceinline__ void phase_e1(bf16* Z, bf16* ZQN, bf16* ZKVN, bf16* KR, const float* gq, const float* gkv, int wg, int G, int wave, int lane, bool do_rope = true) {
    const int n5 = (NB * 4 * NSTEP / 2) % G, tot5 = 4 * n5 + 5 * (G - n5);
    const int c0 = wg < n5 ? 4 * wg : 4 * n5 + 5 * (wg - n5), c1 = wg + 1 < n5 ? 4 * (wg + 1) : 4 * n5 + 5 * (wg + 1 - n5);
    const int rs = (int)(((long long)MTOK * c0) / tot5), re = (int)(((long long)MTOK * c1) / tot5);
    for (int r0 = rs + wave; r0 < re; r0 += 2 * NWAVES)
#pragma unroll
    for (int rr = 0; rr < 2; ++rr) {
        const int r = r0 + rr * NWAVES; if (r >= re) break;
        const int b = r / TB, p = r - b * TB; const bool latent = p >= CTX && do_rope; const int t = p - CTX;
        bf16* z = Z + (size_t)r * DINP;
        { const v4u raw = *(const v4u*)(z + ZQ + 8 * lane); float f[8]; float ss = 0.f;
#pragma unroll
          for (int e = 0; e < 4; ++e) { f[2 * e] = bf2f(raw[e] & 0xffffu); f[2 * e + 1] = bf2f(raw[e] >> 16); ss += f[2 * e] * f[2 * e] + f[2 * e + 1] * f[2 * e + 1]; }
          const float rstd = rsqrtf(wave_sum(ss) * (1.f / 512.f) + NORM_EPS);
          const f32x4 g0 = *(const f32x4*)(gq + 8 * lane), g1 = *(const f32x4*)(gq + 8 * lane + 4);
          v4u o; o.x = pk2(f[0] * rstd * g0.x, f[1] * rstd * g0.y); o.y = pk2(f[2] * rstd * g0.z, f[3] * rstd * g0.w); o.z = pk2(f[4] * rstd * g1.x, f[5] * rstd * g1.y); o.w = pk2(f[6] * rstd * g1.z, f[7] * rstd * g1.w);
          *(v4u*)(ZQN + (size_t)r * 512 + 8 * lane) = o; }
        { const v2u raw = *(const v2u*)(z + ZKV + 4 * lane); float f[4] = {bf2f(raw.x & 0xffffu), bf2f(raw.x >> 16), bf2f(raw.y & 0xffffu), bf2f(raw.y >> 16)};
          const float ss = (f[0] * f[0] + f[1] * f[1]) + (f[2] * f[2] + f[3] * f[3]);
          const float rstd = rsqrtf(wave_sum(ss) * (1.f / 256.f) + NORM_EPS);
          const f32x4 g0 = *(const f32x4*)(gkv + 4 * lane);
          *(v2u*)(ZKVN + (size_t)r * 256 + 4 * lane) = (v2u){pk2(f[0] * rstd * g0.x, f[1] * rstd * g0.y), pk2(f[2] * rstd * g0.z, f[3] * rstd * g0.w)}; }
        if (latent) {
            const int prow = t >> 6, pcol = t & 63, i0 = 4 * (lane & 3);
            float cr[4], sr[4], cc[4], sc[4];
#pragma unroll
            for (int e = 0; e < 4; ++e) { rope_cs(prow, i0 + e, cr[e], sr[e]); rope_cs(pcol, i0 + e, cc[e], sc[e]); }
            { bf16* hp = z + ZSQ + 64 * (lane >> 2); rope4(hp, hp, i0, cr, sr, cc, sc); }
            if (lane < 8) { bf16* hp = z + ZSK + 64 * (lane >> 2); rope4(hp, hp, i0, cr, sr, cc, sc); }
            else if (lane < 12) rope4(z + ZR, KR + (size_t)r * 64, i0, cr, sr, cc, sc);
        } else {
            if (lane < 8) *(v4u*)(KR + (size_t)r * 64 + 8 * lane) = *(const v4u*)(z + ZR + 8 * lane);
        }
    }
}

#define MFMA16(a, b, c) __builtin_amdgcn_mfma_f32_16x16x32_bf16((a), (b), (c), 0, 0, 0)
__device__ __forceinline__ bf16x8 gather8(LAS const unsigned char* base, int stride) {
    bf16x8 r;
#pragma unroll
    for (int j = 0; j < 8; ++j) r[j] = *(LAS const short*)(base + j * stride);
    return r;
}
__device__ __forceinline__ bf16x8 colfrag8(LAS const unsigned char* tile, int row0, int col0, int stride, int lane) {
    typedef short v4i16_ __attribute__((ext_vector_type(4)));
    LAS const unsigned char* p = tile + (row0 + 8 * (lane >> 4) + ((lane & 15) >> 2)) * stride + (col0 + 4 * (lane & 3)) * 2;
    const s16x4 lo = __builtin_bit_cast(s16x4, __builtin_amdgcn_ds_read_tr16_b64_v4i16((LAS v4i16_*)p));
    const s16x4 hi = __builtin_bit_cast(s16x4, __builtin_amdgcn_ds_read_tr16_b64_v4i16((LAS v4i16_*)(p + 4 * stride)));
    return __builtin_shufflevector(lo, hi, 0, 1, 2, 3, 4, 5, 6, 7);
}
__device__ __forceinline__ void chain_step_rows(int dir, int i, int& seg, int& c) { seg = i >= 4; const int ii = seg ? i - 4 : i; c = dir == 0 ? ii : (seg ? 127 - ii : 3 - ii); }
__device__ __forceinline__ float scan_sum(float v, int dir, int lane) {
#pragma unroll
    for (int o = 1; o < 64; o <<= 1) { const float t = dir == 0 ? __shfl_up(v, o) : __shfl_down(v, o); const bool ok = dir == 0 ? (lane >= o) : (lane + o < 64); if (ok) v += t; }
    return v;
}
__device__ __forceinline__ float scan_max(float v, int dir, int lane) {
#pragma unroll
    for (int o = 1; o < 64; o <<= 1) { const float t = dir == 0 ? __shfl_up(v, o) : __shfl_down(v, o); const bool ok = dir == 0 ? (lane >= o) : (lane + o < 64); if (ok) v = fmaxf(v, t); }
    return v;
}

__device__ __forceinline__ void mlstm_a(const bf16* Z, const float* GATES, const float* gbias  , bf16* DC, float* DN, float* SC, LAS unsigned char* L, int wg, int G, int tid) {
    const int wave = tid >> 6, lane = tid & 63, fr = lane & 15, fq = lane >> 4, half = wave >> 2, w4 = wave & 3, t256 = tid & 255;
    LAS unsigned char* kt = L + half * 36864;
    LAS unsigned char* vt = kt + 18432;
    LAS float* wv = (LAS float*)(kt + 35840);
    constexpr int NP = NB * 4 * NSTEP / 2;
    for (int pair = wg; pair < NP; pair += G) {
        const int item = 2 * pair + half;
        const int b = item / (4 * NSTEP), h = (item / NSTEP) & 3, cc0 = item % NSTEP, seg = cc0 >= 4, c = seg ? cc0 - 4 : cc0;
        const int row0 = b * TB + (seg ? CTX : 0) + 64 * c;
        const int step0 = seg ? 4 + c : c, step1 = seg ? 4 + 127 - c : 3 - c;
        if (w4 < 2) {
            const int dir = w4; const size_t sidx = (size_t)((b * 4 + h) * 2 + dir) * NSTEP + (dir == 0 ? step0 : step1);
            const size_t row = (size_t)(row0 + lane);
            const float ip = GATES[row * 16 + (2 * dir) * 4 + h] + gbias[(2 * dir) * 4 + h];
            const float fp = GATES[row * 16 + (2 * dir + 1) * 4 + h] + gbias[(2 * dir + 1) * 4 + h];
            const float bs = scan_sum(logsigf_(fp), dir, lane);
            const float g = __shfl(bs, dir == 0 ? 63 : 0);
            const float a = g - bs + ip, amax = wave_max(a);
            wv[dir * 64 + lane] = expf(a - amax);
            if (lane == 0) { SC[sidx * 4 + 0] = g; SC[sidx * 4 + 1] = amax; }
        }
        v4u kraw[2], vraw[4];
#pragma unroll
        for (int i2 = 0; i2 < 2; ++i2) { const int c2 = t256 + 256 * i2; kraw[i2] = *(const v4u*)(Z + (size_t)(row0 + (c2 >> 3)) * DINP + ZMK + h * 64 + (c2 & 7) * 8); }
#pragma unroll
        for (int i2 = 0; i2 < 4; ++i2) { const int c2 = t256 + 256 * i2; vraw[i2] = *(const v4u*)(Z + (size_t)(row0 + (c2 >> 4)) * DINP + ZMV + h * 128 + (c2 & 15) * 8); }
        __syncthreads();
#pragma unroll
        for (int i2 = 0; i2 < 2; ++i2) { const int c2 = t256 + 256 * i2, krow_ = c2 >> 3, kcc_ = c2 & 7;
#pragma unroll
            for (int dir = 0; dir < 2; ++dir) { const float w = wv[dir * 64 + krow_]; v4u o;
#pragma unroll
                for (int e = 0; e < 4; ++e) o[e] = pk2(bf2f(kraw[i2][e] & 0xffffu) * w, bf2f(kraw[i2][e] >> 16) * w);
                *(LAS v4u*)(kt + dir * 9216 + krow_ * 144 + kcc_ * 16) = o; } }
#pragma unroll
        for (int i2 = 0; i2 < 4; ++i2) { const int c2 = t256 + 256 * i2; *(LAS v4u*)(vt + (c2 >> 4) * 272 + (c2 & 15) * 16) = vraw[i2]; }
        __syncthreads();
        if (w4 < 2) { const int dir = w4; const size_t sidx = (size_t)((b * 4 + h) * 2 + dir) * NSTEP + (dir == 0 ? step0 : step1); float s = 0.f;
#pragma unroll 8
            for (int j = 0; j < 64; ++j) s += bf2f(*(LAS const unsigned short*)(kt + dir * 9216 + j * 144 + lane * 2));
            DN[sidx * 64 + lane] = s; }
        {
            bf16x8 bfr[2][2];
#pragma unroll
            for (int et = 0; et < 2; ++et)
#pragma unroll
                for (int ks = 0; ks < 2; ++ks) bfr[et][ks] = colfrag8(vt, 32 * ks, 16 * (2 * w4 + et), 272, lane);
            const int ecol = 16 * (2 * w4 + (fq & 1)) + 4 * (fq & ~1);
#pragma unroll
            for (int dir = 0; dir < 2; ++dir) {
                bf16* dcp = DC + ((size_t)((b * 4 + h) * 2 + dir) * NSTEP + (dir == 0 ? step0 : step1)) * 8192;
#pragma unroll
                for (int dt = 0; dt < 4; ++dt) { f32x4 acc0 = {0.f, 0.f, 0.f, 0.f}, acc1 = {0.f, 0.f, 0.f, 0.f};
#pragma unroll
                    for (int ks = 0; ks < 2; ++ks) { const bf16x8 af = colfrag8(kt + dir * 9216, 32 * ks, 16 * dt, 144, lane); acc0 = MFMA16(bfr[0][ks], af, acc0); acc1 = MFMA16(bfr[1][ks], af, acc1); }
                    const auto sx = __builtin_amdgcn_permlane16_swap(pk2(acc0[0], acc0[1]), pk2(acc1[0], acc1[1]), false, false);
                    const auto sy = __builtin_amdgcn_permlane16_swap(pk2(acc0[2], acc0[3]), pk2(acc1[2], acc1[3]), false, false);
                    *(v4u*)(dcp + (16 * dt + fr) * 128 + ecol) = (v4u){sx[0], sy[0], sx[1], sy[1]}; } } }
        __syncthreads();
    }
}
__device__ __forceinline__ void mlstm_scan(bf16* DC, float* DN, float* SC, int wg, int G, int tid) {
    for (int unit = wg; unit < 32 * 8; unit += G) {
        const int chain = unit >> 3, slice = unit & 7;
        unsigned* dc = (unsigned*)(DC + (size_t)chain * NSTEP * 8192 + slice * 1024) + tid;
        float* dn = DN + (size_t)chain * NSTEP * 64 + (tid & 63);
        float* sc = SC + (size_t)chain * NSTEP * 4;
        const bool has_n = (slice == 0) && (tid < 64), rec_m = (slice == 0) && (tid == 0);
        float C0 = 0.f, C1 = 0.f, n = 0.f, m = 0.f;
        for (int i = 0; i < NSTEP; i += 12) {
            unsigned v[12]; float nv[12], g[12], am[12];
#pragma unroll
            for (int k = 0; k < 12; ++k) { v[k] = dc[(size_t)(i + k) * 4096]; g[k] = sc[(i + k) * 4]; am[k] = sc[(i + k) * 4 + 1]; nv[k] = has_n ? dn[(i + k) * 64] : 0.f; }
#pragma unroll
            for (int k = 0; k < 12; ++k) {
                const float mn = fmaxf(g[k] + m, am[k]), decay = expf(g[k] + m - mn), grow = expf(am[k] - mn);
                dc[(size_t)(i + k) * 4096] = pk2(C0, C1);
                C0 = decay * C0 + grow * bf2f(v[k] & 0xffffu); C1 = decay * C1 + grow * bf2f(v[k] >> 16);
                if (has_n) { dn[(i + k) * 64] = n; n = decay * n + grow * nv[k]; }
                if (rec_m) sc[(i + k) * 4 + 2] = m;
                m = mn;
            }
        }
    }
}
__device__ __forceinline__ void mlstm_c_phase(int u_first, int G, bool skip_ctx, const bf16* Z, const float* GATES, const float* gbias, const float* gh  , const bf16* DC, const float* DN, const float* SC,
                                              bf16* Y, LAS unsigned char* L, int tid) {
    const int wave = tid >> 6, lane = tid & 63, fr = lane & 15, fq = lane >> 4, dir = wave >> 2, w4 = wave & 3, t256 = tid & 255;
    LAS unsigned char* QS = L;
    LAS unsigned char* KS2 = L + 9216;
    LAS unsigned char* VS2 = L + 18432;
    LAS unsigned char* CS = L + 35840 + dir * 17408;
    LAS unsigned char* SS = L + 70656 + dir * 18432;
    LAS unsigned char* QW = SS + 9216;
    LAS float* HM = (LAS float*)(L + 70656);
    constexpr int HMS = 132;
    LAS float* VEC = (LAS float*)(L + 107520 + dir * 2048);
    LAS float* bq = VEC, *uu = VEC + 64, *iwv = VEC + 128, *emt = VEC + 192, *den = VEC + 256, *nin = VEC + 320;
    constexpr int NU = NB * 4 * NSTEP;
    v4u pq, pk, pv[2], pc[4]; float pig = 0.f, pfp = 0.f, pmin = 0.f, pnin = 0.f;
#define MC_DECODE(U) const int b = (U) / (4 * NSTEP), h = ((U) / NSTEP) & 3, cc0 = (U) % NSTEP, seg = cc0 >= 4, c = seg ? cc0 - 4 : cc0; \
    const int row0 = b * TB + (seg ? CTX : 0) + 64 * c; const int chain = (b * 4 + h) * 2 + dir; \
    const int step = dir == 0 ? (seg ? 4 + c : c) : (seg ? 4 + 127 - c : 3 - c); const size_t sidx = (size_t)chain * NSTEP + step
#define MC_NEXT(U) do { (U) += G; while (skip_ctx && (U) < NU && ((U) % NSTEP) < 4) (U) += G; } while (0)
#define MC_LOAD_A(U) do { MC_DECODE(U); (void)chain; (void)step; { const int row = tid >> 3, ch = tid & 7; const bf16* zr = Z + (size_t)(row0 + row) * DINP + h * 64 + ch * 8; pq = *(const v4u*)(zr + ZMQ); pk = *(const v4u*)(zr + ZMK); } \
        if (w4 == 0) { const size_t row = (size_t)(row0 + lane); pig = GATES[row * 16 + (2 * dir) * 4 + h] + gbias[(2 * dir) * 4 + h]; pfp = GATES[row * 16 + (2 * dir + 1) * 4 + h] + gbias[(2 * dir + 1) * 4 + h]; \
                       pmin = SC[sidx * 4 + 2]; pnin = DN[sidx * 64 + lane]; } } while (0)
#define MC_LOAD_C(U) do { MC_DECODE(U); (void)chain; (void)step; const bf16* cin = DC + sidx * 8192; \
        _Pragma("unroll") for (int i2 = 0; i2 < 2; ++i2) { const int c2 = tid + NTHR * i2; pv[i2] = *(const v4u*)(Z + (size_t)(row0 + (c2 >> 4)) * DINP + ZMV + h * 128 + (c2 & 15) * 8); } \
        _Pragma("unroll") for (int k = 0; k < 4; ++k) { const int c2 = t256 + 256 * k; pc[k] = *(const v4u*)(cin + (c2 >> 4) * 128 + (c2 & 15) * 8); } } while (0)
    int unit = u_first; while (skip_ctx && unit < NU && (unit % NSTEP) < 4) unit += G;
    if (unit < NU) { MC_LOAD_A(unit); MC_LOAD_C(unit); }
    for (; unit < NU; ) {
    int tl_ = tid; asm volatile("" : "+v"(tl_));
    const int wave = tl_ >> 6, lane = tl_ & 63, fr = lane & 15, fq = lane >> 4, dir = wave >> 2, w4 = wave & 3, t256 = tl_ & 255; const int tid = tl_;
    LAS unsigned char* CS = L + 35840 + dir * 17408; LAS unsigned char* SS = L + 70656 + dir * 18432; LAS unsigned char* QW = SS + 9216;
    LAS float* VEC = (LAS float*)(L + 107520 + dir * 2048); LAS float* bq = VEC, *uu = VEC + 64, *iwv = VEC + 128, *emt = VEC + 192, *den = VEC + 256, *nin = VEC + 320;
    MC_DECODE(unit); (void)chain; (void)step; (void)sidx;
    { const int row = tid >> 3, ch = tid & 7; v4u o;
#pragma unroll
      for (int e = 0; e < 4; ++e) o[e] = pk2(bf2f(pq[e] & 0xffffu) * 0.125f, bf2f(pq[e] >> 16) * 0.125f);
      *(LAS v4u*)(QS + row * 144 + ch * 16) = o;
      *(LAS v4u*)(KS2 + row * 144 + ch * 16) = pk; }
#pragma unroll
    for (int i2 = 0; i2 < 2; ++i2) { const int c2 = tid + NTHR * i2; *(LAS v4u*)(VS2 + (c2 >> 4) * 272 + (c2 & 15) * 16) = pv[i2]; }
#pragma unroll
    for (int k = 0; k < 4; ++k) { const int c2 = t256 + 256 * k; *(LAS v4u*)(CS + (c2 >> 4) * 272 + (c2 & 15) * 16) = pc[k]; }
    if (w4 == 0) {
        const float bs = scan_sum(logsigf_(pfp), dir, lane);
        const float u = pig - bs, pm = scan_max(u, dir, lane), m_in = pmin;
        const float mt = bs + fmaxf(m_in, pm);
        bq[lane] = bs - mt; uu[lane] = u; iwv[lane] = fexp(bs + m_in - mt); emt[lane] = fexp(-mt); nin[lane] = pnin;
    }
    __syncthreads();
    int unext = unit; MC_NEXT(unext);
    if (unext < NU) MC_LOAD_A(unext);
    v4u zo[2]; f32x4 ghv[2];
    { const int c8 = 8 * (lane & 15); const bf16* zp = Z + (size_t)(row0 + 8 * wave + (lane >> 4)) * DINP + ZMO + h * 128 + c8;
      zo[0] = *(const v4u*)zp; zo[1] = *(const v4u*)(zp + (size_t)4 * DINP); ghv[0] = *(const f32x4*)(gh + h * 128 + c8); ghv[1] = *(const f32x4*)(gh + h * 128 + c8 + 4); }
#pragma unroll
    for (int k = 0; k < 2; ++k) { const int c2 = t256 + 256 * k, row = c2 >> 3, ch = c2 & 7; const v4u rq = *(LAS const v4u*)(QS + row * 144 + ch * 16); const float w = iwv[row]; v4u o;
#pragma unroll
        for (int e = 0; e < 4; ++e) o[e] = pk2(bf2f(rq[e] & 0xffffu) * w, bf2f(rq[e] >> 16) * w);
        *(LAS v4u*)(QW + row * 144 + ch * 16) = o; }
    {
      const int lrow = 16 * w4 + fr; const float bql = bq[lrow]; float rsum = 0.f;
      bf16x8 qf[2];
#pragma unroll
      for (int ks = 0; ks < 2; ++ks) qf[ks] = *(LAS const bf16x8*)(QS + lrow * 144 + (32 * ks + 8 * fq) * 2);
#pragma unroll
      for (int st = 0; st < 4; ++st) { f32x4 acc = {0.f, 0.f, 0.f, 0.f};
#pragma unroll
          for (int ks = 0; ks < 2; ++ks) { const bf16x8 kf = *(LAS const bf16x8*)(KS2 + (16 * st + fr) * 144 + (32 * ks + 8 * fq) * 2); acc = MFMA16(kf, qf[ks], acc); }
          const f32x4 us4 = *(LAS const f32x4*)(uu + 16 * st + 4 * fq); float val[4];
#pragma unroll
          for (int rg = 0; rg < 4; ++rg) { const int scol = 16 * st + 4 * fq + rg; const bool valid = dir == 0 ? (scol <= lrow) : (scol >= lrow);
              val[rg] = valid ? acc[rg] * fexp(bql + us4[rg]) : 0.f; rsum += val[rg]; }
          *(LAS v2u*)(SS + lrow * 144 + (16 * st + 4 * fq) * 2) = (v2u){pk2(val[0], val[1]), pk2(val[2], val[3])}; }
      float dq = 0.f;
#pragma unroll
      for (int k2 = 0; k2 < 2; ++k2) { const v4u rq = *(LAS const v4u*)(QS + lrow * 144 + (16 * fq + 8 * k2) * 2); const f32x4 n0 = *(LAS const f32x4*)(nin + 16 * fq + 8 * k2), n1 = *(LAS const f32x4*)(nin + 16 * fq + 8 * k2 + 4);
          dq += (bf2f(rq.x & 0xffffu) * n0.x + bf2f(rq.x >> 16) * n0.y) + (bf2f(rq.y & 0xffffu) * n0.z + bf2f(rq.y >> 16) * n0.w) + (bf2f(rq.z & 0xffffu) * n1.x + bf2f(rq.z >> 16) * n1.y) + (bf2f(rq.w & 0xffffu) * n1.z + bf2f(rq.w >> 16) * n1.w); }
      float rs = rsum + iwv[lrow] * dq;
      { const auto r1 = __builtin_amdgcn_permlane16_swap(__float_as_uint(rs), __float_as_uint(rs), false, false); rs = __uint_as_float(r1[0]) + __uint_as_float(r1[1]);
        const auto r2 = __builtin_amdgcn_permlane32_swap(__float_as_uint(rs), __float_as_uint(rs), false, false); rs = __uint_as_float(r2[0]) + __uint_as_float(r2[1]); }
      if (fq == 0) den[lrow] = rs; }
    __syncthreads();
    f32x4 acc[2][4];
#pragma unroll
    for (int et = 0; et < 2; ++et) { bf16x8 bv[2], bc[2];
#pragma unroll
        for (int ks = 0; ks < 2; ++ks) { bv[ks] = colfrag8(VS2, 32 * ks, 16 * (2 * w4 + et), 272, lane); bc[ks] = colfrag8(CS, 32 * ks, 16 * (2 * w4 + et), 272, lane); }
#pragma unroll
        for (int lt = 0; lt < 4; ++lt) { acc[et][lt] = (f32x4){0.f, 0.f, 0.f, 0.f};
#pragma unroll
            for (int ks = 0; ks < 2; ++ks) { const bf16x8 a1 = *(LAS const bf16x8*)(SS + (16 * lt + fr) * 144 + (32 * ks + 8 * fq) * 2); acc[et][lt] = MFMA16(bv[ks], a1, acc[et][lt]); }
#pragma unroll
            for (int ks = 0; ks < 2; ++ks) { const bf16x8 a2 = *(LAS const bf16x8*)(QW + (16 * lt + fr) * 144 + (32 * ks + 8 * fq) * 2); acc[et][lt] = MFMA16(bc[ks], a2, acc[et][lt]); } } }
#pragma unroll
    for (int lt = 0; lt < 4; ++lt) { const int lrow = 16 * lt + fr; const float inv = __builtin_amdgcn_rcpf(fmaxf(fabsf(den[lrow]), emt[lrow]));
#pragma unroll
        for (int et = 0; et < 2; ++et) acc[et][lt] = acc[et][lt] * inv; }
    __syncthreads();
    if (dir == 1) {
#pragma unroll
        for (int et = 0; et < 2; ++et)
#pragma unroll
            for (int lt = 0; lt < 4; ++lt) *(LAS f32x4*)(HM + (16 * lt + fr) * HMS + 16 * (2 * w4 + et) + 4 * fq) = acc[et][lt];
    }
    __syncthreads();
    if (dir == 0) {
#pragma unroll
        for (int et = 0; et < 2; ++et)
#pragma unroll
            for (int lt = 0; lt < 4; ++lt) { LAS f32x4* hp = (LAS f32x4*)(HM + (16 * lt + fr) * HMS + 16 * (2 * w4 + et) + 4 * fq); *hp = *hp + acc[et][lt]; }
    }
    __syncthreads();
    if (unext < NU) MC_LOAD_C(unext);
#pragma unroll
    for (int ps = 0; ps < 2; ++ps) { const int lrow = 8 * wave + 4 * ps + (lane >> 4), c8 = 8 * (lane & 15);
        const f32x4 va = *(LAS const f32x4*)(HM + lrow * HMS + c8), vb = *(LAS const f32x4*)(HM + lrow * HMS + c8 + 4);
        const float rstd = rsqrtf(row16_sum((va.x * va.x + va.y * va.y) + (va.z * va.z + va.w * va.w) + (vb.x * vb.x + vb.y * vb.y) + (vb.z * vb.z + vb.w * vb.w)) * (1.f / 128.f) + NORM_EPS);
        const v4u z = zo[ps]; const f32x4 ga = ghv[0] * rstd, gb = ghv[1] * rstd;
        v4u o; o.x = pk2(va.x * ga.x * sigmoid_fast(bf2f(z.x & 0xffffu)), va.y * ga.y * sigmoid_fast(bf2f(z.x >> 16))); o.y = pk2(va.z * ga.z * sigmoid_fast(bf2f(z.y & 0xffffu)), va.w * ga.w * sigmoid_fast(bf2f(z.y >> 16)));
        o.z = pk2(vb.x * gb.x * sigmoid_fast(bf2f(z.z & 0xffffu)), vb.y * gb.y * sigmoid_fast(bf2f(z.z >> 16))); o.w = pk2(vb.z * gb.z * sigmoid_fast(bf2f(z.w & 0xffffu)), vb.w * gb.w * sigmoid_fast(bf2f(z.w >> 16)));
        *(v4u*)(Y + (size_t)(row0 + lrow) * DM + 1536 + h * 128 + c8) = o; }
    unit = unext;
    }
#undef MC_DECODE
#undef MC_NEXT
#undef MC_LOAD_A
#undef MC_LOAD_C
}

#define MFMA32(a, b, c) __builtin_amdgcn_mfma_f32_32x32x16_bf16((a), (b), (c), 0, 0, 0)
typedef short v4i16_t __attribute__((ext_vector_type(4)));
__device__ __forceinline__ s16x4 tr_read(LAS const unsigned char* p) { return __builtin_bit_cast(s16x4, __builtin_amdgcn_ds_read_tr16_b64_v4i16((LAS v4i16_t*)p)); }
constexpr float ATT_THR = 8.f;
#define SCHED_FENCE() __builtin_amdgcn_sched_barrier(0)
constexpr int NO_MASK = 0x40000000;
template <int DQK, int KSB>
__device__ __forceinline__ void attn_scores(LAS const unsigned char* Kt, const bf16x8 (&qf)[DQK / 16], f32x16 (&p)[2], int r32, int hi) {
    constexpr int NK = DQK / 16;
    LAS const unsigned char* kp = Kt + r32 * KSB + hi * 16;
    f32x16 p0, p1;
#pragma unroll
    for (int e = 0; e < 16; ++e) { p0[e] = 0.f; p1[e] = 0.f; }
    bf16x8 kr[3][2];
#define QK_LOAD(ks) do { kr[(ks) % 3][0] = *(LAS const bf16x8*)(kp + (ks) * 32); kr[(ks) % 3][1] = *(LAS const bf16x8*)(kp + 32 * KSB + (ks) * 32); } while (0)
    QK_LOAD(0); QK_LOAD(1); SCHED_FENCE();
#pragma unroll
    for (int ks = 0; ks < NK; ++ks) {
        if (ks + 2 < NK) QK_LOAD(ks + 2);
        p0 = MFMA32(kr[ks % 3][0], qf[ks], p0); p1 = MFMA32(kr[ks % 3][1], qf[ks], p1); SCHED_FENCE();
    }
#undef QK_LOAD
    p[0] = p0; p[1] = p1;
}
template <int DV, bool MASK>
__device__ __forceinline__ void attn_softmax(f32x16 (&p)[2], f32x16 (&o)[DV / 32], float& m, float& l, float cs, int hi, int dq) {
    if (MASK) { if (__builtin_amdgcn_readfirstlane(dq) != NO_MASK) {
#pragma unroll
        for (int kvb = 0; kvb < 2; ++kvb)
#pragma unroll
            for (int e = 0; e < 16; ++e) { const int rel = dq + 32 * kvb + (e & 3) + 8 * (e >> 2) + 4 * hi; if (rel > 128 || rel < -128) p[kvb][e] = -INFINITY; } } }
    float mx;
    {
        float a0 = fmaxf(fmaxf(p[0][0], p[0][1]), p[0][2]), a1 = fmaxf(fmaxf(p[0][8], p[0][9]), p[0][10]), a2 = fmaxf(fmaxf(p[1][0], p[1][1]), p[1][2]), a3 = fmaxf(fmaxf(p[1][8], p[1][9]), p[1][10]);
        a0 = fmaxf(fmaxf(a0, p[0][3]), p[0][4]); a1 = fmaxf(fmaxf(a1, p[0][11]), p[0][12]); a2 = fmaxf(fmaxf(a2, p[1][3]), p[1][4]); a3 = fmaxf(fmaxf(a3, p[1][11]), p[1][12]);
        a0 = fmaxf(fmaxf(a0, p[0][5]), p[0][6]); a1 = fmaxf(fmaxf(a1, p[0][13]), p[0][14]); a2 = fmaxf(fmaxf(a2, p[1][5]), p[1][6]); a3 = fmaxf(fmaxf(a3, p[1][13]), p[1][14]);
        a0 = fmaxf(a0, p[0][7]); a1 = fmaxf(a1, p[0][15]); a2 = fmaxf(a2, p[1][7]); a3 = fmaxf(a3, p[1][15]);
        mx = fmaxf(fmaxf(a0, a1), fmaxf(a2, a3));
        const auto rr = __builtin_amdgcn_permlane32_swap(__float_as_uint(mx), __float_as_uint(mx), false, false);
        mx = fmaxf(__uint_as_float(rr[0]), __uint_as_float(rr[1])); }
    const float mn = fmaxf(m, mx * cs);
    if (__any(mn - m > ATT_THR)) {
        const float alpha = fexp2(m - mn); m = mn; l *= alpha;
#pragma unroll
        for (int d = 0; d < DV / 32; ++d)
#pragma unroll
            for (int e = 0; e < 16; ++e) o[d][e] *= alpha;
    }
    float ls0 = 0.f, ls1 = 0.f, ls2 = 0.f, ls3 = 0.f;
#pragma unroll
    for (int kvb = 0; kvb < 2; ++kvb)
#pragma unroll
        for (int e = 0; e < 16; e += 4) {
            const float e0 = fexp2(fmaf(p[kvb][e], cs, -m)), e1 = fexp2(fmaf(p[kvb][e + 1], cs, -m)), e2 = fexp2(fmaf(p[kvb][e + 2], cs, -m)), e3 = fexp2(fmaf(p[kvb][e + 3], cs, -m));
            p[kvb][e] = e0; p[kvb][e + 1] = e1; p[kvb][e + 2] = e2; p[kvb][e + 3] = e3; ls0 += e0; ls1 += e1; ls2 += e2; ls3 += e3; }
    l += (ls0 + ls1) + (ls2 + ls3);
}
template <int DV, int VRB>
__device__ __forceinline__ void attn_pv(LAS const unsigned char* Vt, const f32x16 (&p)[2], f32x16 (&o)[DV / 32], int vtb) {
    constexpr int ND = DV / 32;
    LAS const unsigned char* vb = Vt + vtb;
    bf16x8 pf[4];
#pragma unroll
    for (int i = 0; i < 4; ++i) { const int kvb = i >> 1, s = i & 1;
        v4u pw; pw.x = pk2(p[kvb][8 * s + 0], p[kvb][8 * s + 1]); pw.y = pk2(p[kvb][8 * s + 2], p[kvb][8 * s + 3]); pw.z = pk2(p[kvb][8 * s + 4], p[kvb][8 * s + 5]); pw.w = pk2(p[kvb][8 * s + 6], p[kvb][8 * s + 7]);
        pf[i] = __builtin_bit_cast(bf16x8, pw); }
    s16x4 va[2 * ND], vbq[2 * ND];
#define PV_LOAD(dst, i) do { _Pragma("unroll") for (int d = 0; d < ND; ++d) { LAS const unsigned char* vp = vb + (16 * (i)) * VRB + d * 64; dst[2 * d] = tr_read(vp); dst[2 * d + 1] = tr_read(vp + 8 * VRB); } } while (0)
#define PV_MMA(src, i) do { _Pragma("unroll") for (int d = 0; d < ND; ++d) { const bf16x8 vf = __builtin_shufflevector(src[2 * d], src[2 * d + 1], 0, 1, 2, 3, 4, 5, 6, 7); o[d] = MFMA32(vf, pf[i], o[d]); } } while (0)
    PV_LOAD(va, 0); SCHED_FENCE();
    PV_LOAD(vbq, 1); PV_MMA(va, 0); SCHED_FENCE();
    PV_LOAD(va, 2); PV_MMA(vbq, 1); SCHED_FENCE();
    PV_LOAD(vbq, 3); PV_MMA(va, 2); SCHED_FENCE();
    PV_MMA(vbq, 3); SCHED_FENCE();
#undef PV_LOAD
#undef PV_MMA
}
template <int DQK, int DV, int KSB, int VRB, bool MASK>
__device__ __forceinline__ void attn_tile(LAS const unsigned char* Kt, LAS const unsigned char* Vt, const bf16x8 (&qf)[DQK / 16], f32x16 (&o)[DV / 32], float& m, float& l, float cs, int r32, int hi, int vtb, int dq) {
    __builtin_amdgcn_sched_barrier(0);
    f32x16 p[2];
    attn_scores<DQK, KSB>(Kt, qf, p, r32, hi);
    attn_softmax<DV, MASK>(p, o, m, l, cs, hi, dq);
    attn_pv<DV, VRB>(Vt, p, o, vtb);
}
template <int DV>
__device__ __forceinline__ void attn_store(bf16* yrow  , const f32x16 (&o)[DV / 32], float l, int hi) {
    const float lt = l + __shfl_xor(l, 32), inv = 1.f / lt;
    unsigned char* yb = (unsigned char*)yrow + 16 * hi;
#pragma unroll
    for (int d = 0; d < DV / 32; ++d)
#pragma unroll
        for (int kk = 0; kk < 2; ++kk) {
            unsigned ax = pk2(o[d][8 * kk] * inv, o[d][8 * kk + 1] * inv), ay = pk2(o[d][8 * kk + 2] * inv, o[d][8 * kk + 3] * inv);
            unsigned bx = pk2(o[d][8 * kk + 4] * inv, o[d][8 * kk + 5] * inv), by = pk2(o[d][8 * kk + 6] * inv, o[d][8 * kk + 7] * inv);
            const auto rx = __builtin_amdgcn_permlane32_swap(ax, bx, false, false); const auto ry = __builtin_amdgcn_permlane32_swap(ay, by, false, false);
            *(v4u*)(yb + 64 * d + 32 * kk) = (v4u){rx[0], ry[0], rx[1], ry[1]};
        }
}
constexpr int MLA_KSB = 400, MLA_KT = 64 * MLA_KSB  , MLA_VRB = 320, MLA_VT = 64 * MLA_VRB  , MLA_BUF = MLA_KT + MLA_VT;
__device__ __forceinline__ void mla_unit(const bf16* QM, const bf16* KVM, const bf16* KR, bf16* Y, int b, int h, int qrow0, int ntiles, bool latent, LAS unsigned char* L, int tid) {
    const int wave = tid >> 6, lane = tid & 63, r32 = lane & 31, hi = lane >> 5;
    const int qrow = qrow0 + 32 * wave + r32;
    bf16x8 qf[12];
    { const bf16* qp = QM + (size_t)qrow * 768 + h * 192 + 8 * hi;
#pragma unroll
      for (int ks = 0; ks < 12; ++ks) qf[ks] = *(const bf16x8*)(qp + 16 * ks); }
    if (latent) {
        const int t = qrow - b * TB - CTX, prow = t >> 6, pcol = t & 63;
        int hl = hi; asm volatile("" : "+v"(hl));
#pragma unroll
        for (int j = 0; j < 8; ++j) { float cr, sr, cc, sc; rope_cs(prow, 8 * hl + j, cr, sr); rope_cs(pcol, 8 * hl + j, cc, sc);
            const float x1 = bf2f((unsigned short)qf[8][j]), x2 = bf2f((unsigned short)qf[9][j]), x3 = bf2f((unsigned short)qf[10][j]), x4 = bf2f((unsigned short)qf[11][j]);
            qf[8][j] = (short)(pk2(x1 * cr - x2 * sr, 0.f) & 0xffffu); qf[9][j] = (short)(pk2(x2 * cr + x1 * sr, 0.f) & 0xffffu);
            qf[10][j] = (short)(pk2(x3 * cc - x4 * sc, 0.f) & 0xffffu); qf[11][j] = (short)(pk2(x4 * cc + x3 * sc, 0.f) & 0xffffu); }
    }
    f32x16 o[4];
#pragma unroll
    for (int d = 0; d < 4; ++d)
#pragma unroll
        for (int e = 0; e < 16; ++e) o[d][e] = 0.f;
    float m = -INFINITY, l = 0.f;
    const float cs = 0.07216878364870322f * LOG2E;
    const unsigned kgo = (unsigned)(((tid >> 4) * 1024 + (tid & 15) * 8) * 2), klo = (unsigned)((tid >> 4) * MLA_KSB + (tid & 15) * 16);
    const unsigned rgo = (unsigned)(((tid >> 3) * 64 + (tid & 7) * 8) * 2), rlo = (unsigned)((tid >> 3) * MLA_KSB + 256 + (tid & 7) * 16);
    const unsigned vlo = (unsigned)((tid >> 4) * MLA_VRB + (tid & 15) * 16);
    const int vtb = (4 * hi + ((lane & 15) >> 2)) * MLA_VRB + (16 * ((lane >> 4) & 1) + 4 * (lane & 3)) * 2;
    const char* kvb0 = (const char*)(KVM + ((size_t)b * TB) * 1024 + h * 256);
    const char* krb0 = (const char*)(KR + ((size_t)b * TB) * 64);
    v4u kreg[3], vreg[2];
#define MLA_LOAD(t) do { const char* kb_ = kvb0 + (size_t)(t) * (64 * 1024 * 2); const char* rb_ = krb0 + (size_t)(t) * (64 * 64 * 2); \
        kreg[0] = *(const v4u*)(kb_ + kgo); kreg[1] = *(const v4u*)(kb_ + 32 * 1024 * 2 + kgo); kreg[2] = *(const v4u*)(rb_ + rgo); \
        vreg[0] = *(const v4u*)(kb_ + 256 + kgo); vreg[1] = *(const v4u*)(kb_ + 32 * 1024 * 2 + 256 + kgo); } while (0)
#define MLA_STORE(buf) do { LAS unsigned char* Kt_ = L + (buf) * MLA_BUF; LAS unsigned char* Vt_ = Kt_ + MLA_KT; \
        *(LAS v4u*)(Kt_ + klo) = kreg[0]; *(LAS v4u*)(Kt_ + 32 * MLA_KSB + klo) = kreg[1]; *(LAS v4u*)(Kt_ + rlo) = kreg[2]; \
        *(LAS v4u*)(Vt_ + vlo) = vreg[0]; *(LAS v4u*)(Vt_ + 32 * MLA_VRB + vlo) = vreg[1]; } while (0)
    const int half = wave >> 2;
    MLA_LOAD(0); MLA_STORE(0);
    if (ntiles > 1) { MLA_LOAD(1); MLA_STORE(1); }
    __syncthreads();
    if (half) __builtin_amdgcn_s_barrier();
    if (ntiles > 2) MLA_LOAD(2);
    int bcur = 0, bst = 2;
    for (int t = 0; t < ntiles; ++t) {
        LAS const unsigned char* Kt = L + bcur * MLA_BUF;
        f32x16 p[2];
        __builtin_amdgcn_sched_barrier(0);
        attn_scores<192, MLA_KSB>(Kt, qf, p, r32, hi);
        __syncthreads();
        attn_softmax<128, false>(p, o, m, l, cs, hi, 0);
        attn_pv<128, MLA_VRB>(Kt + MLA_KT, p, o, vtb);
        if (t + 2 < ntiles) { MLA_STORE(bst); if (t + 3 < ntiles) MLA_LOAD(t + 3); }
        __syncthreads();
        bcur = bcur == 2 ? 0 : bcur + 1; bst = bst == 2 ? 0 : bst + 1;
    }
    if (!half) __builtin_amdgcn_s_barrier();
#undef MLA_LOAD
#undef MLA_STORE
    attn_store<128>(Y + (size_t)qrow * DM + h * 128, o, l, hi);
}

constexpr int SWA_KSB = 144, SWA_KT = 64 * SWA_KSB  , SWA_VRB = 192, SWA_VT = 64 * SWA_VRB  , SWA_BUF = SWA_KT + SWA_VT;
__device__ __forceinline__ void swa_unit(const bf16* Z, const float* sink  , bf16* Y, int b, int g, int blk, int cblk, LAS unsigned char* L, int tid) {
    const int wave = tid >> 6, lane = tid & 63, r32 = lane & 31, hi = lane >> 5;
    const bool latent = blk >= 0;
    const int head = 8 * g + wave;
    const int qrow0 = b * TB + (latent ? CTX + 64 * blk : 64 * cblk);
    bf16x8 qf[2][4];
#pragma unroll
    for (int sb = 0; sb < 2; ++sb) { const bf16* qp = Z + (size_t)(qrow0 + 32 * sb + r32) * DINP + ZSQ + head * 64 + 8 * hi;
#pragma unroll
        for (int ks = 0; ks < 4; ++ks) qf[sb][ks] = *(const bf16x8*)(qp + 16 * ks); }
    f32x16 o[2][2];
#pragma unroll
    for (int sb = 0; sb < 2; ++sb)
#pragma unroll
        for (int d = 0; d < 2; ++d)
#pragma unroll
            for (int e = 0; e < 16; ++e) o[sb][d][e] = 0.f;
    const float sk = sink[head] * LOG2E;
    float m[2] = {sk, sk}, l[2] = {hi == 0 ? 1.f : 0.f, hi == 0 ? 1.f : 0.f};
    const float cs = 0.125f * LOG2E;
    int wlo = 0, nwin = 0;
    if (latent) { wlo = blk - 2 < 0 ? 0 : blk - 2; const int whi = blk + 2 > 127 ? 127 : blk + 2; nwin = whi - wlo + 1; }
    const int ntiles = 4 + nwin;
    const unsigned kgo = (unsigned)(((tid >> 3) * DINP + ZSK + (tid & 7) * 8) * 2), klo = (unsigned)((tid >> 3) * SWA_KSB + (tid & 7) * 16), vlo = (unsigned)((tid >> 3) * SWA_VRB + (tid & 7) * 16);
    const int vtb = (4 * hi + ((lane & 15) >> 2)) * SWA_VRB + (16 * ((lane >> 4) & 1) + 4 * (lane & 3)) * 2;
    const char* zb0 = (const char*)(Z + ((size_t)b * TB) * DINP + g * 64);
    v4u kreg, vreg;
#define SWA_ROW0(t) ((t) < 4 ? 64 * (t) : CTX + 64 * (wlo + (t) - 4))
#define SWA_LOAD(t) do { const char* zb_ = zb0 + (size_t)SWA_ROW0(t) * (DINP * 2); kreg = *(const v4u*)(zb_ + kgo); vreg = *(const v4u*)(zb_ + (ZSV - ZSK) * 2 + kgo); } while (0)
#define SWA_STORE(buf) do { LAS unsigned char* Kt_ = L + (buf) * SWA_BUF; *(LAS v4u*)(Kt_ + klo) = kreg; *(LAS v4u*)(Kt_ + SWA_KT + vlo) = vreg; } while (0)
    SWA_LOAD(0); SWA_STORE(0);
    __syncthreads();
    for (int t = 0; t < ntiles; ++t) {
        const bool more = t + 1 < ntiles;
        if (more) SWA_LOAD(t + 1);
        LAS const unsigned char* Kt = L + (t & 1) * SWA_BUF;
        const int kpos0 = 64 * (wlo + t - 4);
        const bool edge = t >= 4 && (wlo + t - 4 == blk - 2 || wlo + t - 4 == blk + 2);
#pragma unroll
        for (int sb = 0; sb < 2; ++sb) attn_tile<64, 64, SWA_KSB, SWA_VRB, true>(Kt, Kt + SWA_KT, qf[sb], o[sb], m[sb], l[sb], cs, r32, hi, vtb, edge ? kpos0 - (64 * blk + 32 * sb + r32) : NO_MASK);
        if (more) SWA_STORE((t + 1) & 1);
        __syncthreads();
    }
#undef SWA_ROW0
#undef SWA_LOAD
#undef SWA_STORE
#pragma unroll
    for (int sb = 0; sb < 2; ++sb) attn_store<64>(Y + (size_t)(qrow0 + 32 * sb + r32) * DM + 512 + head * 64, o[sb], l[sb], hi);
}

struct Args { const float* in[20]; float* out; unsigned char* ws; };
enum { IN_X = 0, IN_C, IN_CTX, IN_CCTX, IN_WMOD, IN_BMOD, IN_GN1, IN_GN2, IN_WIN, IN_GQ, IN_WUQ, IN_GKV, IN_WUKV, IN_SINK, IN_GBIAS, IN_GH, IN_WOUT, IN_W1, IN_W2, IN_GFINAL };

__global__ void __launch_bounds__(NTHR, 2) fwd_kernel(Args a) {
    extern __shared__ __attribute__((aligned(16))) unsigned char lds[];
    LAS unsigned char* L = (LAS unsigned char*)lds;
    const int tid0 = threadIdx.x;
    const int G = gridDim.x;
    for (int u = tid0; u < (LDS_BYTES - LDSCTL_OFF) / 4; u += NTHR) ((LAS unsigned*)(L + LDSCTL_OFF))[u] = 0u;
    __syncthreads();
    unsigned char* ws = a.ws;
    XcdBarrier bar = xcd_barrier_post((unsigned*)(ws + WS_CTL) + CW_BAR, (volatile LAS unsigned*)(L + MISC_OFF) + 8);

#define GRID_BAR(id_) do { XcdBarrier b2_ = bar; unsigned xx_ = bar.x; asm volatile("" : "+s"(xx_)); b2_.x = xx_; xcd_barrier(b2_); } while (0)
#define LAUNDER() int tid = tid0; asm volatile("" : "+v"(tid)); int wg = blockIdx.x; asm volatile("" : "+s"(wg)); const int lane = tid & 63, wave = __builtin_amdgcn_readfirstlane(tid >> 6), gw = wg * NWAVES + wave, NGW = G * NWAVES; (void)lane; (void)wave; (void)gw; (void)NGW
    float* MOD = (float*)(ws + WS_MOD);
    constexpr size_t WSET_STRIDE = WS_WSET1 - WS_WIN;
    bf16* X = (bf16*)(ws + WS_X); bf16* H = (bf16*)(ws + WS_H); float* SLAB = (float*)(ws + WS_SLAB);
    float *GATES = (float*)(ws + WS_GATES), *DN = (float*)(ws + WS_DN), *SC = (float*)(ws + WS_SC); bf16* DC = (bf16*)(ws + WS_DC);
    unsigned char* big = ws + WS_BIG;
    bf16 *Z = (bf16*)(big + BG_Z), *ZQN = (bf16*)(big + BG_ZQN), *ZKVN = (bf16*)(big + BG_ZKVN), *KR = (bf16*)(big + BG_KR), *QM = (bf16*)(big + BG_QM), *KVM = (bf16*)(big + BG_KVM), *Y = (bf16*)(big + BG_Y), *ACT = (bf16*)big;
    const ConvSrc csrc{a.in[IN_WIN], a.in[IN_WUQ], a.in[IN_WUKV], a.in[IN_WOUT], a.in[IN_W1], a.in[IN_W2]};

    unsigned long long* ROWSS = (unsigned long long*)(ws + WS_STAT); long long* BIAS = (long long*)(ws + WS_STAT + 3 * MiB);
    { LAUNDER(); for (int i = wg * NTHR + tid; i < (int)(5 * MiB / 8); i += G * NTHR) ROWSS[i] = 0ull;
      phase_mod(a.in[IN_C], a.in[IN_CCTX], a.in[IN_WMOD], a.in[IN_BMOD], MOD, L, wg, G, tid); }
    GRID_BAR(0);

    for (int l = 0; l < DEPTH; ++l) {
        const float* modl = MOD + (size_t)l * 5 * 12288;
        long long* biasl = BIAS + (size_t)l * 5 * BIASW;
        unsigned long long* rssA = ROWSS + (size_t)(2 * l) * MTOK;
        unsigned long long* rssB = ROWSS + (size_t)(2 * l + 1) * MTOK;
        const bool lastl = l == DEPTH - 1;
        unsigned char* wset = ws + (size_t)(l & 1) * WSET_STRIDE; unsigned char* wnext = ws + (size_t)((l + 1) & 1) * WSET_STRIDE;
        bf16 *WIN = (bf16*)(wset + WS_WIN), *WUQ = (bf16*)(wset + WS_WUQ), *WUKV = (bf16*)(wset + WS_WUKV), *WOUT = (bf16*)(wset + WS_WOUT), *W1 = (bf16*)(wset + WS_W1), *W2 = (bf16*)(wset + WS_W2);
        const ConvDst cdst{WIN, WUQ, WUKV, WOUT, W1, W2};
        const ConvDst cnext{(bf16*)(wnext + WS_WIN), (bf16*)(wnext + WS_WUQ), (bf16*)(wnext + WS_WUKV), (bf16*)(wnext + WS_WOUT), (bf16*)(wnext + WS_W1), (bf16*)(wnext + WS_W2)};
        const float* modn = MOD + (size_t)(l + 1) * 5 * 12288; long long* biasn = BIAS + (size_t)(l + 1) * 5 * BIASW;
        { LAUNDER(); LAS float* scr = (LAS float*)(L + wave * 8448); LAS float* tab = (LAS float*)(L + 8 * 8448);
          const bool g1tail = ((MTOK / 256) * (DINP / 256)) % G != 0, g4tail = ((MTOK / 256) * (DFF / 256)) % G != 0;
          const bool needA0 = l == 0 || !g1tail, needA1 = l == 0 || !g4tail;
          if (needA0 || needA1) { conv_load_tab(tab, modl, 3, tid);
              if (needA0) conv_A(csrc, cdst, l, 0, CV_A_SPLIT, gw, NGW, scr, tab, biasl, lane);
              if (needA1) { conv_A(csrc, cdst, l, CV_A_SPLIT, CV_I1, gw, NGW, scr, tab, biasl, lane); conv_B(csrc, cdst, l, 0, CV_B_SPLIT, gw, NGW, scr, lane); } }
          conv_B(csrc, cdst, l, CV_B_SPLIT, CV_I2, gw, NGW, scr, lane);
          conv_load_tab(tab, modl, 0, tid); conv_CD(csrc, cdst, l, gw, NGW, scr, tab, biasl, lane); __syncthreads(); }
        { LAUNDER();
          if (l == 0) phase_first(a.in[IN_X], a.in[IN_CTX], X, H, rssB, a.in[IN_GN1], modl, gw, NGW, lane);
          else phase_ctxfix(X, H, rssB, SLAB, MOD + (size_t)((l - 1) * 5 + 4) * 12288 + 5 * DM, a.in[IN_GN1] + l * DM, modl + (size_t)4 * 12288 + DM, gw, NGW, lane); }
        GRID_BAR(1);
        { LAUNDER(); pg8::Gemm g{H, WIN, MTOK, DINP, DM}; pg8::StaticOrder S; S.init(MTOK, DINP, DM, G, wg);
          pg8::EpiBf16<0, true, true> E{Z, DINP, GATES, rssB, biasl, BIASW};
          pg8::gemm_phase<pg8::EpiBf16<0, true, true>, pg8::StaticOrder, true, true>(L, g, S, E);
          constexpr int NU = (MTOK / 256) * (DINP / 256); const int rem = NU % G;
          if (!lastl && rem != 0 && wg >= rem) { LAS float* scr = (LAS float*)(L + wave * 8448); LAS float* tab = (LAS float*)(L + 8 * 8448);
              conv_load_tab(tab, modn, 3, tid); conv_A(csrc, cnext, l + 1, 0, CV_A_SPLIT, (wg - rem) * NWAVES + wave, (G - rem) * NWAVES, scr, tab, biasn, lane); __syncthreads(); } }
        GRID_BAR(2);
        { LAUNDER(); phase_e1(Z, ZQN, ZKVN, KR, a.in[IN_GQ] + l * 512, a.in[IN_GKV] + l * 256, wg, G, wave, lane); }
        { LAUNDER(); mlstm_a(Z, GATES, a.in[IN_GBIAS] + l * 16, DC, DN, SC, L, wg, G, tid); }
        GRID_BAR(3);
        { LAUNDER(); mlstm_scan(DC, DN, SC, wg, G, tid); }
        __syncthreads();
        { LAUNDER(); pg8::Gemm g{ZQN, WUQ, MTOK, 768, 512}; pg8::StaticOrder S; S.init(MTOK, 768, 512, G, wg);
          pg8::EpiBf16<0, false, false> E{QM, 768, nullptr, nullptr, nullptr, 0};
          pg8::gemm_phase<pg8::EpiBf16<0, false, false>, pg8::StaticOrder, true, true>(L, g, S, E); }
        { LAUNDER(); pg8::Gemm g{ZKVN, WUKV, MTOK, 1024, 256}; pg8::StaticOrder S; S.init(MTOK, 1024, 256, G, (wg + 116) % G);
          pg8::EpiBf16<0, false, false> E{KVM, 1024, nullptr, nullptr, nullptr, 0};
          pg8::gemm_phase<pg8::EpiBf16<0, false, false>, pg8::StaticOrder, true, true>(L, g, S, E); }
        GRID_BAR(4);
#ifndef ATT_SWAP_MASK
#define ATT_SWAP_MASK 4
#endif
        for (int stage = 0; stage < 2; ++stage) {
        bool mla_now; { int wgs = blockIdx.x; asm volatile("" : "+s"(wgs)); mla_now = (stage == 0) != ((wgs & ATT_SWAP_MASK) != 0); }
        if (mla_now) { LAUNDER();
          const int n_mla = lastl ? 512 : 512 + 16;
          for (int u = wg; u < n_mla; u += G) {
            if (u < 512) { const int pair = 2 * (u & 7) + (u >> 8), qb = (u >> 3) & 31, b = pair >> 2, h = pair & 3; mla_unit(QM, KVM, KR, Y, b, h, b * TB + CTX + 256 * qb, 132, true, L, tid); }
            else { const int i = u - 512, b = i >> 2, h = i & 3; mla_unit(QM, KVM, KR, Y, b, h, b * TB, 4, false, L, tid); }
          } }
        else {
        { LAUNDER();
          const int n_swa = lastl ? 1024 : 1024 + 32;
          for (int u = (wg + 64) % G; u < n_swa; u += G) {
            if (u < 1024) swa_unit(Z, a.in[IN_SINK] + l * 16, Y, u >> 8, (u >> 7) & 1, u & 127, 0, L, tid);
            else { const int i = u - 1024; swa_unit(Z, a.in[IN_SINK] + l * 16, Y, i >> 3, (i >> 2) & 1, -1, i & 3, L, tid); }
          } }
        { LAUNDER();
          mlstm_c_phase((wg + 128) % G, G, lastl, Z, GATES, a.in[IN_GBIAS] + l * 16, a.in[IN_GH] + l * 512, DC, DN, SC, Y, L, tid); }
        }
        __syncthreads();
        }
        GRID_BAR(5);
        { LAUNDER(); pg8::Gemm g{Y, WOUT, MTOK, DM, DM}; pg8::LatentOrder S; S.init(DM, DM, G, wg, lastl ? 0 : 2);
          pg8::EpiResid E{X, modl, 2 * DM, SLAB, DM / 64, H, a.in[IN_GN2] + l * DM, modl + 4 * DM, rssA};
          pg8::gemm_phase<pg8::EpiResid, pg8::LatentOrder, true, true>(L, g, S, E); }
        GRID_BAR(6);
        if (!lastl) {
            { LAUNDER(); phase_ctxfix(X, H, rssA, SLAB, modl + (size_t)4 * 12288 + 2 * DM, a.in[IN_GN2] + l * DM, modl + (size_t)4 * 12288 + 4 * DM, gw, NGW, lane); }
            GRID_BAR(7);
        }
        { LAUNDER(); pg8::Gemm g{H, W1, MTOK, DFF, DM}; pg8::LatentOrder S; S.init(DFF, DM, G, wg, lastl ? 0 : 1);
          pg8::EpiBf16<2, false, true> E{ACT, DFF, nullptr, rssA, biasl + DINP, BIASW};
          pg8::gemm_phase<pg8::EpiBf16<2, false, true>, pg8::LatentOrder, true, true>(L, g, S, E);
          constexpr int NU = (MTOK / 256) * (DFF / 256); const int rem = NU % G;
          if (!lastl && rem != 0 && wg >= rem) { LAS float* scr = (LAS float*)(L + wave * 8448); LAS float* tab = (LAS float*)(L + 8 * 8448); const int worker = (wg - rem) * NWAVES + wave, nworkers = (G - rem) * NWAVES;
              conv_load_tab(tab, modn, 3, tid); conv_A(csrc, cnext, l + 1, CV_A_SPLIT, CV_I1, worker, nworkers, scr, tab, biasn, lane); conv_B(csrc, cnext, l + 1, 0, CV_B_SPLIT, worker, nworkers, scr, lane); __syncthreads(); } }
        GRID_BAR(8);
        { LAUNDER(); pg8::Gemm g{ACT, W2, MTOK, DM, DFF}; pg8::LatentOrder S; S.init(DM, DFF, G, wg, lastl ? 0 : 2);
          pg8::EpiResid E{X, modl, 5 * DM, SLAB, DFF / 64, lastl ? nullptr : H, a.in[IN_GN1] + (l + 1) * DM, MOD + (size_t)(l + 1) * 5 * 12288 + DM, ROWSS + (size_t)(2 * l + 3) * MTOK};
          pg8::gemm_phase<pg8::EpiResid, pg8::LatentOrder, true, true>(L, g, S, E); }
        GRID_BAR(9);
    }
    { LAUNDER(); phase_final(X, a.out, a.in[IN_GFINAL], gw, NGW, lane); }
}

extern "C" void kernel_launch(void* const* d_in, const int* in_sizes, int n_in, void* d_out, int out_size, void* d_ws, size_t ws_size, hipStream_t stream) {
    static int grid = 0;
    if (grid == 0) {
        if (n_in != 20 || in_sizes[0] != NB * SEQ * DM || out_size != NB * SEQ * DM || ws_size < WS_END) {
            fprintf(stderr, "kernel_launch: unexpected shapes (n_in %d, in0 %d, out %d, ws %zu, need %zu); nothing launched\n", n_in, n_in > 0 ? in_sizes[0] : -1, out_size, ws_size, (size_t)WS_END); grid = -1; return; }
        int dev = 0, cus = 0, per_cu = 0;
        if (hipGetDevice(&dev) != hipSuccess || hipDeviceGetAttribute(&cus, hipDeviceAttributeMultiprocessorCount, dev) != hipSuccess) { fprintf(stderr, "kernel_launch: device query failed\n"); grid = -1; return; }
        if (hipFuncSetAttribute((const void*)fwd_kernel, hipFuncAttributeMaxDynamicSharedMemorySize, LDS_BYTES) != hipSuccess) { fprintf(stderr, "kernel_launch: hipFuncSetAttribute failed\n"); grid = -1; return; }
        if (hipOccupancyMaxActiveBlocksPerMultiprocessor(&per_cu, (const void*)fwd_kernel, NTHR, LDS_BYTES) != hipSuccess || per_cu < 1)
            fprintf(stderr, "kernel_launch: note: occupancy query reports %d workgroups per CU\n", per_cu);
        (void)hipGetLastError();
        grid = cus;
    }
    if (grid < 0) return;
    if (hipMemsetAsync((char*)d_ws + WS_CTL, 0, CTL_ZERO_BYTES, stream) != hipSuccess) { fprintf(stderr, "kernel_launch: memset failed\n"); return; }
    Args a{};
    for (int i = 0; i < 20; ++i) a.in[i] = (const float*)d_in[i];
    a.out = (float*)d_out; a.ws = (unsigned char*)d_ws;
    hipLaunchKernelGGL(fwd_kernel, dim3(grid), dim3(NTHR), LDS_BYTES, stream, a);
    const hipError_t le = hipPeekAtLastError();
    if (le != hipSuccess) fprintf(stderr, "kernel_launch: launch failed: %s\n", hipGetErrorName(le));
}
```

```cpp
#include <hip/hip_runtime.h>
#include <cstdio>
#include <cstdint>
#include <cmath>


namespace pg8 {
#define PG8_LAS __attribute__((address_space(3)))
typedef unsigned short bf16_t;
typedef short bf16x8 __attribute__((ext_vector_type(8)));
typedef float f32x4 __attribute__((ext_vector_type(4)));
typedef unsigned u32x4 __attribute__((ext_vector_type(4)));
constexpr int BM = 256, BK = 64, HALF = 128, HTB = HALF * BK * 2  , STAGE_BYTES = 8 * HTB, NXCD = 8, WGM = 8;

__host__ __device__ __forceinline__ int lds_byte(int r, int c) { const int st = (r >> 4) * 2 + (c >> 5), rr = r & 15, cc = c & 31, ob = rr * 64 + cc * 2; return st * 1024 + (ob ^ (((ob >> 9) & 1) << 5)); }
__host__ __device__ __forceinline__ void stage_rc(int b, int& R, int& C) { const int st = b / 1024, sb = b % 1024, swz = sb ^ (((sb >> 9) & 1) << 5); R = (st >> 1) * 16 + swz / 64; C = (st & 1) * 32 + (swz % 64) / 2; }
__host__ __device__ __forceinline__ int perm32(int rho) { const int n = rho >> 4, i = rho & 15; return 8 * (i >> 2) + 4 * n + (i & 3); }

struct Unit { int pm, pn, k0, nt; };
struct Gemm { const bf16_t* A; const bf16_t* Bt; int M, N, K; };

struct StaticOrder {
    int nM, nN, nwg, G, c, fullnt;
    __host__ __device__ void init(int M, int N, int K, int G_, int c_) { nM = M / BM; nN = N / BM; nwg = nM * nN; G = G_; c = c_; fullnt = K / BK; }
    __host__ __device__ bool next(int i, Unit& u) const {
        const long L = (long)i * G + c; if (L >= nwg) return false;
        int wgid = (int)L; { const int q = nwg / NXCD, r = nwg % NXCD, xcd = wgid % NXCD, off = wgid / NXCD; wgid = (xcd < r ? xcd * (q + 1) : r * (q + 1) + (xcd - r) * q) + off; }
        const int nig = WGM * nN, gid = wgid / nig, fm = gid * WGM, gsz = (nM - fm) < WGM ? (nM - fm) : WGM;
        u.pm = fm + ((wgid % nig) % gsz); u.pn = (wgid % nig) / gsz; u.k0 = 0; u.nt = fullnt; return true;
    }
    __device__ __forceinline__ void a_ready(const Unit&) const {}
    __device__ __forceinline__ void done(const Unit&) const {}
};

struct LatentOrder {
    StaticOrder so; int nN, mode;
    __host__ __device__ void init(int N, int K, int G_, int c_, int mode_) { so.init(128 * BM, N, K, G_, c_); nN = N / BM; mode = mode_; }
    __host__ __device__ bool next(int i, Unit& u) const {
        if (so.next(i, u)) { u.pm = u.pm + u.pm / 32 + 1; return true; }
        const long L = (long)i * so.G + so.c - so.nwg;
        if (mode == 1) { if (L >= 4 * nN) return false; u.pm = 33 * (int)(L / nN); u.pn = (int)(L % nN); u.k0 = 0; u.nt = so.fullnt; return true; }
        if (mode == 2) { if (L >= 32 * nN) return false; const int tile = (int)(L >> 3), ks = (int)(L & 7); u.pm = 33 * (tile / nN); u.pn = tile % nN; u.nt = so.fullnt >> 3; u.k0 = ks * u.nt; return true; }
        return false;
    }
    __device__ __forceinline__ void a_ready(const Unit&) const {}
    __device__ __forceinline__ void done(const Unit&) const {}
};

__device__ __forceinline__ unsigned cvt_pk_bf16(float lo, float hi) { unsigned r; asm volatile("v_cvt_pk_bf16_f32 %0, %1, %2" : "=v"(r) : "v"(lo), "v"(hi)); return r; }
typedef float f32x2 __attribute__((ext_vector_type(2)));

typedef float f32x2v __attribute__((ext_vector_type(2))); typedef __bf16 bf16x2v __attribute__((ext_vector_type(2)));
__device__ __forceinline__ unsigned pkbf(float lo, float hi) { f32x2v v = {lo, hi}; bf16x2v b = __builtin_convertvector(v, bf16x2v); return __builtin_bit_cast(unsigned, b); }

template <int ACT, bool GATES, bool NORMED, int NW = 2048, bool BIASED = true> struct EpiBf16 {
    static constexpr bool PERM = true, AFTER_DRAIN = false;
    bf16_t* O; int ldc; float* gates; const unsigned long long* rowss; const long long* bias; int ldb; unsigned long long* rs2 = nullptr; int rs2_stride = 0;
    __device__ __forceinline__ void operator()(const f32x4 (&acc)[2][2][4][2], const Unit& u, int wr, int wc, int fr, int fq) const {
        const int row0 = u.pm * BM + wr * 64 + fr; const int col0 = u.pn * BM + wc * 32 + 8 * fq;
        f32x4 bv[2][2]; float tots[4];
        if (NORMED && BIASED) { const int bb = u.pm / 33, bp = (u.pm - bb * 33 == 0) ? 4 : bb; const long long* bptr = bias + (size_t)bp * ldb + col0;
#pragma unroll
            for (int bj = 0; bj < 2; ++bj)
#pragma unroll
                for (int n = 0; n < 2; ++n)
#pragma unroll
                    for (int e = 0; e < 4; ++e) bv[bj][n][e] = (float)bptr[bj * HALF + 4 * n + e] * 2.3283064365386963e-10f; }
#pragma unroll
        for (int ai = 0; ai < 2; ++ai)
#pragma unroll
            for (int m = 0; m < 4; ++m) { const int row = row0 + ai * HALF + m * 16; bf16_t* rowp = O + (size_t)row * ldc + col0;
                float rstd = 1.f; if (NORMED) rstd = __builtin_amdgcn_rsqf((float)rowss[row] * (1.f / (float)NW / 16777216.f) + 1e-6f);
                float ssq = 0.f;
#pragma unroll
                for (int bj = 0; bj < 2; ++bj) { f32x4 v0 = acc[ai][bj][m][0], v1 = acc[ai][bj][m][1];
                    if (NORMED) { if (BIASED) { v0 = v0 * rstd + bv[bj][0]; v1 = v1 * rstd + bv[bj][1]; } else { v0 = v0 * rstd; v1 = v1 * rstd; } }
                    if (GATES) ssq += ((v0[0] * v0[0] + v0[1] * v0[1]) + (v0[2] * v0[2] + v0[3] * v0[3])) + ((v1[0] * v1[0] + v1[1] * v1[1]) + (v1[2] * v1[2] + v1[3] * v1[3]));
                    if (GATES) { if (bj == 0 && u.pn == 12 && wc == 2 && fq < 2) { float* gp = gates + (size_t)row * 16 + 8 * fq; *(f32x4*)gp = v0; *(f32x4*)(gp + 4) = v1; } }
                    if (ACT == 2) {
#pragma unroll
                        for (int e = 0; e < 4; ++e) { float a = v0[e] > 0.f ? v0[e] : 0.f; v0[e] = a * a; float b = v1[e] > 0.f ? v1[e] : 0.f; v1[e] = b * b; } }
                    u32x4 w; w.x = pkbf(v0[0], v0[1]); w.y = pkbf(v0[2], v0[3]); w.z = pkbf(v1[0], v1[1]); w.w = pkbf(v1[2], v1[3]);
                    *(u32x4*)(rowp + bj * HALF) = w; }
                if (GATES) { if (u.pn < 3) {
                    const auto r1 = __builtin_amdgcn_permlane16_swap(__float_as_uint(ssq), __float_as_uint(ssq), false, false); ssq = __uint_as_float(r1[0]) + __uint_as_float(r1[1]);
                    const auto r2 = __builtin_amdgcn_permlane32_swap(__float_as_uint(ssq), __float_as_uint(ssq), false, false); tots[m] = __uint_as_float(r2[0]) + __uint_as_float(r2[1]);
                    if (m == 3) { const float mine = fq == 0 ? tots[0] : fq == 1 ? tots[1] : fq == 2 ? tots[2] : tots[3];
                        atomicAdd(rs2 + (size_t)(u.pn == 2 ? rs2_stride : 0) + (u.pm * BM + ai * HALF + wr * 64 + fq * 16 + fr), (unsigned long long)(mine * 16777216.f)); } } } }
    }
};
struct EpiResid {
    static constexpr bool PERM = false, AFTER_DRAIN = false;
    bf16_t* X; const float* modl; int goff; float* slab; int fullnt;
    bf16_t* hx; const float* ng; const float* nsc; unsigned long long* rowss;
    __device__ __forceinline__ void operator()(const f32x4 (&acc)[2][2][4][2], const Unit& u, int wr, int wc, int fr, int fq) const {
        const int bb = u.pm / 33, bp = (u.pm - bb * 33 == 0) ? 4 : bb;
        const int col0 = u.pn * BM + wc * 32 + 4 * fq;
        if (u.nt != fullnt) {
            float* sp0 = slab + ((size_t)(u.k0 / u.nt) * 1024 + bb * 256 + wr * 64 + fr) * 2048 + col0;
#pragma unroll
            for (int ai = 0; ai < 2; ++ai)
#pragma unroll
                for (int m = 0; m < 4; ++m) { float* sp = sp0 + (size_t)(ai * HALF + m * 16) * 2048;
#pragma unroll
                    for (int bj = 0; bj < 2; ++bj)
#pragma unroll
                        for (int n = 0; n < 2; ++n) *(f32x4*)(sp + bj * HALF + n * 16) = acc[ai][bj][m][n]; }
            return;
        }
        const float* gate = modl + (size_t)bp * 12288 + goff;
        f32x4 gv[2][2], gm[2][2];
#pragma unroll
        for (int bj = 0; bj < 2; ++bj)
#pragma unroll
            for (int n = 0; n < 2; ++n) { gv[bj][n] = *(const f32x4*)(gate + col0 + bj * HALF + n * 16);
                if (hx) { const f32x4 g4 = *(const f32x4*)(ng + col0 + bj * HALF + n * 16), s4 = *(const f32x4*)(nsc + (size_t)bp * 12288 + col0 + bj * HALF + n * 16); gm[bj][n] = g4 * (s4 + 1.f); } }
        const int hc = u.pn * BM + wc * 32 + ((fq & 1) ? 16 + 4 * (fq - 1) : 4 * fq);
        u32x4 xr[4][2]; float tots[4];
#define ER_LOAD(g) do { const bf16_t* xp_ = X + (size_t)(u.pm * BM + ((g) >> 2) * HALF + wr * 64 + ((g) & 3) * 16 + fr) * 2048 + hc; \
        _Pragma("unroll") for (int bj = 0; bj < 2; ++bj) xr[(g) & 3][bj] = *(const u32x4*)(xp_ + bj * HALF); } while (0)
        ER_LOAD(0); ER_LOAD(1); ER_LOAD(2); ER_LOAD(3);
        asm volatile("" ::: "memory");
#pragma unroll
        for (int g = 0; g < 8; ++g) { const int ai = g >> 2, m = g & 3; const int row = u.pm * BM + ai * HALF + wr * 64 + m * 16 + fr; float ss = 0.f;
#pragma unroll
            for (int bj = 0; bj < 2; ++bj) { const u32x4 raw = xr[g & 3][bj];
                const auto lx = __builtin_amdgcn_permlane16_swap(raw[0], raw[2], false, false); const auto ly = __builtin_amdgcn_permlane16_swap(raw[1], raw[3], false, false);
                unsigned xw[2][2], hw[2][2];
#pragma unroll
                for (int n = 0; n < 2; ++n) { const unsigned wx = lx[n], wy = ly[n];
                    f32x4 xv = {__uint_as_float(wx << 16), __uint_as_float(wx & 0xffff0000u), __uint_as_float(wy << 16), __uint_as_float(wy & 0xffff0000u)};
                    xv = xv + gv[bj][n] * acc[ai][bj][m][n]; xw[n][0] = pkbf(xv[0], xv[1]); xw[n][1] = pkbf(xv[2], xv[3]);
                    if (hx) { ss += (xv[0] * xv[0] + xv[1] * xv[1]) + (xv[2] * xv[2] + xv[3] * xv[3]); const f32x4 hv = xv * gm[bj][n]; hw[n][0] = pkbf(hv[0], hv[1]); hw[n][1] = pkbf(hv[2], hv[3]); } }
                { const auto sx = __builtin_amdgcn_permlane16_swap(xw[0][0], xw[1][0], false, false); const auto sy = __builtin_amdgcn_permlane16_swap(xw[0][1], xw[1][1], false, false);
                  *(u32x4*)(X + (size_t)row * 2048 + bj * HALF + hc) = (u32x4){sx[0], sy[0], sx[1], sy[1]}; }
                if (hx) { const auto rx = __builtin_amdgcn_permlane16_swap(hw[0][0], hw[1][0], false, false); const auto ry = __builtin_amdgcn_permlane16_swap(hw[0][1], hw[1][1], false, false);
                    *(u32x4*)(hx + (size_t)row * 2048 + bj * HALF + hc) = (u32x4){rx[0], ry[0], rx[1], ry[1]}; } }
            if (hx) {
                const auto r1 = __builtin_amdgcn_permlane16_swap(__float_as_uint(ss), __float_as_uint(ss), false, false); ss = __uint_as_float(r1[0]) + __uint_as_float(r1[1]);
                const auto r2 = __builtin_amdgcn_permlane32_swap(__float_as_uint(ss), __float_as_uint(ss), false, false); tots[m] = __uint_as_float(r2[0]) + __uint_as_float(r2[1]);
                if (m == 3) { const float mine = fq == 0 ? tots[0] : fq == 1 ? tots[1] : fq == 2 ? tots[2] : tots[3];
                    atomicAdd(rowss + (u.pm * BM + ai * HALF + wr * 64 + fq * 16 + fr), (unsigned long long)(mine * 16777216.f)); } }
            asm volatile("" ::: "memory");
            if (g + 4 < 8) { ER_LOAD(g + 4); asm volatile("" ::: "memory"); } }
#undef ER_LOAD
    }
};

template <class Epi, class Sched, bool ALIGN_EPI = false, bool SP2 = false, int LDA = 0>
__device__ __forceinline__ void gemm_phase(PG8_LAS unsigned char* lds, const Gemm g, const Sched& S, const Epi& E) {
    int tid_l = threadIdx.x; asm volatile("" : "+v"(tid_l));
    const int tid = tid_l, wid = __builtin_amdgcn_readfirstlane(tid >> 6), lane = tid & 63, wr = wid >> 2, wc = wid & 3, fr = lane & 15, fq = lane >> 4;
    const int K = g.K; const int lda = LDA ? LDA : K;
    unsigned voffA[2], voffB[2];
#pragma unroll
    for (int i = 0; i < 2; ++i) { int R, C; stage_rc(tid * 16 + i * 8192, R, C); const int Rb = Epi::PERM ? ((R & ~31) + perm32(R & 31)) : R;
        voffA[i] = (unsigned)(R * lda + C) * 2u; voffB[i] = (unsigned)(Rb * K + C) * 2u; }
    const size_t kstep = (size_t)(BK * 2);
    const size_t hstep = (size_t)HALF * K * 2;
    const size_t tstep = 2 * hstep;
    const size_t hstepA = LDA ? (size_t)HALF * LDA * 2 : hstep, tstepA = 2 * hstepA;
    const unsigned ldsw = (unsigned)wid * 1024u;
    const int aoff = lds_byte(wr * 64 + fr, fq * 8), boff = lds_byte(wc * 32 + fr, fq * 8);
#define PG8_SA(b, h) (((b) * 2 + (h)) * HTB)
#define PG8_SB(b, h) ((4 + (b) * 2 + (h)) * HTB)
#define PG8_STAGE(bufoff, gbase, voff) do { _Pragma("unroll") for (int _i = 0; _i < 2; ++_i) \
        __builtin_amdgcn_global_load_lds((const unsigned*)((const char*)(gbase) + (voff)[_i]), (PG8_LAS unsigned*)(lds + (bufoff) + ldsw + _i * 8192), 16, 0, 0); } while (0)
#define PG8_LDA(dst, b, h) do { _Pragma("unroll") for (int m = 0; m < 4; ++m) _Pragma("unroll") for (int k = 0; k < 2; ++k) dst[m][k] = *(const PG8_LAS bf16x8*)(lds + PG8_SA(b, h) + aoff + m * 2048 + k * 1024); } while (0)
#define PG8_LDB(dst, b, h) do { _Pragma("unroll") for (int n = 0; n < 2; ++n) _Pragma("unroll") for (int k = 0; k < 2; ++k) dst[n][k] = *(const PG8_LAS bf16x8*)(lds + PG8_SB(b, h) + boff + n * 2048 + k * 1024); } while (0)
#define PG8_MMA(ai, bj, At, Bt) do { __builtin_amdgcn_s_setprio(1); _Pragma("unroll") for (int m = 0; m < 4; ++m) _Pragma("unroll") for (int n = 0; n < 2; ++n) _Pragma("unroll") for (int k = 0; k < 2; ++k) \
        acc[ai][bj][m][n] = __builtin_amdgcn_mfma_f32_16x16x32_bf16(Bt[n][k], At[m][k], acc[ai][bj][m][n], 0, 0, 0); __builtin_amdgcn_s_setprio(0); } while (0)
#define PG8_WAIT_V(n) asm volatile("s_waitcnt vmcnt(" #n ")" ::: "memory")
#define PG8_WAIT_L(n) asm volatile("s_waitcnt lgkmcnt(" #n ")" ::: "memory")
#define PG8_BAR __builtin_amdgcn_s_barrier()
#define PG8_SCHED __builtin_amdgcn_sched_barrier(0)
    Unit cur, nxt; int ui = 0;
    if (!S.next(0, cur)) return;
    f32x4 acc[2][2][4][2];
#pragma unroll
    for (int a = 0; a < 2; ++a)
#pragma unroll
        for (int b = 0; b < 2; ++b)
#pragma unroll
            for (int m = 0; m < 4; ++m)
#pragma unroll
                for (int n = 0; n < 2; ++n) acc[a][b][m][n] = (f32x4){0.f, 0.f, 0.f, 0.f};
    bf16x8 At[4][2], B0[2][2], B1[2][2];
    int nt = cur.nt;
    const char* cA = (const char*)g.A + (size_t)cur.pm * tstepA + (size_t)cur.k0 * kstep; const char* cB = (const char*)g.Bt + (size_t)cur.pn * tstep + (size_t)cur.k0 * kstep;
    S.a_ready(cur);
    if constexpr (SP2) {
        PG8_STAGE(PG8_SB(0, 0), cB, voffB); PG8_STAGE(PG8_SB(0, 1), cB + hstep, voffB); PG8_STAGE(PG8_SA(0, 0), cA, voffA); PG8_STAGE(PG8_SA(0, 1), cA + hstepA, voffA);
        if (wr == 1) PG8_BAR;
        PG8_WAIT_V(2); PG8_BAR;
        PG8_STAGE(PG8_SB(1, 0), cB + kstep, voffB); PG8_STAGE(PG8_SA(1, 0), cA + kstep, voffA); PG8_STAGE(PG8_SB(1, 1), cB + hstep + kstep, voffB);
        PG8_WAIT_V(6); PG8_BAR;
    } else {
        PG8_STAGE(PG8_SB(0, 0), cB, voffB); PG8_STAGE(PG8_SA(0, 0), cA, voffA); PG8_STAGE(PG8_SB(0, 1), cB + hstep, voffB); PG8_STAGE(PG8_SA(0, 1), cA + hstepA, voffA);
        if (wr == 1) PG8_BAR;
        PG8_WAIT_V(4); PG8_BAR;
        PG8_STAGE(PG8_SB(1, 0), cB + kstep, voffB); PG8_STAGE(PG8_SA(1, 0), cA + kstep, voffA); PG8_STAGE(PG8_SB(1, 1), cB + hstep + kstep, voffB);
        PG8_WAIT_V(6); PG8_BAR;
    }
    for (;;) {
        const bool has_next = S.next(ui + 1, nxt);
        const char* nA = has_next ? (const char*)g.A + (size_t)nxt.pm * tstepA + (size_t)nxt.k0 * kstep : cA; const char* nB = has_next ? (const char*)g.Bt + (size_t)nxt.pn * tstep + (size_t)nxt.k0 * kstep : cB;
        for (int t = 0; t < nt; t += 2) {
            const bool last = (t == nt - 2);
            const char* a1 = cA + (size_t)(t + 1) * kstep;
            const char* a2 = last ? nA : cA + (size_t)(t + 2) * kstep; const char* b2 = last ? nB : cB + (size_t)(t + 2) * kstep;
            const char* a3 = a2 + kstep; const char* b3 = b2 + kstep;
            if (last && has_next) S.a_ready(nxt);
            if constexpr (SP2) {
            PG8_LDB(B0, 0, 0); PG8_LDB(B1, 0, 1); PG8_SCHED; PG8_LDA(At, 0, 0); PG8_STAGE(PG8_SA(1, 1), a1 + hstepA, voffA);
            PG8_WAIT_V(8); PG8_WAIT_L(0); PG8_BAR; PG8_MMA(0, 0, At, B0); PG8_MMA(0, 1, At, B1); PG8_BAR; PG8_SCHED;
            PG8_LDA(At, 0, 1); PG8_STAGE(PG8_SB(0, 0), b2, voffB); PG8_STAGE(PG8_SB(0, 1), b2 + hstep, voffB); PG8_STAGE(PG8_SA(0, 0), a2, voffA);
            PG8_WAIT_V(8); PG8_WAIT_L(0); PG8_BAR; PG8_MMA(1, 0, At, B0); PG8_MMA(1, 1, At, B1); PG8_BAR; PG8_SCHED;
            PG8_LDB(B0, 1, 0); PG8_LDB(B1, 1, 1); PG8_SCHED; PG8_LDA(At, 1, 0); PG8_STAGE(PG8_SA(0, 1), a2 + hstepA, voffA);
            PG8_WAIT_V(8); PG8_WAIT_L(0); PG8_BAR; PG8_MMA(0, 0, At, B0); PG8_MMA(0, 1, At, B1); PG8_BAR; PG8_SCHED;
            PG8_LDA(At, 1, 1); PG8_STAGE(PG8_SB(1, 0), b3, voffB); PG8_STAGE(PG8_SB(1, 1), b3 + hstep, voffB); PG8_STAGE(PG8_SA(1, 0), a3, voffA);
            PG8_WAIT_V(8); PG8_WAIT_L(0); PG8_BAR; PG8_MMA(1, 0, At, B0); PG8_MMA(1, 1, At, B1); PG8_BAR; PG8_SCHED;
            } else {
            PG8_LDB(B0, 0, 0); PG8_SCHED; PG8_LDA(At, 0, 0); PG8_STAGE(PG8_SA(1, 1), a1 + hstepA, voffA);
            PG8_WAIT_L(8); PG8_BAR; PG8_WAIT_L(0); PG8_MMA(0, 0, At, B0); PG8_BAR; PG8_SCHED;
            PG8_LDB(B1, 0, 1); PG8_STAGE(PG8_SB(0, 0), b2, voffB);
            PG8_BAR; PG8_WAIT_L(0); PG8_MMA(0, 1, At, B1); PG8_BAR;
            PG8_LDA(At, 0, 1); PG8_STAGE(PG8_SA(0, 0), a2, voffA);
            PG8_BAR; PG8_WAIT_L(0); PG8_MMA(1, 0, At, B0); PG8_BAR; PG8_SCHED;
            PG8_STAGE(PG8_SB(0, 1), b2 + hstep, voffB);
            PG8_WAIT_V(6); PG8_BAR; PG8_MMA(1, 1, At, B1); PG8_BAR;
            PG8_LDB(B0, 1, 0); PG8_SCHED; PG8_LDA(At, 1, 0); PG8_STAGE(PG8_SA(0, 1), a2 + hstepA, voffA);
            PG8_WAIT_L(8); PG8_BAR; PG8_WAIT_L(0); PG8_MMA(0, 0, At, B0); PG8_BAR; PG8_SCHED;
            PG8_LDB(B1, 1, 1); PG8_STAGE(PG8_SB(1, 0), b3, voffB);
            PG8_BAR; PG8_WAIT_L(0); PG8_MMA(0, 1, At, B1); PG8_BAR;
            PG8_LDA(At, 1, 1); PG8_STAGE(PG8_SA(1, 0), a3, voffA);
            PG8_BAR; PG8_WAIT_L(0); PG8_MMA(1, 0, At, B0); PG8_BAR; PG8_SCHED;
            PG8_STAGE(PG8_SB(1, 1), b3 + hstep, voffB);
            PG8_WAIT_V(6); PG8_BAR; PG8_MMA(1, 1, At, B1); PG8_BAR;
            }
        }
        if constexpr (ALIGN_EPI) { if (wr == 0) PG8_BAR; }
        if constexpr (!Epi::AFTER_DRAIN) { E(acc, cur, wr, wc, fr, fq); S.done(cur); }
        if (!has_next) break;
#pragma unroll
        for (int a = 0; a < 2; ++a)
#pragma unroll
            for (int b = 0; b < 2; ++b)
#pragma unroll
                for (int m = 0; m < 4; ++m)
#pragma unroll
                    for (int n = 0; n < 2; ++n) acc[a][b][m][n] = (f32x4){0.f, 0.f, 0.f, 0.f};
        cur = nxt; cA = nA; cB = nB; nt = cur.nt; ++ui;
        if constexpr (ALIGN_EPI) { if (wr == 1) PG8_BAR; }
    }
    PG8_WAIT_V(0);
    if constexpr (!ALIGN_EPI) { if (wr == 0) PG8_BAR; }
    PG8_BAR;
    if constexpr (Epi::AFTER_DRAIN) { E.fused(acc, cur, wr, wc, fr, fq, lds, wid, lane); S.done(cur); }
#undef PG8_SA
#undef PG8_SB
#undef PG8_STAGE
#undef PG8_LDA
#undef PG8_LDB
#undef PG8_MMA
#undef PG8_WAIT_V
#undef PG8_WAIT_L
#undef PG8_BAR
#undef PG8_SCHED
}
}
#define LAS __attribute__((address_space(3)))
typedef __attribute__((address_space(1))) unsigned gu32;
#define XB_TMO      128
#define XB_XCNT(j)  (256  + 64 * (j))
#define XB_XSUB(j)  (1280 + 64 * (j))
#define XB_XGEN(j)  (2304 + 64 * (j))
#define XB_TOP      3328
#define XB_TOPGEN   3392
#define XCD_BAR_WORDS 3456
#define XB_SPIN_CAP (1u << 18)

__device__ __forceinline__ unsigned xb_ld(unsigned* p)              { return __hip_atomic_load(p, __ATOMIC_RELAXED, __HIP_MEMORY_SCOPE_AGENT); }
__device__ __forceinline__ unsigned xb_add(unsigned* p, unsigned v) { return __hip_atomic_fetch_add(p, v, __ATOMIC_RELAXED, __HIP_MEMORY_SCOPE_AGENT); }
__device__ __forceinline__ unsigned xb_xcc_id() { return (unsigned)__builtin_amdgcn_s_getreg((3 << 11) | 20) & 0xFu; }
#define XB_SPIN(cond, bar) do { unsigned _sp = 0; while (cond) { __builtin_amdgcn_s_sleep(1); \
    if ((++_sp & 255u) == 0u) { if (xb_ld(&(bar)[XB_TMO])) break; if (_sp > XB_SPIN_CAP) { atomicAdd(&(bar)[XB_TMO], 1u); break; } } } } while (0)

struct XcdBarrier {
    unsigned* bar; unsigned x;
    volatile LAS unsigned* st;
};

__device__ __forceinline__ XcdBarrier xcd_barrier_post(unsigned* bar, volatile LAS unsigned* st) {
    XcdBarrier b; b.bar = bar; b.x = xb_xcc_id(); b.st = st;
    if (threadIdx.x == 0) (void)xb_add(&bar[XB_XCNT(b.x)], 1u);
    return b;
}
__device__ __forceinline__ void xcd_barrier_complete(unsigned* bar, unsigned x, unsigned& nloc, unsigned& nx) {
    const unsigned G = gridDim.x * gridDim.y * gridDim.z;
    unsigned sum, cnt, mine, sp = 0u;
    for (;;) {
        sum = 0u; cnt = 0u; mine = 0u;
#pragma unroll
        for (unsigned j = 0; j < 16; ++j) { const unsigned c = xb_ld(&bar[XB_XCNT(j)]); sum += c; cnt += (c > 0u) ? 1u : 0u; mine = (j == x) ? c : mine; }
        if (sum == G) break;
        __builtin_amdgcn_s_sleep(1);
        if ((++sp & 255u) == 0u) { if (xb_ld(&bar[XB_TMO])) break; if (sp > XB_SPIN_CAP) { atomicAdd(&bar[XB_TMO], 1u); break; } }
    }
    nloc = mine > 0u ? mine : 1u; nx = cnt > 0u ? cnt : 1u;
}

__device__ __forceinline__ void xcd_barrier(const XcdBarrier& b) {
    asm volatile("s_waitcnt vmcnt(0)" ::: "memory");
    __syncthreads();
    if (threadIdx.x == 0) {
        unsigned* bar = b.bar;
        __builtin_amdgcn_s_waitcnt(0);
        unsigned nloc = b.st[0], nx = b.st[1];
        if (nloc == 0u) { xcd_barrier_complete(bar, b.x, nloc, nx); b.st[0] = nloc; b.st[1] = nx; }
        const unsigned old = xb_add(&bar[XB_XSUB(b.x)], 1u);
        const unsigned gen = old / nloc;
        if (old + 1u == (gen + 1u) * nloc) {
            __builtin_amdgcn_fence(__ATOMIC_RELEASE, "agent");
            asm volatile("s_waitcnt vmcnt(0)" ::: "memory");
            const unsigned og = xb_add(&bar[XB_TOP], 1u);
            const unsigned tg = og / nx;
            if (og + 1u == (tg + 1u) * nx) xb_add(&bar[XB_TOPGEN], 1u);
            else XB_SPIN(xb_ld(&bar[XB_TOPGEN]) == tg, bar);
            __builtin_amdgcn_fence(__ATOMIC_ACQUIRE, "agent");
            xb_add(&bar[XB_XGEN(b.x)], 1u);
            asm volatile("s_waitcnt vmcnt(0)" ::: "memory");
        } else {
            XB_SPIN(xb_ld(&bar[XB_XGEN(b.x)]) == gen, bar);
            __builtin_amdgcn_fence(__ATOMIC_ACQUIRE, "agent");
            asm volatile("s_waitcnt vmcnt(0)" ::: "memory");
        }
    }
    __syncthreads();
}

typedef unsigned short bf16;
typedef unsigned v4u __attribute__((ext_vector_type(4)));
typedef unsigned v2u __attribute__((ext_vector_type(2)));
typedef float f32x4 __attribute__((ext_vector_type(4)));
typedef float f32x16 __attribute__((ext_vector_type(16)));
typedef short bf16x8 __attribute__((ext_vector_type(8)));
typedef short s16x4 __attribute__((ext_vector_type(4)));
#define GAS __attribute__((address_space(1)))

constexpr int NWAVES = 8, NTHR = 512;
constexpr int NB = 4, SEQ = 8192, CTX = 256, TB = SEQ + CTX, MTOK = NB * TB, DM = 2048, DFF = 8192, DIN = 3664, DINP = 3840, DEPTH = 4;
constexpr int ZQ = 0, ZKV = 512, ZR = 768, ZSQ = 832, ZSK = 1856, ZSV = 1984, ZMQ = 2112, ZMK = 2368, ZMV = 2624, ZMG = 3136, ZMO = 3152;
constexpr int NSTEP = 132;
constexpr float NORM_EPS = 1e-6f;
constexpr float LOG2E = 1.4426950408889634f;

constexpr size_t MiB = 1u << 20;
constexpr size_t WS_CTL = 0, CTL_ZERO_BYTES = 1 * MiB;
constexpr size_t WS_MOD = 1 * MiB, WS_WIN = 2 * MiB, WS_WUQ = 17 * MiB, WS_WUKV = 18 * MiB, WS_WOUT = 19 * MiB, WS_W1 = 27 * MiB, WS_W2 = 59 * MiB;
constexpr size_t WS_X = 91 * MiB, WS_H = 355 * MiB, WS_GATES = 487 * MiB, WS_DC = 490 * MiB, WS_DN = 622 * MiB, WS_SC = 624 * MiB, WS_BIG = 625 * MiB;
constexpr size_t BG_Z = 0, BG_ZQN = 248 * MiB, BG_ZKVN = 281 * MiB, BG_KR = 298 * MiB, BG_QM = 303 * MiB, BG_KVM = 353 * MiB, BG_Y = 419 * MiB, BG_END = 551 * MiB;
constexpr size_t WS_SLAB = WS_BIG + BG_END;
constexpr size_t WS_STAT = WS_SLAB + 64 * MiB;
constexpr size_t WS_RS2 = WS_STAT + 5 * MiB;
constexpr size_t WS_WSET1 = WS_STAT + 8 * MiB;
constexpr size_t WSET_BYTES = 89 * MiB;
constexpr size_t WS_END = WS_WSET1 + WSET_BYTES;
constexpr int BIASW = DINP + DFF;
static_assert((size_t)MTOK * DM * 4 == 264 * MiB && (size_t)MTOK * DFF * 2 <= BG_END && (size_t)MTOK * DINP * 2 <= BG_ZQN, "ws map");
constexpr int CW_BAR = 4096;

constexpr int RING_BYTES = 131072, LDSCTL_OFF = 138240  , MISC_OFF = LDSCTL_OFF + 320, LDS_BYTES = 147456;

#define LDS_WAIT() asm volatile("s_waitcnt lgkmcnt(0)" ::: "memory")
__device__ __forceinline__ float bf2f(unsigned h) { return __uint_as_float(h << 16); }
__device__ __forceinline__ unsigned pk2(float lo, float hi) { return pg8::pkbf(lo, hi); }
__device__ __forceinline__ float wave_sum(float v) {
#pragma unroll
    for (int o = 1; o < 64; o <<= 1) v += __shfl_xor(v, o);
    return v;
}
__device__ __forceinline__ float wave_max(float v) {
#pragma unroll
    for (int o = 1; o < 64; o <<= 1) v = fmaxf(v, __shfl_xor(v, o));
    return v;
}
__device__ __forceinline__ float fexp2(float x) { return __builtin_amdgcn_exp2f(x); }
__device__ __forceinline__ float fexp(float x) { return __builtin_amdgcn_exp2f(x * LOG2E); }
__device__ __forceinline__ float sigmoidf_(float x) { return 1.f / (1.f + fexp(-x)); }
__device__ __forceinline__ float sigmoid_fast(float x) { return __builtin_amdgcn_rcpf(1.f + fexp(-x)); }
__device__ __forceinline__ float row16_sum(float v) {
    v += __int_as_float(__builtin_amdgcn_mov_dpp(__float_as_int(v), 0xB1, 0xf, 0xf, true));
    v += __int_as_float(__builtin_amdgcn_mov_dpp(__float_as_int(v), 0x4E, 0xf, 0xf, true));
    v += __int_as_float(__builtin_amdgcn_mov_dpp(__float_as_int(v), 0x124, 0xf, 0xf, true));
    v += __int_as_float(__builtin_amdgcn_mov_dpp(__float_as_int(v), 0x128, 0xf, 0xf, true));
    return v;
}
__device__ __forceinline__ float logsigf_(float x) { return fminf(x, 0.f) - log1pf(expf(-fabsf(x))); }
__device__ __forceinline__ float logsig_fast(float x) { return fminf(x, 0.f) - 0.6931471805599453f * __builtin_amdgcn_logf(1.f + fexp(-fabsf(x))); }
__device__ __forceinline__ void rope_cs(int pos, int i, float& c, float& s) {
    const float inv = fexp2(-0.8304820237218406f * (float)i);
    float rev = (float)pos * inv * 0.15915494309189535f; rev -= floorf(rev);
    c = __builtin_amdgcn_cosf(rev); s = __builtin_amdgcn_sinf(rev);
}

__device__ __forceinline__ void phase_mod(const float* c, const float* c_ctx, const float* w_mod, const float* b_mod, float* MOD, LAS unsigned char* L, int wg, int G, int tid) {
    LAS float* sv = (LAS float*)L;
    LAS float* red = (LAS float*)(L + 40960);
    for (int i = tid; i < 5 * DM; i += NTHR) { const int b = i / DM, k = i - b * DM; const float v = b < 4 ? c[b * DM + k] : c_ctx[k]; sv[i] = v / (1.f + expf(-v)); }
    __syncthreads();
    const int wave = tid >> 6, lane = tid & 63;
    for (int item = wg; item < DEPTH * 192; item += G) {
        const int l = item / 192, cg = item - l * 192;
        const float* W = w_mod + (size_t)l * DM * 12288 + cg * 64 + lane;
        float a0 = 0.f, a1 = 0.f, a2 = 0.f, a3 = 0.f, a4 = 0.f;
        const int k0 = wave * 256;
#pragma unroll 8
        for (int k = k0; k < k0 + 256; ++k) { const float w = W[(size_t)k * 12288];
            a0 += sv[k] * w; a1 += sv[DM + k] * w; a2 += sv[2 * DM + k] * w; a3 += sv[3 * DM + k] * w; a4 += sv[4 * DM + k] * w; }
        red[(wave * 5 + 0) * 64 + lane] = a0; red[(wave * 5 + 1) * 64 + lane] = a1; red[(wave * 5 + 2) * 64 + lane] = a2; red[(wave * 5 + 3) * 64 + lane] = a3; red[(wave * 5 + 4) * 64 + lane] = a4;
        __syncthreads();
        if (tid < 320) { const int b = tid >> 6, ln = tid & 63; float s = 0.f;
#pragma unroll
            for (int w = 0; w < 8; ++w) s += red[(w * 5 + b) * 64 + ln];
            MOD[(size_t)(l * 5 + b) * 12288 + cg * 64 + ln] = s + b_mod[l * 12288 + cg * 64 + ln]; }
        __syncthreads();
    }
}

__device__ __forceinline__ void transpose_item(const float* W, int K, int N, int NP, bf16* WT, LAS float* scr, int item, int lane, const LAS float* tab, long long* bias, int ldb, const float* kscale = nullptr) {
    const int nblk = NP / 32, kb = item / nblk, nb = item - kb * nblk, k0 = 64 * kb, n0 = 32 * nb;
    const int n = n0 + (lane & 31); const bool okn = n < N;
    float wv_[32];
    const float* wp = W + (size_t)(k0 + (lane >> 5)) * N + (okn ? n : 0);
#pragma unroll
    for (int i = 0; i < 32; ++i) wv_[i] = wp[(size_t)(2 * i) * N];
#pragma unroll
    for (int i = 0; i < 32; ++i) { if (!okn) wv_[i] = 0.f; if (kscale != nullptr) wv_[i] *= kscale[k0 + 2 * i + (lane >> 5)]; scr[(2 * i + (lane >> 5)) * 33 + (lane & 31)] = wv_[i]; }
    if (tab != nullptr) {
        const LAS float* tp = tab + k0 + (lane >> 5);
#pragma unroll
        for (int bp = 0; bp < 5; ++bp) { float s = 0.f;
#pragma unroll
            for (int i = 0; i < 32; ++i) s += tp[bp * 2048 + 2 * i] * wv_[i];
            s += __shfl_xor(s, 32);
            if (lane < 32) atomicAdd((unsigned long long*)(bias + (size_t)bp * ldb + n), (unsigned long long)(long long)(s * 4294967296.f)); }
    }
    LDS_WAIT(); asm volatile("" ::: "memory");
    const int c = lane & 7;
#pragma unroll
    for (int j = 0; j < 4; ++j) { const int nn = (lane >> 3) + 8 * j; const LAS float* s = scr + (8 * c) * 33 + nn;
        v4u o; o.x = pk2(s[0 * 33], s[1 * 33]); o.y = pk2(s[2 * 33], s[3 * 33]); o.z = pk2(s[4 * 33], s[5 * 33]); o.w = pk2(s[6 * 33], s[7 * 33]);
        *(v4u*)(WT + (size_t)(n0 + nn) * K + k0 + 8 * c) = o; }
    LDS_WAIT(); asm volatile("" ::: "memory");
}
struct ConvSrc { const float *w_in, *w_uq, *w_ukv, *w_out, *w1, *w2, *g_q, *g_kv; };
struct ConvDst { bf16 *win, *wuq, *wukv, *wout, *w1, *w2; };
constexpr int CV_I1 = (DM / 64) * (DFF / 32), CV_I2 = (DFF / 64) * (DM / 32), CV_IOUT = (DM / 64) * (DM / 32), CV_IIN = (DM / 64) * (DINP / 32), CV_IUQ = (512 / 64) * (768 / 32), CV_IUKV = (256 / 64) * (1024 / 32);
constexpr int CV_A_SPLIT = 4352, CV_B_SPLIT = 6400;
__device__ __forceinline__ void conv_load_tab(LAS float* tab, const float* modl, int which  , int tid) {
    __syncthreads();
    for (int i = tid; i < 5 * DM; i += NTHR) { const int bp = i / DM, k = i - bp * DM; tab[i] = modl[(size_t)bp * 12288 + which * DM + k]; }
    __syncthreads();
}
__device__ __forceinline__ void conv_A(const ConvSrc s, const ConvDst d, int l, int lo, int hi, int worker, int nworkers, LAS float* scr, const LAS float* tab, long long* biasl, int lane) {
    for (int it = lo + worker; it < hi; it += nworkers) transpose_item(s.w1 + (size_t)l * DM * DFF, DM, DFF, DFF, d.w1, scr, it, lane, tab, biasl + DINP, BIASW);
}
__device__ __forceinline__ void conv_B(const ConvSrc s, const ConvDst d, int l, int lo, int hi, int worker, int nworkers, LAS float* scr, int lane) {
    for (int it = lo + worker; it < hi; it += nworkers) transpose_item(s.w2 + (size_t)l * DFF * DM, DFF, DM, DM, d.w2, scr, it, lane, nullptr, nullptr, 0);
}
__device__ __forceinline__ void conv_CD(const ConvSrc s, const ConvDst d, int l, int worker, int nworkers, LAS float* scr, const LAS float* tab, long long* biasl, int lane) {
    for (int it = worker; it < CV_IOUT + CV_IIN + CV_IUQ + CV_IUKV; it += nworkers) {
        int r = it;
        if (r < CV_IIN) { transpose_item(s.w_in + (size_t)l * DM * DIN, DM, DIN, DINP, d.win, scr, r, lane, tab, biasl, BIASW); continue; } r -= CV_IIN;
        if (r < CV_IOUT) { transpose_item(s.w_out + (size_t)l * DM * DM, DM, DM, DM, d.wout, scr, r, lane, nullptr, nullptr, 0); continue; } r -= CV_IOUT;
        if (r < CV_IUQ) { transpose_item(s.w_uq + (size_t)l * 512 * 768, 512, 768, 768, d.wuq, scr, r, lane, nullptr, nullptr, 0, s.g_q + l * 512); continue; } r -= CV_IUQ;
        transpose_item(s.w_ukv + (size_t)l * 256 * 1024, 256, 1024, 1024, d.wukv, scr, r, lane, nullptr, nullptr, 0, s.g_kv + l * 256);
    }
}

__device__ __forceinline__ void phase_first(const float* xin, const float* ctxin, bf16* X, bf16* HX, unsigned long long* rowss, const float* g, const float* modl, int gw, int NGW, int lane) {
    const int rs = (int)(((long long)MTOK * gw) / NGW), re = (int)(((long long)MTOK * (gw + 1)) / NGW);
    f32x4 gm[4][2], cur[4][2], nxt[4][2]; int bpc = -1;
#define PF_LOAD(dst, r_) do { const int b_ = (r_) / TB, p_ = (r_) - b_ * TB; const float* s_ = (p_ < CTX ? ctxin + (size_t)(b_ * CTX + p_) * DM : xin + (size_t)(b_ * SEQ + p_ - CTX) * DM) + 8 * lane; \
        _Pragma("unroll") for (int j = 0; j < 4; ++j) { dst[j][0] = *(const f32x4*)(s_ + 512 * j); dst[j][1] = *(const f32x4*)(s_ + 512 * j + 4); } } while (0)
    if (rs < re) PF_LOAD(cur, rs);
    for (int r = rs; r < re; ++r) {
        if (r + 1 < re) PF_LOAD(nxt, r + 1);
        const int b = r / TB, p = r - b * TB, bp = p < CTX ? 4 : b;
        if (bp != bpc) { bpc = bp; const float* gp = g + 8 * lane; const float* scp = modl + (size_t)bp * 12288 + DM + 8 * lane;
#pragma unroll
            for (int j = 0; j < 4; ++j)
#pragma unroll
                for (int h = 0; h < 2; ++h) gm[j][h] = *(const f32x4*)(gp + 512 * j + 4 * h) * (*(const f32x4*)(scp + 512 * j + 4 * h) + 1.f); }
        float ss = 0.f;
#pragma unroll
        for (int j = 0; j < 4; ++j)
#pragma unroll
            for (int h = 0; h < 2; ++h) { const f32x4 v = cur[j][h]; ss += (v.x * v.x + v.y * v.y) + (v.z * v.z + v.w * v.w); }
        ss = wave_sum(ss); if (lane == 0) rowss[r] = (unsigned long long)(ss * 16777216.f);
        bf16* xo = X + (size_t)r * DM + 8 * lane; bf16* ho = HX + (size_t)r * DM + 8 * lane;
#pragma unroll
        for (int j = 0; j < 4; ++j) { const f32x4 v0 = cur[j][0], v1 = cur[j][1], h0 = v0 * gm[j][0], h1 = v1 * gm[j][1];
            *(v4u*)(xo + 512 * j) = (v4u){pk2(v0.x, v0.y), pk2(v0.z, v0.w), pk2(v1.x, v1.y), pk2(v1.z, v1.w)};
            *(v4u*)(ho + 512 * j) = (v4u){pk2(h0.x, h0.y), pk2(h0.z, h0.w), pk2(h1.x, h1.y), pk2(h1.z, h1.w)}; }
#pragma unroll
        for (int j = 0; j < 4; ++j) { cur[j][0] = nxt[j][0]; cur[j][1] = nxt[j][1]; }
    }
#undef PF_LOAD
}
__device__ __forceinline__ void phase_ctxfix(bf16* X, bf16* HX, unsigned long long* rowss, const float* slab, const float* fixgate, const float* g, const float* nsc, int gw, int NGW, int lane) {
    for (int cr = gw; cr < NB * CTX; cr += NGW) {
        const int b = cr / CTX, p = cr - b * CTX; const size_t r = (size_t)b * TB + p;
        unsigned long long* xr = (unsigned long long*)(X + r * DM) + lane; const f32x4* sp = (const f32x4*)(slab + (size_t)cr * DM) + lane; const f32x4* fg = (const f32x4*)fixgate + lane;
        f32x4 v[8]; float ss = 0.f;
#pragma unroll
        for (int j = 0; j < 8; ++j) { f32x4 acc = sp[64 * j];
#pragma unroll
            for (int s = 1; s < 8; ++s) acc = acc + sp[(size_t)s * (1024 * DM / 4) + 64 * j];
            const unsigned long long xw = xr[64 * j]; const unsigned w0 = (unsigned)xw, w1 = (unsigned)(xw >> 32);
            v[j] = (f32x4){__uint_as_float(w0 << 16), __uint_as_float(w0 & 0xffff0000u), __uint_as_float(w1 << 16), __uint_as_float(w1 & 0xffff0000u)} + fg[64 * j] * acc; ss += (v[j].x * v[j].x + v[j].y * v[j].y) + (v[j].z * v[j].z + v[j].w * v[j].w); }
        ss = wave_sum(ss); if (lane == 0) rowss[r] = (unsigned long long)(ss * 16777216.f);
        const f32x4* gp = (const f32x4*)g + lane; const f32x4* scp = (const f32x4*)nsc + lane;
        unsigned long long* o8 = (unsigned long long*)(HX + r * DM) + lane;
#pragma unroll
        for (int j = 0; j < 8; ++j) { xr[64 * j] = (unsigned long long)pk2(v[j].x, v[j].y) | ((unsigned long long)pk2(v[j].z, v[j].w) << 32); const f32x4 gg = gp[64 * j], sc = scp[64 * j];
            o8[64 * j] = (unsigned long long)pk2(v[j].x * gg.x * (1.f + sc.x), v[j].y * gg.y * (1.f + sc.y)) | ((unsigned long long)pk2(v[j].z * gg.z * (1.f + sc.z), v[j].w * gg.w * (1.f + sc.w)) << 32); }
    }
}
__device__ __forceinline__ void phase_final(const bf16* X, float* out, const float* g, int gw, int NGW, int lane) {
    const int qs = (int)(((long long)NB * SEQ * gw) / NGW), qe = (int)(((long long)NB * SEQ * (gw + 1)) / NGW);
    f32x4 gg[4][2]; v4u cur[4], nxt[4];
#pragma unroll
    for (int j = 0; j < 4; ++j) { gg[j][0] = *(const f32x4*)(g + 512 * j + 8 * lane); gg[j][1] = *(const f32x4*)(g + 512 * j + 8 * lane + 4); }
#define FN_LOAD(dst, q_) do { const int b_ = (q_) / SEQ; const bf16* s_ = X + ((size_t)b_ * TB + CTX + ((q_) - b_ * SEQ)) * DM + 8 * lane; \
        _Pragma("unroll") for (int j = 0; j < 4; ++j) dst[j] = *(const v4u*)(s_ + 512 * j); } while (0)
    if (qs < qe) FN_LOAD(cur, qs);
    for (int q = qs; q < qe; ++q) {
        if (q + 1 < qe) FN_LOAD(nxt, q + 1);
        f32x4 v[4][2]; float ss = 0.f;
#pragma unroll
        for (int j = 0; j < 4; ++j) { const v4u w = cur[j];
            v[j][0] = (f32x4){__uint_as_float(w.x << 16), __uint_as_float(w.x & 0xffff0000u), __uint_as_float(w.y << 16), __uint_as_float(w.y & 0xffff0000u)};
            v[j][1] = (f32x4){__uint_as_float(w.z << 16), __uint_as_float(w.z & 0xffff0000u), __uint_as_float(w.w << 16), __uint_as_float(w.w & 0xffff0000u)};
#pragma unroll
            for (int h = 0; h < 2; ++h) ss += (v[j][h].x * v[j][h].x + v[j][h].y * v[j][h].y) + (v[j][h].z * v[j][h].z + v[j][h].w * v[j][h].w); }
        const float rstd = rsqrtf(wave_sum(ss) * (1.f / DM) + NORM_EPS);
        float* o = out + (size_t)q * DM + 8 * lane;
#pragma unroll
        for (int j = 0; j < 4; ++j)
#pragma unroll
            for (int h = 0; h < 2; ++h) *(f32x4*)(o + 512 * j + 4 * h) = v[j][h] * rstd * gg[j][h];
#pragma unroll
        for (int j = 0; j < 4; ++j) cur[j] = nxt[j];
    }
#undef FN_LOAD
}

__device__ __forceinline__ void rope4(const bf16* src, bf16* dst, int i0, const float (&cr)[4], const float (&sr)[4], const float (&cc)[4], const float (&sc)[4]) {
    const v2u r1 = *(const v2u*)(src + i0), r2 = *(const v2u*)(src + 16 + i0), r3 = *(const v2u*)(src + 32 + i0), r4 = *(const v2u*)(src + 48 + i0);
    float x1[4] = {bf2f(r1.x & 0xffffu), bf2f(r1.x >> 16), bf2f(r1.y & 0xffffu), bf2f(r1.y >> 16)};
    float x2[4] = {bf2f(r2.x & 0xffffu), bf2f(r2.x >> 16), bf2f(r2.y & 0xffffu), bf2f(r2.y >> 16)};
    float x3[4] = {bf2f(r3.x & 0xffffu), bf2f(r3.x >> 16), bf2f(r3.y & 0xffffu), bf2f(r3.y >> 16)};
    float x4[4] = {bf2f(r4.x & 0xffffu), bf2f(r4.x >> 16), bf2f(r4.y & 0xffffu), bf2f(r4.y >> 16)};
    float o1[4], o2[4], o3[4], o4[4];
#pragma unroll
    for (int e = 0; e < 4; ++e) { o1[e] = x1[e] * cr[e] - x2[e] * sr[e]; o2[e] = x2[e] * cr[e] + x1[e] * sr[e]; o3[e] = x3[e] * cc[e] - x4[e] * sc[e]; o4[e] = x4[e] * cc[e] + x3[e] * sc[e]; }
    *(v2u*)(dst + i0) = (v2u){pk2(o1[0], o1[1]), pk2(o1[2], o1[3])}; *(v2u*)(dst + 16 + i0) = (v2u){pk2(o2[0], o2[1]), pk2(o2[2], o2[3])};
    *(v2u*)(dst + 32 + i0) = (v2u){pk2(o3[0], o3[1]), pk2(o3[2], o3[3])}; *(v2u*)(dst + 48 + i0) = (v2u){pk2(o4[0], o4[1]), pk2(o4[2], o4[3])};
}
__device__ __forceinline__ void phase_e1(bf16* Z, bf16* KR, int wg, int G, int wave, int lane, bool do_rope = true) {
    const int n5 = (NB * 4 * NSTEP / 2) % G, tot5 = 4 * n5 + 5 * (G - n5);
    const int c0 = wg < n5 ? 4 * wg : 4 * n5 + 5 * (wg - n5), c1 = wg + 1 < n5 ? 4 * (wg + 1) : 4 * n5 + 5 * (wg + 1 - n5);
    const int rs = (int)(((long long)MTOK * c0) / tot5), re = (int)(((long long)MTOK * c1) / tot5);
    for (int r0 = rs + wave; r0 < re; r0 += 2 * NWAVES)
#pragma unroll
    for (int rr = 0; rr < 2; ++rr) {
        const int r = r0 + rr * NWAVES; if (r >= re) break;
        const int b = r / TB, p = r - b * TB; const bool latent = p >= CTX && do_rope; const int t = p - CTX;
        bf16* z = Z + (size_t)r * DINP;
        if (latent) {
            const int prow = t >> 6, pcol = t & 63, i0 = 4 * (lane & 3);
            float cr[4], sr[4], cc[4], sc[4];
#pragma unroll
            for (int e = 0; e < 4; ++e) { rope_cs(prow, i0 + e, cr[e], sr[e]); rope_cs(pcol, i0 + e, cc[e], sc[e]); }
            { bf16* hp = z + ZSQ + 64 * (lane >> 2); rope4(hp, hp, i0, cr, sr, cc, sc); }
            if (lane < 8) { bf16* hp = z + ZSK + 64 * (lane >> 2); rope4(hp, hp, i0, cr, sr, cc, sc); }
            else if (lane < 12) rope4(z + ZR, KR + (size_t)r * 64, i0, cr, sr, cc, sc);
        } else {
            if (lane < 8) *(v4u*)(KR + (size_t)r * 64 + 8 * lane) = *(const v4u*)(z + ZR + 8 * lane);
        }
    }
}

#define MFMA16(a, b, c) __builtin_amdgcn_mfma_f32_16x16x32_bf16((a), (b), (c), 0, 0, 0)
__device__ __forceinline__ bf16x8 gather8(LAS const unsigned char* base, int stride) {
    bf16x8 r;
#pragma unroll
    for (int j = 0; j < 8; ++j) r[j] = *(LAS const short*)(base + j * stride);
    return r;
}
__device__ __forceinline__ bf16x8 colfrag8(LAS const unsigned char* tile, int row0, int col0, int stride, int lane) {
    typedef short v4i16_ __attribute__((ext_vector_type(4)));
    LAS const unsigned char* p = tile + (row0 + 8 * (lane >> 4) + ((lane & 15) >> 2)) * stride + (col0 + 4 * (lane & 3)) * 2;
    const s16x4 lo = __builtin_bit_cast(s16x4, __builtin_amdgcn_ds_read_tr16_b64_v4i16((LAS v4i16_*)p));
    const s16x4 hi = __builtin_bit_cast(s16x4, __builtin_amdgcn_ds_read_tr16_b64_v4i16((LAS v4i16_*)(p + 4 * stride)));
    return __builtin_shufflevector(lo, hi, 0, 1, 2, 3, 4, 5, 6, 7);
}
__device__ __forceinline__ void chain_step_rows(int dir, int i, int& seg, int& c) { seg = i >= 4; const int ii = seg ? i - 4 : i; c = dir == 0 ? ii : (seg ? 127 - ii : 3 - ii); }
__device__ __forceinline__ float scan_sum(float v, int dir, int lane) {
#pragma unroll
    for (int o = 1; o < 64; o <<= 1) { const float t = dir == 0 ? __shfl_up(v, o) : __shfl_down(v, o); const bool ok = dir == 0 ? (lane >= o) : (lane + o < 64); if (ok) v += t; }
    return v;
}
__device__ __forceinline__ float scan_max(float v, int dir, int lane) {
#pragma unroll
    for (int o = 1; o < 64; o <<= 1) { const float t = dir == 0 ? __shfl_up(v, o) : __shfl_down(v, o); const bool ok = dir == 0 ? (lane >= o) : (lane + o < 64); if (ok) v = fmaxf(v, t); }
    return v;
}

__device__ __forceinline__ void mlstm_a(const bf16* Z, const float* GATES, const float* gbias  , bf16* DC, float* DN, float* SC, LAS unsigned char* L, int wg, int G, int tid) {
    const int wave = tid >> 6, lane = tid & 63, fr = lane & 15, fq = lane >> 4, half = wave >> 2, w4 = wave & 3, t256 = tid & 255;
    LAS unsigned char* kt = L + half * 36864;
    LAS unsigned char* vt = kt + 18432;
    LAS float* wv = (LAS float*)(kt + 35840);
    constexpr int NP = NB * 4 * NSTEP / 2;
    for (int pair = wg; pair < NP; pair += G) {
        const int item = 2 * pair + half;
        const int b = item / (4 * NSTEP), h = (item / NSTEP) & 3, cc0 = item % NSTEP, seg = cc0 >= 4, c = seg ? cc0 - 4 : cc0;
        const int row0 = b * TB + (seg ? CTX : 0) + 64 * c;
        const int step0 = seg ? 4 + c : c, step1 = seg ? 4 + 127 - c : 3 - c;
        if (w4 < 2) {
            const int dir = w4; const size_t sidx = (size_t)((b * 4 + h) * 2 + dir) * NSTEP + (dir == 0 ? step0 : step1);
            const size_t row = (size_t)(row0 + lane);
            const float ip = GATES[row * 16 + (2 * dir) * 4 + h] + gbias[(2 * dir) * 4 + h];
            const float fp = GATES[row * 16 + (2 * dir + 1) * 4 + h] + gbias[(2 * dir + 1) * 4 + h];
            const float bs = scan_sum(logsigf_(fp), dir, lane);
            const float g = __shfl(bs, dir == 0 ? 63 : 0);
            const float a = g - bs + ip, amax = wave_max(a);
            wv[dir * 64 + lane] = expf(a - amax);
            if (lane == 0) { SC[sidx * 4 + 0] = g; SC[sidx * 4 + 1] = amax; }
        }
        v4u kraw[2], vraw[4];
#pragma unroll
        for (int i2 = 0; i2 < 2; ++i2) { const int c2 = t256 + 256 * i2; kraw[i2] = *(const v4u*)(Z + (size_t)(row0 + (c2 >> 3)) * DINP + ZMK + h * 64 + (c2 & 7) * 8); }
#pragma unroll
        for (int i2 = 0; i2 < 4; ++i2) { const int c2 = t256 + 256 * i2; vraw[i2] = *(const v4u*)(Z + (size_t)(row0 + (c2 >> 4)) * DINP + ZMV + h * 128 + (c2 & 15) * 8); }
        __syncthreads();
#pragma unroll
        for (int i2 = 0; i2 < 2; ++i2) { const int c2 = t256 + 256 * i2, krow_ = c2 >> 3, kcc_ = c2 & 7;
#pragma unroll
            for (int dir = 0; dir < 2; ++dir) { const float w = wv[dir * 64 + krow_]; v4u o;
#pragma unroll
                for (int e = 0; e < 4; ++e) o[e] = pk2(bf2f(kraw[i2][e] & 0xffffu) * w, bf2f(kraw[i2][e] >> 16) * w);
                *(LAS v4u*)(kt + dir * 9216 + krow_ * 144 + kcc_ * 16) = o; } }
#pragma unroll
        for (int i2 = 0; i2 < 4; ++i2) { const int c2 = t256 + 256 * i2; *(LAS v4u*)(vt + (c2 >> 4) * 272 + (c2 & 15) * 16) = vraw[i2]; }
        __syncthreads();
        if (w4 < 2) { const int dir = w4; const size_t sidx = (size_t)((b * 4 + h) * 2 + dir) * NSTEP + (dir == 0 ? step0 : step1); float s = 0.f;
#pragma unroll 8
            for (int j = 0; j < 64; ++j) s += bf2f(*(LAS const unsigned short*)(kt + dir * 9216 + j * 144 + lane * 2));
            DN[sidx * 64 + lane] = s; }
        {
            bf16x8 bfr[2][2];
#pragma unroll
            for (int et = 0; et < 2; ++et)
#pragma unroll
                for (int ks = 0; ks < 2; ++ks) bfr[et][ks] = colfrag8(vt, 32 * ks, 16 * (2 * w4 + et), 272, lane);
            const int ecol = 16 * (2 * w4 + (fq & 1)) + 4 * (fq & ~1);
#pragma unroll
            for (int dir = 0; dir < 2; ++dir) {
                bf16* dcp = DC + ((size_t)((b * 4 + h) * 2 + dir) * NSTEP + (dir == 0 ? step0 : step1)) * 8192;
#pragma unroll
                for (int dt = 0; dt < 4; ++dt) { f32x4 acc0 = {0.f, 0.f, 0.f, 0.f}, acc1 = {0.f, 0.f, 0.f, 0.f};
#pragma unroll
                    for (int ks = 0; ks < 2; ++ks) { const bf16x8 af = colfrag8(kt + dir * 9216, 32 * ks, 16 * dt, 144, lane); acc0 = MFMA16(bfr[0][ks], af, acc0); acc1 = MFMA16(bfr[1][ks], af, acc1); }
                    const auto sx = __builtin_amdgcn_permlane16_swap(pk2(acc0[0], acc0[1]), pk2(acc1[0], acc1[1]), false, false);
                    const auto sy = __builtin_amdgcn_permlane16_swap(pk2(acc0[2], acc0[3]), pk2(acc1[2], acc1[3]), false, false);
                    *(v4u*)(dcp + (16 * dt + fr) * 128 + ecol) = (v4u){sx[0], sy[0], sx[1], sy[1]}; } } }
        __syncthreads();
    }
}
__device__ __forceinline__ void mlstm_scan(bf16* DC, float* DN, float* SC, int wg, int G, int tid) {
    for (int unit = wg; unit < 32 * 8; unit += G) {
        const int chain = unit >> 3, slice = unit & 7;
        unsigned* dc = (unsigned*)(DC + (size_t)chain * NSTEP * 8192 + slice * 1024) + tid;
        float* dn = DN + (size_t)chain * NSTEP * 64 + (tid & 63);
        float* sc = SC + (size_t)chain * NSTEP * 4;
        const bool has_n = (slice == 0) && (tid < 64), rec_m = (slice == 0) && (tid == 0);
        float C0 = 0.f, C1 = 0.f, n = 0.f, m = 0.f;
        for (int i = 0; i < NSTEP; i += 12) {
            unsigned v[12]; float nv[12], g[12], am[12];
#pragma unroll
            for (int k = 0; k < 12; ++k) { v[k] = dc[(size_t)(i + k) * 4096]; g[k] = sc[(i + k) * 4]; am[k] = sc[(i + k) * 4 + 1]; nv[k] = has_n ? dn[(i + k) * 64] : 0.f; }
#pragma unroll
            for (int k = 0; k < 12; ++k) {
                const float mn = fmaxf(g[k] + m, am[k]), decay = expf(g[k] + m - mn), grow = expf(am[k] - mn);
                dc[(size_t)(i + k) * 4096] = pk2(C0, C1);
                C0 = decay * C0 + grow * bf2f(v[k] & 0xffffu); C1 = decay * C1 + grow * bf2f(v[k] >> 16);
                if (has_n) { dn[(i + k) * 64] = n; n = decay * n + grow * nv[k]; }
                if (rec_m) sc[(i + k) * 4 + 2] = m;
                m = mn;
            }
        }
    }
}
__device__ __forceinline__ void mlstm_c_phase(int u_first, int G, bool skip_ctx, const bf16* Z, const float* GATES, const float* gbias, const float* gh  , const bf16* DC, const float* DN, const float* SC,
                                              bf16* Y, LAS unsigned char* L, int tid) {
    const int wave = tid >> 6, lane = tid & 63, fr = lane & 15, fq = lane >> 4, dir = wave >> 2, w4 = wave & 3, t256 = tid & 255;
    LAS unsigned char* QS = L;
    LAS unsigned char* KS2 = L + 9216;
    LAS unsigned char* VS2 = L + 18432;
    LAS unsigned char* CS = L + 35840 + dir * 17408;
    LAS unsigned char* SS = L + 70656 + dir * 18432;
    LAS unsigned char* QW = SS + 9216;
    LAS float* HM = (LAS float*)(L + 70656);
    constexpr int HMS = 132;
    LAS float* VEC = (LAS float*)(L + 107520 + dir * 2048);
    LAS float* bq = VEC, *uu = VEC + 64, *iwv = VEC + 128, *emt = VEC + 192, *den = VEC + 256, *nin = VEC + 320;
    constexpr int NU = NB * 4 * NSTEP;
    v4u pq, pk, pv[2], pc[4]; float pig = 0.f, pfp = 0.f, pmin = 0.f, pnin = 0.f;
#define MC_DECODE(U) const int b = (U) / (4 * NSTEP), h = ((U) / NSTEP) & 3, cc0 = (U) % NSTEP, seg = cc0 >= 4, c = seg ? cc0 - 4 : cc0; \
    const int row0 = b * TB + (seg ? CTX : 0) + 64 * c; const int chain = (b * 4 + h) * 2 + dir; \
    const int step = dir == 0 ? (seg ? 4 + c : c) : (seg ? 4 + 127 - c : 3 - c); const size_t sidx = (size_t)chain * NSTEP + step
#define MC_NEXT(U) do { (U) += G; while (skip_ctx && (U) < NU && ((U) % NSTEP) < 4) (U) += G; } while (0)
#define MC_LOAD_A(U) do { MC_DECODE(U); (void)chain; (void)step; { const int row = tid >> 3, ch = tid & 7; const bf16* zr = Z + (size_t)(row0 + row) * DINP + h * 64 + ch * 8; pq = *(const v4u*)(zr + ZMQ); pk = *(const v4u*)(zr + ZMK); } \
        if (w4 == 0) { const size_t row = (size_t)(row0 + lane); pig = GATES[row * 16 + (2 * dir) * 4 + h] + gbias[(2 * dir) * 4 + h]; pfp = GATES[row * 16 + (2 * dir + 1) * 4 + h] + gbias[(2 * dir + 1) * 4 + h]; \
                       pmin = SC[sidx * 4 + 2]; pnin = DN[sidx * 64 + lane]; } } while (0)
#define MC_LOAD_C(U) do { MC_DECODE(U); (void)chain; (void)step; const bf16* cin = DC + sidx * 8192; \
        _Pragma("unroll") for (int i2 = 0; i2 < 2; ++i2) { const int c2 = tid + NTHR * i2; pv[i2] = *(const v4u*)(Z + (size_t)(row0 + (c2 >> 4)) * DINP + ZMV + h * 128 + (c2 & 15) * 8); } \
        _Pragma("unroll") for (int k = 0; k < 4; ++k) { const int c2 = t256 + 256 * k; pc[k] = *(const v4u*)(cin + (c2 >> 4) * 128 + (c2 & 15) * 8); } } while (0)
    int unit = u_first; while (skip_ctx && unit < NU && (unit % NSTEP) < 4) unit += G;
    if (unit < NU) { MC_LOAD_A(unit); MC_LOAD_C(unit); }
    for (; unit < NU; ) {
    int tl_ = tid; asm volatile("" : "+v"(tl_));
    const int wave = tl_ >> 6, lane = tl_ & 63, fr = lane & 15, fq = lane >> 4, dir = wave >> 2, w4 = wave & 3, t256 = tl_ & 255; const int tid = tl_;
    LAS unsigned char* CS = L + 35840 + dir * 17408; LAS unsigned char* SS = L + 70656 + dir * 18432; LAS unsigned char* QW = SS + 9216;
    LAS float* VEC = (LAS float*)(L + 107520 + dir * 2048); LAS float* bq = VEC, *uu = VEC + 64, *iwv = VEC + 128, *emt = VEC + 192, *den = VEC + 256, *nin = VEC + 320;
    MC_DECODE(unit); (void)chain; (void)step; (void)sidx;
    { const int row = tid >> 3, ch = tid & 7; v4u o;
#pragma unroll
      for (int e = 0; e < 4; ++e) o[e] = pk2(bf2f(pq[e] & 0xffffu) * 0.125f, bf2f(pq[e] >> 16) * 0.125f);
      *(LAS v4u*)(QS + row * 144 + ch * 16) = o;
      *(LAS v4u*)(KS2 + row * 144 + ch * 16) = pk; }
#pragma unroll
    for (int i2 = 0; i2 < 2; ++i2) { const int c2 = tid + NTHR * i2; *(LAS v4u*)(VS2 + (c2 >> 4) * 272 + (c2 & 15) * 16) = pv[i2]; }
#pragma unroll
    for (int k = 0; k < 4; ++k) { const int c2 = t256 + 256 * k; *(LAS v4u*)(CS + (c2 >> 4) * 272 + (c2 & 15) * 16) = pc[k]; }
    if (w4 == 0) {
        const float bs = scan_sum(logsigf_(pfp), dir, lane);
        const float u = pig - bs, pm = scan_max(u, dir, lane), m_in = pmin;
        const float mt = bs + fmaxf(m_in, pm);
        bq[lane] = bs - mt; uu[lane] = u; iwv[lane] = fexp(bs + m_in - mt); emt[lane] = fexp(-mt); nin[lane] = pnin;
    }
    __syncthreads();
    int unext = unit; MC_NEXT(unext);
    if (unext < NU) MC_LOAD_A(unext);
    v4u zo[2]; f32x4 ghv[2];
    { const int c8 = 8 * (lane & 15); const bf16* zp = Z + (size_t)(row0 + 8 * wave + (lane >> 4)) * DINP + ZMO + h * 128 + c8;
      zo[0] = *(const v4u*)zp; zo[1] = *(const v4u*)(zp + (size_t)4 * DINP); ghv[0] = *(const f32x4*)(gh + h * 128 + c8); ghv[1] = *(const f32x4*)(gh + h * 128 + c8 + 4); }
#pragma unroll
    for (int k = 0; k < 2; ++k) { const int c2 = t256 + 256 * k, row = c2 >> 3, ch = c2 & 7; const v4u rq = *(LAS const v4u*)(QS + row * 144 + ch * 16); const float w = iwv[row]; v4u o;
#pragma unroll
        for (int e = 0; e < 4; ++e) o[e] = pk2(bf2f(rq[e] & 0xffffu) * w, bf2f(rq[e] >> 16) * w);
        *(LAS v4u*)(QW + row * 144 + ch * 16) = o; }
    {
      const int lrow = 16 * w4 + fr; const float bql = bq[lrow]; float rsum = 0.f;
      bf16x8 qf[2];
#pragma unroll
      for (int ks = 0; ks < 2; ++ks) qf[ks] = *(LAS const bf16x8*)(QS + lrow * 144 + (32 * ks + 8 * fq) * 2);
#pragma unroll
      for (int st = 0; st < 4; ++st) { f32x4 acc = {0.f, 0.f, 0.f, 0.f};
#pragma unroll
          for (int ks = 0; ks < 2; ++ks) { const bf16x8 kf = *(LAS const bf16x8*)(KS2 + (16 * st + fr) * 144 + (32 * ks + 8 * fq) * 2); acc = MFMA16(kf, qf[ks], acc); }
          const f32x4 us4 = *(LAS const f32x4*)(uu + 16 * st + 4 * fq); float val[4];
#pragma unroll
          for (int rg = 0; rg < 4; ++rg) { const int scol = 16 * st + 4 * fq + rg; const bool valid = dir == 0 ? (scol <= lrow) : (scol >= lrow);
              val[rg] = valid ? acc[rg] * fexp(bql + us4[rg]) : 0.f; rsum += val[rg]; }
          *(LAS v2u*)(SS + lrow * 144 + (16 * st + 4 * fq) * 2) = (v2u){pk2(val[0], val[1]), pk2(val[2], val[3])}; }
      float dq = 0.f;
#pragma unroll
      for (int k2 = 0; k2 < 2; ++k2) { const v4u rq = *(LAS const v4u*)(QS + lrow * 144 + (16 * fq + 8 * k2) * 2); const f32x4 n0 = *(LAS const f32x4*)(nin + 16 * fq + 8 * k2), n1 = *(LAS const f32x4*)(nin + 16 * fq + 8 * k2 + 4);
          dq += (bf2f(rq.x & 0xffffu) * n0.x + bf2f(rq.x >> 16) * n0.y) + (bf2f(rq.y & 0xffffu) * n0.z + bf2f(rq.y >> 16) * n0.w) + (bf2f(rq.z & 0xffffu) * n1.x + bf2f(rq.z >> 16) * n1.y) + (bf2f(rq.w & 0xffffu) * n1.z + bf2f(rq.w >> 16) * n1.w); }
      float rs = rsum + iwv[lrow] * dq;
      { const auto r1 = __builtin_amdgcn_permlane16_swap(__float_as_uint(rs), __float_as_uint(rs), false, false); rs = __uint_as_float(r1[0]) + __uint_as_float(r1[1]);
        const auto r2 = __builtin_amdgcn_permlane32_swap(__float_as_uint(rs), __float_as_uint(rs), false, false); rs = __uint_as_float(r2[0]) + __uint_as_float(r2[1]); }
      if (fq == 0) den[lrow] = rs; }
    __syncthreads();
    f32x4 acc[2][4];
#pragma unroll
    for (int et = 0; et < 2; ++et) { bf16x8 bv[2], bc[2];
#pragma unroll
        for (int ks = 0; ks < 2; ++ks) { bv[ks] = colfrag8(VS2, 32 * ks, 16 * (2 * w4 + et), 272, lane); bc[ks] = colfrag8(CS, 32 * ks, 16 * (2 * w4 + et), 272, lane); }
#pragma unroll
        for (int lt = 0; lt < 4; ++lt) { acc[et][lt] = (f32x4){0.f, 0.f, 0.f, 0.f};
#pragma unroll
            for (int ks = 0; ks < 2; ++ks) { const bf16x8 a1 = *(LAS const bf16x8*)(SS + (16 * lt + fr) * 144 + (32 * ks + 8 * fq) * 2); acc[et][lt] = MFMA16(bv[ks], a1, acc[et][lt]); }
#pragma unroll
            for (int ks = 0; ks < 2; ++ks) { const bf16x8 a2 = *(LAS const bf16x8*)(QW + (16 * lt + fr) * 144 + (32 * ks + 8 * fq) * 2); acc[et][lt] = MFMA16(bc[ks], a2, acc[et][lt]); } } }
#pragma unroll
    for (int lt = 0; lt < 4; ++lt) { const int lrow = 16 * lt + fr; const float inv = __builtin_amdgcn_rcpf(fmaxf(fabsf(den[lrow]), emt[lrow]));
#pragma unroll
        for (int et = 0; et < 2; ++et) acc[et][lt] = acc[et][lt] * inv; }
    __syncthreads();
    if (dir == 1) {
#pragma unroll
        for (int et = 0; et < 2; ++et)
#pragma unroll
            for (int lt = 0; lt < 4; ++lt) *(LAS f32x4*)(HM + (16 * lt + fr) * HMS + 16 * (2 * w4 + et) + 4 * fq) = acc[et][lt];
    }
    __syncthreads();
    if (dir == 0) {
#pragma unroll
        for (int et = 0; et < 2; ++et)
#pragma unroll
            for (int lt = 0; lt < 4; ++lt) { LAS f32x4* hp = (LAS f32x4*)(HM + (16 * lt + fr) * HMS + 16 * (2 * w4 + et) + 4 * fq); *hp = *hp + acc[et][lt]; }
    }
    __syncthreads();
    if (unext < NU) MC_LOAD_C(unext);
#pragma unroll
    for (int ps = 0; ps < 2; ++ps) { const int lrow = 8 * wave + 4 * ps + (lane >> 4), c8 = 8 * (lane & 15);
        const f32x4 va = *(LAS const f32x4*)(HM + lrow * HMS + c8), vb = *(LAS const f32x4*)(HM + lrow * HMS + c8 + 4);
        const float rstd = rsqrtf(row16_sum((va.x * va.x + va.y * va.y) + (va.z * va.z + va.w * va.w) + (vb.x * vb.x + vb.y * vb.y) + (vb.z * vb.z + vb.w * vb.w)) * (1.f / 128.f) + NORM_EPS);
        const v4u z = zo[ps]; const f32x4 ga = ghv[0] * rstd, gb = ghv[1] * rstd;
        v4u o; o.x = pk2(va.x * ga.x * sigmoid_fast(bf2f(z.x & 0xffffu)), va.y * ga.y * sigmoid_fast(bf2f(z.x >> 16))); o.y = pk2(va.z * ga.z * sigmoid_fast(bf2f(z.y & 0xffffu)), va.w * ga.w * sigmoid_fast(bf2f(z.y >> 16)));
        o.z = pk2(vb.x * gb.x * sigmoid_fast(bf2f(z.z & 0xffffu)), vb.y * gb.y * sigmoid_fast(bf2f(z.z >> 16))); o.w = pk2(vb.z * gb.z * sigmoid_fast(bf2f(z.w & 0xffffu)), vb.w * gb.w * sigmoid_fast(bf2f(z.w >> 16)));
        *(v4u*)(Y + (size_t)(row0 + lrow) * DM + 1536 + h * 128 + c8) = o; }
    unit = unext;
    }
#undef MC_DECODE
#undef MC_NEXT
#undef MC_LOAD_A
#undef MC_LOAD_C
}

#define MFMA32(a, b, c) __builtin_amdgcn_mfma_f32_32x32x16_bf16((a), (b), (c), 0, 0, 0)
typedef short v4i16_t __attribute__((ext_vector_type(4)));
__device__ __forceinline__ s16x4 tr_read(LAS const unsigned char* p) { return __builtin_bit_cast(s16x4, __builtin_amdgcn_ds_read_tr16_b64_v4i16((LAS v4i16_t*)p)); }
constexpr float ATT_THR = 8.f;
#define SCHED_FENCE() __builtin_amdgcn_sched_barrier(0)
constexpr int NO_MASK = 0x40000000;
template <int DQK, int KSB>
__device__ __forceinline__ void attn_scores(LAS const unsigned char* Kt, const bf16x8 (&qf)[DQK / 16], f32x16 (&p)[2], int r32, int hi) {
    constexpr int NK = DQK / 16;
    LAS const unsigned char* kp = Kt + r32 * KSB + hi * 16;
    f32x16 p0, p1;
#pragma unroll
    for (int e = 0; e < 16; ++e) { p0[e] = 0.f; p1[e] = 0.f; }
    bf16x8 kr[3][2];
#define QK_LOAD(ks) do { kr[(ks) % 3][0] = *(LAS const bf16x8*)(kp + (ks) * 32); kr[(ks) % 3][1] = *(LAS const bf16x8*)(kp + 32 * KSB + (ks) * 32); } while (0)
    QK_LOAD(0); QK_LOAD(1); SCHED_FENCE();
#pragma unroll
    for (int ks = 0; ks < NK; ++ks) {
        if (ks + 2 < NK) QK_LOAD(ks + 2);
        p0 = MFMA32(kr[ks % 3][0], qf[ks], p0); p1 = MFMA32(kr[ks % 3][1], qf[ks], p1); SCHED_FENCE();
    }
#undef QK_LOAD
    p[0] = p0; p[1] = p1;
}
template <int DV, bool MASK>
__device__ __forceinline__ void attn_softmax(f32x16 (&p)[2], f32x16 (&o)[DV / 32], float& m, float& l, float cs, int hi, int dq) {
    if (MASK) { if (__builtin_amdgcn_readfirstlane(dq) != NO_MASK) {
#pragma unroll
        for (int kvb = 0; kvb < 2; ++kvb)
#pragma unroll
            for (int e = 0; e < 16; ++e) { const int rel = dq + 32 * kvb + (e & 3) + 8 * (e >> 2) + 4 * hi; if (rel > 128 || rel < -128) p[kvb][e] = -INFINITY; } } }
    float mx;
    {
        float a0 = fmaxf(fmaxf(p[0][0], p[0][1]), p[0][2]), a1 = fmaxf(fmaxf(p[0][8], p[0][9]), p[0][10]), a2 = fmaxf(fmaxf(p[1][0], p[1][1]), p[1][2]), a3 = fmaxf(fmaxf(p[1][8], p[1][9]), p[1][10]);
        a0 = fmaxf(fmaxf(a0, p[0][3]), p[0][4]); a1 = fmaxf(fmaxf(a1, p[0][11]), p[0][12]); a2 = fmaxf(fmaxf(a2, p[1][3]), p[1][4]); a3 = fmaxf(fmaxf(a3, p[1][11]), p[1][12]);
        a0 = fmaxf(fmaxf(a0, p[0][5]), p[0][6]); a1 = fmaxf(fmaxf(a1, p[0][13]), p[0][14]); a2 = fmaxf(fmaxf(a2, p[1][5]), p[1][6]); a3 = fmaxf(fmaxf(a3, p[1][13]), p[1][14]);
        a0 = fmaxf(a0, p[0][7]); a1 = fmaxf(a1, p[0][15]); a2 = fmaxf(a2, p[1][7]); a3 = fmaxf(a3, p[1][15]);
        mx = fmaxf(fmaxf(a0, a1), fmaxf(a2, a3));
        const auto rr = __builtin_amdgcn_permlane32_swap(__float_as_uint(mx), __float_as_uint(mx), false, false);
        mx = fmaxf(__uint_as_float(rr[0]), __uint_as_float(rr[1])); }
    const float mn = fmaxf(m, mx * cs);
    if (__any(mn - m > ATT_THR)) {
        const float alpha = fexp2(m - mn); m = mn; l *= alpha;
#pragma unroll
        for (int d = 0; d < DV / 32; ++d)
#pragma unroll
            for (int e = 0; e < 16; ++e) o[d][e] *= alpha;
    }
    float ls0 = 0.f, ls1 = 0.f, ls2 = 0.f, ls3 = 0.f;
#pragma unroll
    for (int kvb = 0; kvb < 2; ++kvb)
#pragma unroll
        for (int e = 0; e < 16; e += 4) {
            const float e0 = fexp2(fmaf(p[kvb][e], cs, -m)), e1 = fexp2(fmaf(p[kvb][e + 1], cs, -m)), e2 = fexp2(fmaf(p[kvb][e + 2], cs, -m)), e3 = fexp2(fmaf(p[kvb][e + 3], cs, -m));
            p[kvb][e] = e0; p[kvb][e + 1] = e1; p[kvb][e + 2] = e2; p[kvb][e + 3] = e3; ls0 += e0; ls1 += e1; ls2 += e2; ls3 += e3; }
    l += (ls0 + ls1) + (ls2 + ls3);
}
template <int DV, int VRB>
__device__ __forceinline__ void attn_pv(LAS const unsigned char* Vt, const f32x16 (&p)[2], f32x16 (&o)[DV / 32], int vtb) {
    constexpr int ND = DV / 32;
    LAS const unsigned char* vb = Vt + vtb;
    bf16x8 pf[4];
#pragma unroll
    for (int i = 0; i < 4; ++i) { const int kvb = i >> 1, s = i & 1;
        v4u pw; pw.x = pk2(p[kvb][8 * s + 0], p[kvb][8 * s + 1]); pw.y = pk2(p[kvb][8 * s + 2], p[kvb][8 * s + 3]); pw.z = pk2(p[kvb][8 * s + 4], p[kvb][8 * s + 5]); pw.w = pk2(p[kvb][8 * s + 6], p[kvb][8 * s + 7]);
        pf[i] = __builtin_bit_cast(bf16x8, pw); }
    s16x4 va[2 * ND], vbq[2 * ND];
#define PV_LOAD(dst, i) do { _Pragma("unroll") for (int d = 0; d < ND; ++d) { LAS const unsigned char* vp = vb + (16 * (i)) * VRB + d * 64; dst[2 * d] = tr_read(vp); dst[2 * d + 1] = tr_read(vp + 8 * VRB); } } while (0)
#define PV_MMA(src, i) do { _Pragma("unroll") for (int d = 0; d < ND; ++d) { const bf16x8 vf = __builtin_shufflevector(src[2 * d], src[2 * d + 1], 0, 1, 2, 3, 4, 5, 6, 7); o[d] = MFMA32(vf, pf[i], o[d]); } } while (0)
    PV_LOAD(va, 0); SCHED_FENCE();
    PV_LOAD(vbq, 1); PV_MMA(va, 0); SCHED_FENCE();
    PV_LOAD(va, 2); PV_MMA(vbq, 1); SCHED_FENCE();
    PV_LOAD(vbq, 3); PV_MMA(va, 2); SCHED_FENCE();
    PV_MMA(vbq, 3); SCHED_FENCE();
#undef PV_LOAD
#undef PV_MMA
}
template <int DQK, int DV, int KSB, int VRB, bool MASK>
__device__ __forceinline__ void attn_tile(LAS const unsigned char* Kt, LAS const unsigned char* Vt, const bf16x8 (&qf)[DQK / 16], f32x16 (&o)[DV / 32], float& m, float& l, float cs, int r32, int hi, int vtb, int dq) {
    __builtin_amdgcn_sched_barrier(0);
    f32x16 p[2];
    attn_scores<DQK, KSB>(Kt, qf, p, r32, hi);
    attn_softmax<DV, MASK>(p, o, m, l, cs, hi, dq);
    attn_pv<DV, VRB>(Vt, p, o, vtb);
}
template <int DV>
__device__ __forceinline__ void attn_store(bf16* yrow  , const f32x16 (&o)[DV / 32], float l, int hi) {
    const float lt = l + __shfl_xor(l, 32), inv = 1.f / lt;
    unsigned char* yb = (unsigned char*)yrow + 16 * hi;
#pragma unroll
    for (int d = 0; d < DV / 32; ++d)
#pragma unroll
        for (int kk = 0; kk < 2; ++kk) {
            unsigned ax = pk2(o[d][8 * kk] * inv, o[d][8 * kk + 1] * inv), ay = pk2(o[d][8 * kk + 2] * inv, o[d][8 * kk + 3] * inv);
            unsigned bx = pk2(o[d][8 * kk + 4] * inv, o[d][8 * kk + 5] * inv), by = pk2(o[d][8 * kk + 6] * inv, o[d][8 * kk + 7] * inv);
            const auto rx = __builtin_amdgcn_permlane32_swap(ax, bx, false, false); const auto ry = __builtin_amdgcn_permlane32_swap(ay, by, false, false);
            *(v4u*)(yb + 64 * d + 32 * kk) = (v4u){rx[0], ry[0], rx[1], ry[1]};
        }
}
constexpr int MLA_KSB = 400, MLA_KT = 64 * MLA_KSB  , MLA_VRB = 320, MLA_VT = 64 * MLA_VRB  , MLA_BUF = MLA_KT + MLA_VT;
__device__ __forceinline__ void mla_unit(const bf16* QM, const bf16* KVM, const bf16* KR, bf16* Y, int b, int h, int qrow0, int ntiles, bool latent, LAS unsigned char* L, int tid) {
    const int wave = tid >> 6, lane = tid & 63, r32 = lane & 31, hi = lane >> 5;
    const int qrow = qrow0 + 32 * wave + r32;
    bf16x8 qf[12];
    { const bf16* qp = QM + (size_t)qrow * 768 + h * 192 + 8 * hi;
#pragma unroll
      for (int ks = 0; ks < 12; ++ks) qf[ks] = *(const bf16x8*)(qp + 16 * ks); }
    if (latent) {
        const int t = qrow - b * TB - CTX, prow = t >> 6, pcol = t & 63;
        int hl = hi; asm volatile("" : "+v"(hl));
#pragma unroll
        for (int j = 0; j < 8; ++j) { float cr, sr, cc, sc; rope_cs(prow, 8 * hl + j, cr, sr); rope_cs(pcol, 8 * hl + j, cc, sc);
            const float x1 = bf2f((unsigned short)qf[8][j]), x2 = bf2f((unsigned short)qf[9][j]), x3 = bf2f((unsigned short)qf[10][j]), x4 = bf2f((unsigned short)qf[11][j]);
            qf[8][j] = (short)(pk2(x1 * cr - x2 * sr, 0.f) & 0xffffu); qf[9][j] = (short)(pk2(x2 * cr + x1 * sr, 0.f) & 0xffffu);
            qf[10][j] = (short)(pk2(x3 * cc - x4 * sc, 0.f) & 0xffffu); qf[11][j] = (short)(pk2(x4 * cc + x3 * sc, 0.f) & 0xffffu); }
    }
    f32x16 o[4];
#pragma unroll
    for (int d = 0; d < 4; ++d)
#pragma unroll
        for (int e = 0; e < 16; ++e) o[d][e] = 0.f;
    float m = -INFINITY, l = 0.f;
    const float cs = 0.07216878364870322f * LOG2E;
    const unsigned kgo = (unsigned)(((tid >> 4) * 1024 + (tid & 15) * 8) * 2), klo = (unsigned)((tid >> 4) * MLA_KSB + (tid & 15) * 16);
    const unsigned rgo = (unsigned)(((tid >> 3) * 64 + (tid & 7) * 8) * 2), rlo = (unsigned)((tid >> 3) * MLA_KSB + 256 + (tid & 7) * 16);
    const unsigned vlo = (unsigned)((tid >> 4) * MLA_VRB + (tid & 15) * 16);
    const int vtb = (4 * hi + ((lane & 15) >> 2)) * MLA_VRB + (16 * ((lane >> 4) & 1) + 4 * (lane & 3)) * 2;
    const char* kvb0 = (const char*)(KVM + ((size_t)b * TB) * 1024 + h * 256);
    const char* krb0 = (const char*)(KR + ((size_t)b * TB) * 64);
    v4u kreg[3], vreg[2];
#define MLA_LOAD(t) do { const char* kb_ = kvb0 + (size_t)(t) * (64 * 1024 * 2); const char* rb_ = krb0 + (size_t)(t) * (64 * 64 * 2); \
        kreg[0] = *(const v4u*)(kb_ + kgo); kreg[1] = *(const v4u*)(kb_ + 32 * 1024 * 2 + kgo); kreg[2] = *(const v4u*)(rb_ + rgo); \
        vreg[0] = *(const v4u*)(kb_ + 256 + kgo); vreg[1] = *(const v4u*)(kb_ + 32 * 1024 * 2 + 256 + kgo); } while (0)
#define MLA_STORE(buf) do { LAS unsigned char* Kt_ = L + (buf) * MLA_BUF; LAS unsigned char* Vt_ = Kt_ + MLA_KT; \
        *(LAS v4u*)(Kt_ + klo) = kreg[0]; *(LAS v4u*)(Kt_ + 32 * MLA_KSB + klo) = kreg[1]; *(LAS v4u*)(Kt_ + rlo) = kreg[2]; \
        *(LAS v4u*)(Vt_ + vlo) = vreg[0]; *(LAS v4u*)(Vt_ + 32 * MLA_VRB + vlo) = vreg[1]; } while (0)
    const int half = wave >> 2;
    MLA_LOAD(0); MLA_STORE(0);
    if (ntiles > 1) { MLA_LOAD(1); MLA_STORE(1); }
    __syncthreads();
    if (half) __builtin_amdgcn_s_barrier();
    if (ntiles > 2) MLA_LOAD(2);
    int bcur = 0, bst = 2;
    for (int t = 0; t < ntiles; ++t) {
        LAS const unsigned char* Kt = L + bcur * MLA_BUF;
        f32x16 p[2];
        __builtin_amdgcn_sched_barrier(0);
        attn_scores<192, MLA_KSB>(Kt, qf, p, r32, hi);
        __syncthreads();
        attn_softmax<128, false>(p, o, m, l, cs, hi, 0);
        attn_pv<128, MLA_VRB>(Kt + MLA_KT, p, o, vtb);
        if (t + 2 < ntiles) { MLA_STORE(bst); if (t + 3 < ntiles) MLA_LOAD(t + 3); }
        __syncthreads();
        bcur = bcur == 2 ? 0 : bcur + 1; bst = bst == 2 ? 0 : bst + 1;
    }
    if (!half) __builtin_amdgcn_s_barrier();
#undef MLA_LOAD
#undef MLA_STORE
    attn_store<128>(Y + (size_t)qrow * DM + h * 128, o, l, hi);
}

constexpr int SWA_KSB = 144, SWA_KT = 64 * SWA_KSB  , SWA_VRB = 192, SWA_VT = 64 * SWA_VRB  , SWA_BUF = SWA_KT + SWA_VT;
__device__ __forceinline__ void swa_unit(const bf16* Z, const float* sink  , bf16* Y, int b, int g, int blk, int cblk, LAS unsigned char* L, int tid) {
    const int wave = tid >> 6, lane = tid & 63, r32 = lane & 31, hi = lane >> 5;
    const bool latent = blk >= 0;
    const int head = 8 * g + wave;
    const int qrow0 = b * TB + (latent ? CTX + 64 * blk : 64 * cblk);
    bf16x8 qf[2][4];
#pragma unroll
    for (int sb = 0; sb < 2; ++sb) { const bf16* qp = Z + (size_t)(qrow0 + 32 * sb + r32) * DINP + ZSQ + head * 64 + 8 * hi;
#pragma unroll
        for (int ks = 0; ks < 4; ++ks) qf[sb][ks] = *(const bf16x8*)(qp + 16 * ks); }
    f32x16 o[2][2];
#pragma unroll
    for (int sb = 0; sb < 2; ++sb)
#pragma unroll
        for (int d = 0; d < 2; ++d)
#pragma unroll
            for (int e = 0; e < 16; ++e) o[sb][d][e] = 0.f;
    const float sk = sink[head] * LOG2E;
    float m[2] = {sk, sk}, l[2] = {hi == 0 ? 1.f : 0.f, hi == 0 ? 1.f : 0.f};
    const float cs = 0.125f * LOG2E;
    int wlo = 0, nwin = 0;
    if (latent) { wlo = blk - 2 < 0 ? 0 : blk - 2; const int whi = blk + 2 > 127 ? 127 : blk + 2; nwin = whi - wlo + 1; }
    const int ntiles = 4 + nwin;
    const unsigned kgo = (unsigned)(((tid >> 3) * DINP + ZSK + (tid & 7) * 8) * 2), klo = (unsigned)((tid >> 3) * SWA_KSB + (tid & 7) * 16), vlo = (unsigned)((tid >> 3) * SWA_VRB + (tid & 7) * 16);
    const int vtb = (4 * hi + ((lane & 15) >> 2)) * SWA_VRB + (16 * ((lane >> 4) & 1) + 4 * (lane & 3)) * 2;
    const char* zb0 = (const char*)(Z + ((size_t)b * TB) * DINP + g * 64);
    v4u kreg, vreg;
#define SWA_ROW0(t) ((t) < 4 ? 64 * (t) : CTX + 64 * (wlo + (t) - 4))
#define SWA_LOAD(t) do { const char* zb_ = zb0 + (size_t)SWA_ROW0(t) * (DINP * 2); kreg = *(const v4u*)(zb_ + kgo); vreg = *(const v4u*)(zb_ + (ZSV - ZSK) * 2 + kgo); } while (0)
#define SWA_STORE(buf) do { LAS unsigned char* Kt_ = L + (buf) * SWA_BUF; *(LAS v4u*)(Kt_ + klo) = kreg; *(LAS v4u*)(Kt_ + SWA_KT + vlo) = vreg; } while (0)
    SWA_LOAD(0); SWA_STORE(0);
    __syncthreads();
    for (int t = 0; t < ntiles; ++t) {
        const bool more = t + 1 < ntiles;
        if (more) SWA_LOAD(t + 1);
        LAS const unsigned char* Kt = L + (t & 1) * SWA_BUF;
        const int kpos0 = 64 * (wlo + t - 4);
        const bool edge = t >= 4 && (wlo + t - 4 == blk - 2 || wlo + t - 4 == blk + 2);
#pragma unroll
        for (int sb = 0; sb < 2; ++sb) attn_tile<64, 64, SWA_KSB, SWA_VRB, true>(Kt, Kt + SWA_KT, qf[sb], o[sb], m[sb], l[sb], cs, r32, hi, vtb, edge ? kpos0 - (64 * blk + 32 * sb + r32) : NO_MASK);
        if (more) SWA_STORE((t + 1) & 1);
        __syncthreads();
    }
#undef SWA_ROW0
#undef SWA_LOAD
#undef SWA_STORE
#pragma unroll
    for (int sb = 0; sb < 2; ++sb) attn_store<64>(Y + (size_t)(qrow0 + 32 * sb + r32) * DM + 512 + head * 64, o[sb], l[sb], hi);
}

struct Args { const float* in[20]; float* out; unsigned char* ws; };
enum { IN_X = 0, IN_C, IN_CTX, IN_CCTX, IN_WMOD, IN_BMOD, IN_GN1, IN_GN2, IN_WIN, IN_GQ, IN_WUQ, IN_GKV, IN_WUKV, IN_SINK, IN_GBIAS, IN_GH, IN_WOUT, IN_W1, IN_W2, IN_GFINAL };

__global__ void __launch_bounds__(NTHR, 2) fwd_kernel(Args a) {
    extern __shared__ __attribute__((aligned(16))) unsigned char lds[];
    LAS unsigned char* L = (LAS unsigned char*)lds;
    const int tid0 = threadIdx.x;
    const int G = gridDim.x;
    for (int u = tid0; u < (LDS_BYTES - LDSCTL_OFF) / 4; u += NTHR) ((LAS unsigned*)(L + LDSCTL_OFF))[u] = 0u;
    __syncthreads();
    unsigned char* ws = a.ws;
    XcdBarrier bar = xcd_barrier_post((unsigned*)(ws + WS_CTL) + CW_BAR, (volatile LAS unsigned*)(L + MISC_OFF) + 8);

#define GRID_BAR(id_) do { XcdBarrier b2_ = bar; unsigned xx_ = bar.x; asm volatile("" : "+s"(xx_)); b2_.x = xx_; xcd_barrier(b2_); } while (0)
#define LAUNDER() int tid = tid0; asm volatile("" : "+v"(tid)); int wg = blockIdx.x; asm volatile("" : "+s"(wg)); const int lane = tid & 63, wave = __builtin_amdgcn_readfirstlane(tid >> 6), gw = wg * NWAVES + wave, NGW = G * NWAVES; (void)lane; (void)wave; (void)gw; (void)NGW
    float* MOD = (float*)(ws + WS_MOD);
    constexpr size_t WSET_STRIDE = WS_WSET1 - WS_WIN;
    bf16* X = (bf16*)(ws + WS_X); bf16* H = (bf16*)(ws + WS_H); float* SLAB = (float*)(ws + WS_SLAB);
    float *GATES = (float*)(ws + WS_GATES), *DN = (float*)(ws + WS_DN), *SC = (float*)(ws + WS_SC); bf16* DC = (bf16*)(ws + WS_DC);
    unsigned char* big = ws + WS_BIG;
    bf16 *Z = (bf16*)(big + BG_Z), *ZQN = (bf16*)(big + BG_ZQN), *ZKVN = (bf16*)(big + BG_ZKVN), *KR = (bf16*)(big + BG_KR), *QM = (bf16*)(big + BG_QM), *KVM = (bf16*)(big + BG_KVM), *Y = (bf16*)(big + BG_Y), *ACT = (bf16*)big;
    const ConvSrc csrc{a.in[IN_WIN], a.in[IN_WUQ], a.in[IN_WUKV], a.in[IN_WOUT], a.in[IN_W1], a.in[IN_W2], a.in[IN_GQ], a.in[IN_GKV]};

    unsigned long long* ROWSS = (unsigned long long*)(ws + WS_STAT); long long* BIAS = (long long*)(ws + WS_STAT + 3 * MiB);
    { LAUNDER(); for (int i = wg * NTHR + tid; i < (int)(8 * MiB / 8); i += G * NTHR) ROWSS[i] = 0ull;
      phase_mod(a.in[IN_C], a.in[IN_CCTX], a.in[IN_WMOD], a.in[IN_BMOD], MOD, L, wg, G, tid); }
    GRID_BAR(0);

    for (int l = 0; l < DEPTH; ++l) {
        const float* modl = MOD + (size_t)l * 5 * 12288;
        long long* biasl = BIAS + (size_t)l * 5 * BIASW;
        unsigned long long* rssA = ROWSS + (size_t)(2 * l) * MTOK;
        unsigned long long* rssB = ROWSS + (size_t)(2 * l + 1) * MTOK;
        unsigned long long* rs2 = (unsigned long long*)(ws + WS_RS2) + (size_t)(2 * l) * MTOK;
        const bool lastl = l == DEPTH - 1;
        unsigned char* wset = ws + (size_t)(l & 1) * WSET_STRIDE; unsigned char* wnext = ws + (size_t)((l + 1) & 1) * WSET_STRIDE;
        bf16 *WIN = (bf16*)(wset + WS_WIN), *WUQ = (bf16*)(wset + WS_WUQ), *WUKV = (bf16*)(wset + WS_WUKV), *WOUT = (bf16*)(wset + WS_WOUT), *W1 = (bf16*)(wset + WS_W1), *W2 = (bf16*)(wset + WS_W2);
        const ConvDst cdst{WIN, WUQ, WUKV, WOUT, W1, W2};
        const ConvDst cnext{(bf16*)(wnext + WS_WIN), (bf16*)(wnext + WS_WUQ), (bf16*)(wnext + WS_WUKV), (bf16*)(wnext + WS_WOUT), (bf16*)(wnext + WS_W1), (bf16*)(wnext + WS_W2)};
        const float* modn = MOD + (size_t)(l + 1) * 5 * 12288; long long* biasn = BIAS + (size_t)(l + 1) * 5 * BIASW;
        { LAUNDER(); LAS float* scr = (LAS float*)(L + wave * 8448); LAS float* tab = (LAS float*)(L + 8 * 8448);
          const bool g1tail = ((MTOK / 256) * (DINP / 256)) % G != 0, g4tail = ((MTOK / 256) * (DFF / 256)) % G != 0;
          const bool needA0 = l == 0 || !g1tail, needA1 = l == 0 || !g4tail;
          if (needA0 || needA1) { conv_load_tab(tab, modl, 3, tid);
              if (needA0) conv_A(csrc, cdst, l, 0, CV_A_SPLIT, gw, NGW, scr, tab, biasl, lane);
              if (needA1) { conv_A(csrc, cdst, l, CV_A_SPLIT, CV_I1, gw, NGW, scr, tab, biasl, lane); conv_B(csrc, cdst, l, 0, CV_B_SPLIT, gw, NGW, scr, lane); } }
          conv_B(csrc, cdst, l, CV_B_SPLIT, CV_I2, gw, NGW, scr, lane);
          conv_load_tab(tab, modl, 0, tid); conv_CD(csrc, cdst, l, gw, NGW, scr, tab, biasl, lane); __syncthreads(); }
        { LAUNDER();
          if (l == 0) phase_first(a.in[IN_X], a.in[IN_CTX], X, H, rssB, a.in[IN_GN1], modl, gw, NGW, lane);
          else phase_ctxfix(X, H, rssB, SLAB, MOD + (size_t)((l - 1) * 5 + 4) * 12288 + 5 * DM, a.in[IN_GN1] + l * DM, modl + (size_t)4 * 12288 + DM, gw, NGW, lane); }
        GRID_BAR(1);
        { LAUNDER(); pg8::Gemm g{H, WIN, MTOK, DINP, DM}; pg8::StaticOrder S; S.init(MTOK, DINP, DM, G, wg);
          pg8::EpiBf16<0, true, true> E{Z, DINP, GATES, rssB, biasl, BIASW, rs2, MTOK};
          pg8::gemm_phase<pg8::EpiBf16<0, true, true>, pg8::StaticOrder, true, true>(L, g, S, E);
          constexpr int NU = (MTOK / 256) * (DINP / 256); const int rem = NU % G;
          if (!lastl && rem != 0 && wg >= rem) { LAS float* scr = (LAS float*)(L + wave * 8448); LAS float* tab = (LAS float*)(L + 8 * 8448);
              conv_load_tab(tab, modn, 3, tid); conv_A(csrc, cnext, l + 1, 0, CV_A_SPLIT, (wg - rem) * NWAVES + wave, (G - rem) * NWAVES, scr, tab, biasn, lane); __syncthreads(); } }
        GRID_BAR(2);
        { LAUNDER(); phase_e1(Z, KR, wg, G, wave, lane); }
        { LAUNDER(); mlstm_a(Z, GATES, a.in[IN_GBIAS] + l * 16, DC, DN, SC, L, wg, G, tid); }
        GRID_BAR(3);
        { LAUNDER(); mlstm_scan(DC, DN, SC, wg, G, tid); }
        __syncthreads();
        { LAUNDER(); pg8::Gemm g{Z + ZQ, WUQ, MTOK, 768, 512}; pg8::StaticOrder S; S.init(MTOK, 768, 512, G, wg);
          pg8::EpiBf16<0, false, true, 512, false> E{QM, 768, nullptr, rs2, nullptr, 0};
          pg8::gemm_phase<pg8::EpiBf16<0, false, true, 512, false>, pg8::StaticOrder, true, true, DINP>(L, g, S, E); }
        { LAUNDER(); pg8::Gemm g{Z + ZKV, WUKV, MTOK, 1024, 256}; pg8::StaticOrder S; S.init(MTOK, 1024, 256, G, (wg + 116) % G);
          pg8::EpiBf16<0, false, true, 256, false> E{KVM, 1024, nullptr, rs2 + MTOK, nullptr, 0};
          pg8::gemm_phase<pg8::EpiBf16<0, false, true, 256, false>, pg8::StaticOrder, true, true, DINP>(L, g, S, E); }
        GRID_BAR(4);
#ifndef ATT_SWAP_MASK
#define ATT_SWAP_MASK 4
#endif
        for (int stage = 0; stage < 2; ++stage) {
        bool mla_now; { int wgs = blockIdx.x; asm volatile("" : "+s"(wgs)); mla_now = (stage == 0) != ((wgs & ATT_SWAP_MASK) != 0); }
        if (mla_now) { LAUNDER();
          const int n_mla = lastl ? 512 : 512 + 16;
          for (int u = wg; u < n_mla; u += G) {
            if (u < 512) { const int pair = 2 * (u & 7) + (u >> 8), qb = (u >> 3) & 31, b = pair >> 2, h = pair & 3; mla_unit(QM, KVM, KR, Y, b, h, b * TB + CTX + 256 * qb, 132, true, L, tid); }
            else { const int i = u - 512, b = i >> 2, h = i & 3; mla_unit(QM, KVM, KR, Y, b, h, b * TB, 4, false, L, tid); }
          } }
        else {
        { LAUNDER();
          const int n_swa = lastl ? 1024 : 1024 + 32;
          for (int u = (wg + 64) % G; u < n_swa; u += G) {
            if (u < 1024) swa_unit(Z, a.in[IN_SINK] + l * 16, Y, u >> 8, (u >> 7) & 1, u & 127, 0, L, tid);
            else { const int i = u - 1024; swa_unit(Z, a.in[IN_SINK] + l * 16, Y, i >> 3, (i >> 2) & 1, -1, i & 3, L, tid); }
          } }
        { LAUNDER();
          mlstm_c_phase((wg + 128) % G, G, lastl, Z, GATES, a.in[IN_GBIAS] + l * 16, a.in[IN_GH] + l * 512, DC, DN, SC, Y, L, tid); }
        }
        __syncthreads();
        }
        GRID_BAR(5);
        { LAUNDER(); pg8::Gemm g{Y, WOUT, MTOK, DM, DM}; pg8::LatentOrder S; S.init(DM, DM, G, wg, lastl ? 0 : 2);
          pg8::EpiResid E{X, modl, 2 * DM, SLAB, DM / 64, H, a.in[IN_GN2] + l * DM, modl + 4 * DM, rssA};
          pg8::gemm_phase<pg8::EpiResid, pg8::LatentOrder, true, true>(L, g, S, E); }
        GRID_BAR(6);
        if (!lastl) {
            { LAUNDER(); phase_ctxfix(X, H, rssA, SLAB, modl + (size_t)4 * 12288 + 2 * DM, a.in[IN_GN2] + l * DM, modl + (size_t)4 * 12288 + 4 * DM, gw, NGW, lane); }
            GRID_BAR(7);
        }
        { LAUNDER(); pg8::Gemm g{H, W1, MTOK, DFF, DM}; pg8::LatentOrder S; S.init(DFF, DM, G, wg, lastl ? 0 : 1);
          pg8::EpiBf16<2, false, true> E{ACT, DFF, nullptr, rssA, biasl + DINP, BIASW};
          pg8::gemm_phase<pg8::EpiBf16<2, false, true>, pg8::LatentOrder, true, true>(L, g, S, E);
          constexpr int NU = (MTOK / 256) * (DFF / 256); const int rem = NU % G;
          if (!lastl && rem != 0 && wg >= rem) { LAS float* scr = (LAS float*)(L + wave * 8448); LAS float* tab = (LAS float*)(L + 8 * 8448); const int worker = (wg - rem) * NWAVES + wave, nworkers = (G - rem) * NWAVES;
              conv_load_tab(tab, modn, 3, tid); conv_A(csrc, cnext, l + 1, CV_A_SPLIT, CV_I1, worker, nworkers, scr, tab, biasn, lane); conv_B(csrc, cnext, l + 1, 0, CV_B_SPLIT, worker, nworkers, scr, lane); __syncthreads(); } }
        GRID_BAR(8);
        { LAUNDER(); pg8::Gemm g{ACT, W2, MTOK, DM, DFF}; pg8::LatentOrder S; S.init(DM, DFF, G, wg, lastl ? 0 : 2);
          pg8::EpiResid E{X, modl, 5 * DM, SLAB, DFF / 64, lastl ? nullptr : H, a.in[IN_GN1] + (l + 1) * DM, MOD + (size_t)(l + 1) * 5 * 12288 + DM, ROWSS + (size_t)(2 * l + 3) * MTOK};
          pg8::gemm_phase<pg8::EpiResid, pg8::LatentOrder, true, true>(L, g, S, E); }
        GRID_BAR(9);
    }
    { LAUNDER(); phase_final(X, a.out, a.in[IN_GFINAL], gw, NGW, lane); }
}

extern "C" void kernel_launch(void* const* d_in, const int* in_sizes, int n_in, void* d_out, int out_size, void* d_ws, size_t ws_size, hipStream_t stream) {
    static int grid = 0;
    if (grid == 0) {
        if (n_in != 20 || in_sizes[0] != NB * SEQ * DM || out_size != NB * SEQ * DM || ws_size < WS_END) {
            fprintf(stderr, "kernel_launch: unexpected shapes (n_in %d, in0 %d, out %d, ws %zu, need %zu); nothing launched\n", n_in, n_in > 0 ? in_sizes[0] : -1, out_size, ws_size, (size_t)WS_END); grid = -1; return; }
        int dev = 0, cus = 0, per_cu = 0;
        if (hipGetDevice(&dev) != hipSuccess || hipDeviceGetAttribute(&cus, hipDeviceAttributeMultiprocessorCount, dev) != hipSuccess) { fprintf(stderr, "kernel_launch: device query failed\n"); grid = -1; return; }
        if (hipFuncSetAttribute((const void*)fwd_kernel, hipFuncAttributeMaxDynamicSharedMemorySize, LDS_BYTES) != hipSuccess) { fprintf(stderr, "kernel_launch: hipFuncSetAttribute failed\n"); grid = -1; return; }
        if (hipOccupancyMaxActiveBlocksPerMultiprocessor(&per_cu, (const void*)fwd_kernel, NTHR, LDS_BYTES) != hipSuccess || per_cu < 1)
            fprintf(stderr, "kernel_launch: note: occupancy query reports %d workgroups per CU\n", per_cu);
        (void)hipGetLastError();
        grid = cus;
    }
    if (grid < 0) return;
    if (hipMemsetAsync((char*)d_ws + WS_CTL, 0, CTL_ZERO_BYTES, stream) != hipSuccess) { fprintf(stderr, "kernel_launch: memset failed\n"); return; }
    Args a{};
    for (int i = 0; i < 20; ++i) a.in[i] = (const float*)d_in[i];
    a.out = (float*)d_out; a.ws = (unsigned char*)d_ws;
    hipLaunchKernelGGL(fwd_kernel, dim3(grid), dim3(NTHR), LDS_BYTES, stream, a);
    const hipError_t le = hipPeekAtLastError();
    if (le != hipSuccess) fprintf(stderr, "kernel_launch: launch failed: %s\n", hipGetErrorName(le));
}
```

```cpp
#include <hip/hip_runtime.h>
#include <cstdio>
#include <cstdint>
#include <cmath>


namespace pg8 {
#define PG8_LAS __attribute__((address_space(3)))
typedef unsigned short bf16_t;
typedef short bf16x8 __attribute__((ext_vector_type(8)));
typedef float f32x4 __attribute__((ext_vector_type(4)));
typedef unsigned u32x4 __attribute__((ext_vector_type(4)));
constexpr int BM = 256, BK = 64, HALF = 128, HTB = HALF * BK * 2  , STAGE_BYTES = 8 * HTB, NXCD = 8, WGM = 8;

__host__ __device__ __forceinline__ int lds_byte(int r, int c) { const int st = (r >> 4) * 2 + (c >> 5), rr = r & 15, cc = c & 31, ob = rr * 64 + cc * 2; return st * 1024 + (ob ^ (((ob >> 9) & 1) << 5)); }
__host__ __device__ __forceinline__ void stage_rc(int b, int& R, int& C) { const int st = b / 1024, sb = b % 1024, swz = sb ^ (((sb >> 9) & 1) << 5); R = (st >> 1) * 16 + swz / 64; C = (st & 1) * 32 + (swz % 64) / 2; }
__host__ __device__ __forceinline__ int perm32(int rho) { const int n = rho >> 4, i = rho & 15; return 8 * (i >> 2) + 4 * n + (i & 3); }

struct Unit { int pm, pn, k0, nt; };
struct Gemm { const bf16_t* A; const bf16_t* Bt; int M, N, K; };

struct StaticOrder {
    int nM, nN, nwg, G, c, fullnt;
    __host__ __device__ void init(int M, int N, int K, int G_, int c_) { nM = M / BM; nN = N / BM; nwg = nM * nN; G = G_; c = c_; fullnt = K / BK; }
    __host__ __device__ bool next(int i, Unit& u) const {
        const long L = (long)i * G + c; if (L >= nwg) return false;
        int wgid = (int)L; { const int q = nwg / NXCD, r = nwg % NXCD, xcd = wgid % NXCD, off = wgid / NXCD; wgid = (xcd < r ? xcd * (q + 1) : r * (q + 1) + (xcd - r) * q) + off; }
        const int nig = WGM * nN, gid = wgid / nig, fm = gid * WGM, gsz = (nM - fm) < WGM ? (nM - fm) : WGM;
        u.pm = fm + ((wgid % nig) % gsz); u.pn = (wgid % nig) / gsz; u.k0 = 0; u.nt = fullnt; return true;
    }
    __device__ __forceinline__ void a_ready(const Unit&) const {}
    __device__ __forceinline__ void done(const Unit&) const {}
};

struct LatentOrder {
    StaticOrder so; int nN, mode;
    __host__ __device__ void init(int N, int K, int G_, int c_, int mode_) { so.init(128 * BM, N, K, G_, c_); nN = N / BM; mode = mode_; }
    __host__ __device__ bool next(int i, Unit& u) const {
        if (so.next(i, u)) { u.pm = u.pm + u.pm / 32 + 1; return true; }
        const long L = (long)i * so.G + so.c - so.nwg;
        if (mode == 1) { if (L >= 4 * nN) return false; u.pm = 33 * (int)(L / nN); u.pn = (int)(L % nN); u.k0 = 0; u.nt = so.fullnt; return true; }
        if (mode == 2) { if (L >= 32 * nN) return false; const int tile = (int)(L >> 3), ks = (int)(L & 7); u.pm = 33 * (tile / nN); u.pn = tile % nN; u.nt = so.fullnt >> 3; u.k0 = ks * u.nt; return true; }
        return false;
    }
    __device__ __forceinline__ void a_ready(const Unit&) const {}
    __device__ __forceinline__ void done(const Unit&) const {}
};

__device__ __forceinline__ unsigned cvt_pk_bf16(float lo, float hi) { unsigned r; asm volatile("v_cvt_pk_bf16_f32 %0, %1, %2" : "=v"(r) : "v"(lo), "v"(hi)); return r; }
typedef float f32x2 __attribute__((ext_vector_type(2)));

typedef float f32x2v __attribute__((ext_vector_type(2))); typedef __bf16 bf16x2v __attribute__((ext_vector_type(2)));
__device__ __forceinline__ unsigned pkbf(float lo, float hi) { f32x2v v = {lo, hi}; bf16x2v b = __builtin_convertvector(v, bf16x2v); return __builtin_bit_cast(unsigned, b); }

template <int ACT, bool GATES, bool NORMED, int NW = 2048, bool BIASED = true> struct EpiBf16 {
    static constexpr bool PERM = true, AFTER_DRAIN = false;
    bf16_t* O; int ldc; float* gates; const unsigned long long* rowss; const long long* bias; int ldb; unsigned long long* rs2 = nullptr; int rs2_stride = 0;
    __device__ __forceinline__ void operator()(const f32x4 (&acc)[2][2][4][2], const Unit& u, int wr, int wc, int fr, int fq) const {
        const int row0 = u.pm * BM + wr * 64 + fr; const int col0 = u.pn * BM + wc * 32 + 8 * fq;
        f32x4 bv[2][2]; float tots[4];
        if (NORMED && BIASED) { const int bb = u.pm / 33, bp = (u.pm - bb * 33 == 0) ? 4 : bb; const long long* bptr = bias + (size_t)bp * ldb + col0;
#pragma unroll
            for (int bj = 0; bj < 2; ++bj)
#pragma unroll
                for (int n = 0; n < 2; ++n)
#pragma unroll
                    for (int e = 0; e < 4; ++e) bv[bj][n][e] = (float)bptr[bj * HALF + 4 * n + e] * 2.3283064365386963e-10f; }
#pragma unroll
        for (int ai = 0; ai < 2; ++ai)
#pragma unroll
            for (int m = 0; m < 4; ++m) { const int row = row0 + ai * HALF + m * 16; bf16_t* rowp = O + (size_t)row * ldc + col0;
                float rstd = 1.f; if (NORMED) rstd = __builtin_amdgcn_rsqf((float)rowss[row] * (1.f / (float)NW / 16777216.f) + 1e-6f);
                float ssq = 0.f;
#pragma unroll
                for (int bj = 0; bj < 2; ++bj) { f32x4 v0 = acc[ai][bj][m][0], v1 = acc[ai][bj][m][1];
                    if (NORMED) { if (BIASED) { v0 = v0 * rstd + bv[bj][0]; v1 = v1 * rstd + bv[bj][1]; } else { v0 = v0 * rstd; v1 = v1 * rstd; } }
                    if (GATES) ssq += ((v0[0] * v0[0] + v0[1] * v0[1]) + (v0[2] * v0[2] + v0[3] * v0[3])) + ((v1[0] * v1[0] + v1[1] * v1[1]) + (v1[2] * v1[2] + v1[3] * v1[3]));
                    if (GATES) { if (bj == 0 && u.pn == 12 && wc == 2 && fq < 2) { float* gp = gates + (size_t)row * 16 + 8 * fq; *(f32x4*)gp = v0; *(f32x4*)(gp + 4) = v1; } }
                    if (ACT == 2) {
#pragma unroll
                        for (int e = 0; e < 4; ++e) { float a = v0[e] > 0.f ? v0[e] : 0.f; v0[e] = a * a; float b = v1[e] > 0.f ? v1[e] : 0.f; v1[e] = b * b; } }
                    u32x4 w; w.x = pkbf(v0[0], v0[1]); w.y = pkbf(v0[2], v0[3]); w.z = pkbf(v1[0], v1[1]); w.w = pkbf(v1[2], v1[3]);
                    *(u32x4*)(rowp + bj * HALF) = w; }
                if (GATES) { if (u.pn < 3) {
                    const auto r1 = __builtin_amdgcn_permlane16_swap(__float_as_uint(ssq), __float_as_uint(ssq), false, false); ssq = __uint_as_float(r1[0]) + __uint_as_float(r1[1]);
                    const auto r2 = __builtin_amdgcn_permlane32_swap(__float_as_uint(ssq), __float_as_uint(ssq), false, false); tots[m] = __uint_as_float(r2[0]) + __uint_as_float(r2[1]);
                    if (m == 3) { const float mine = fq == 0 ? tots[0] : fq == 1 ? tots[1] : fq == 2 ? tots[2] : tots[3];
                        atomicAdd(rs2 + (size_t)(u.pn == 2 ? rs2_stride : 0) + (u.pm * BM + ai * HALF + wr * 64 + fq * 16 + fr), (unsigned long long)(mine * 16777216.f)); } } } }
    }
};
struct EpiResid {
    static constexpr bool PERM = false, AFTER_DRAIN = false;
    bf16_t* X; const float* modl; int goff; float* slab; int fullnt;
    bf16_t* hx; const float* ng; const float* nsc; unsigned long long* rowss;
    __device__ __forceinline__ void operator()(const f32x4 (&acc)[2][2][4][2], const Unit& u, int wr, int wc, int fr, int fq) const {
        const int bb = u.pm / 33, bp = (u.pm - bb * 33 == 0) ? 4 : bb;
        const int col0 = u.pn * BM + wc * 32 + 4 * fq;
        if (u.nt != fullnt) {
            float* sp0 = slab + ((size_t)(u.k0 / u.nt) * 1024 + bb * 256 + wr * 64 + fr) * 2048 + col0;
#pragma unroll
            for (int ai = 0; ai < 2; ++ai)
#pragma unroll
                for (int m = 0; m < 4; ++m) { float* sp = sp0 + (size_t)(ai * HALF + m * 16) * 2048;
#pragma unroll
                    for (int bj = 0; bj < 2; ++bj)
#pragma unroll
                        for (int n = 0; n < 2; ++n) *(f32x4*)(sp + bj * HALF + n * 16) = acc[ai][bj][m][n]; }
            return;
        }
        const float* gate = modl + (size_t)bp * 12288 + goff;
        f32x4 gv[2][2], gm[2][2];
#pragma unroll
        for (int bj = 0; bj < 2; ++bj)
#pragma unroll
            for (int n = 0; n < 2; ++n) { gv[bj][n] = *(const f32x4*)(gate + col0 + bj * HALF + n * 16);
                if (hx) { const f32x4 g4 = *(const f32x4*)(ng + col0 + bj * HALF + n * 16), s4 = *(const f32x4*)(nsc + (size_t)bp * 12288 + col0 + bj * HALF + n * 16); gm[bj][n] = g4 * (s4 + 1.f); } }
        const int hc = u.pn * BM + wc * 32 + ((fq & 1) ? 16 + 4 * (fq - 1) : 4 * fq);
        u32x4 xr[4][2]; float tots[4];
#define ER_LOAD(g) do { const bf16_t* xp_ = X + (size_t)(u.pm * BM + ((g) >> 2) * HALF + wr * 64 + ((g) & 3) * 16 + fr) * 2048 + hc; \
        _Pragma("unroll") for (int bj = 0; bj < 2; ++bj) xr[(g) & 3][bj] = *(const u32x4*)(xp_ + bj * HALF); } while (0)
        ER_LOAD(0); ER_LOAD(1); ER_LOAD(2); ER_LOAD(3);
        asm volatile("" ::: "memory");
#pragma unroll
        for (int g = 0; g < 8; ++g) { const int ai = g >> 2, m = g & 3; const int row = u.pm * BM + ai * HALF + wr * 64 + m * 16 + fr; float ss = 0.f;
#pragma unroll
            for (int bj = 0; bj < 2; ++bj) { const u32x4 raw = xr[g & 3][bj];
                const auto lx = __builtin_amdgcn_permlane16_swap(raw[0], raw[2], false, false); const auto ly = __builtin_amdgcn_permlane16_swap(raw[1], raw[3], false, false);
                unsigned xw[2][2], hw[2][2];
#pragma unroll
                for (int n = 0; n < 2; ++n) { const unsigned wx = lx[n], wy = ly[n];
                    f32x4 xv = {__uint_as_float(wx << 16), __uint_as_float(wx & 0xffff0000u), __uint_as_float(wy << 16), __uint_as_float(wy & 0xffff0000u)};
                    xv = xv + gv[bj][n] * acc[ai][bj][m][n]; xw[n][0] = pkbf(xv[0], xv[1]); xw[n][1] = pkbf(xv[2], xv[3]);
                    if (hx) { ss += (xv[0] * xv[0] + xv[1] * xv[1]) + (xv[2] * xv[2] + xv[3] * xv[3]); const f32x4 hv = xv * gm[bj][n]; hw[n][0] = pkbf(hv[0], hv[1]); hw[n][1] = pkbf(hv[2], hv[3]); } }
                { const auto sx = __builtin_amdgcn_permlane16_swap(xw[0][0], xw[1][0], false, false); const auto sy = __builtin_amdgcn_permlane16_swap(xw[0][1], xw[1][1], false, false);
                  *(u32x4*)(X + (size_t)row * 2048 + bj * HALF + hc) = (u32x4){sx[0], sy[0], sx[1], sy[1]}; }
                if (hx) { const auto rx = __builtin_amdgcn_permlane16_swap(hw[0][0], hw[1][0], false, false); const auto ry = __builtin_amdgcn_permlane16_swap(hw[0][1], hw[1][1], false, false);
                    *(u32x4*)(hx + (size_t)row * 2048 + bj * HALF + hc) = (u32x4){rx[0], ry[0], rx[1], ry[1]}; } }
            if (hx) {
                const auto r1 = __builtin_amdgcn_permlane16_swap(__float_as_uint(ss), __float_as_uint(ss), false, false); ss = __uint_as_float(r1[0]) + __uint_as_float(r1[1]);
                const auto r2 = __builtin_amdgcn_permlane32_swap(__float_as_uint(ss), __float_as_uint(ss), false, false); tots[m] = __uint_as_float(r2[0]) + __uint_as_float(r2[1]);
                if (m == 3) { const float mine = fq == 0 ? tots[0] : fq == 1 ? tots[1] : fq == 2 ? tots[2] : tots[3];
                    atomicAdd(rowss + (u.pm * BM + ai * HALF + wr * 64 + fq * 16 + fr), (unsigned long long)(mine * 16777216.f)); } }
            asm volatile("" ::: "memory");
            if (g + 4 < 8) { ER_LOAD(g + 4); asm volatile("" ::: "memory"); } }
#undef ER_LOAD
    }
};

template <class Epi, class Sched, bool ALIGN_EPI = false, bool SP2 = false, int LDA = 0>
__device__ __forceinline__ void gemm_phase(PG8_LAS unsigned char* lds, const Gemm g, const Sched& S, const Epi& E) {
    int tid_l = threadIdx.x; asm volatile("" : "+v"(tid_l));
    const int tid = tid_l, wid = __builtin_amdgcn_readfirstlane(tid >> 6), lane = tid & 63, wr = wid >> 2, wc = wid & 3, fr = lane & 15, fq = lane >> 4;
    const int K = g.K; const int lda = LDA ? LDA : K;
    unsigned voffA[2], voffB[2];
#pragma unroll
    for (int i = 0; i < 2; ++i) { int R, C; stage_rc(tid * 16 + i * 8192, R, C); const int Rb = Epi::PERM ? ((R & ~31) + perm32(R & 31)) : R;
        voffA[i] = (unsigned)(R * lda + C) * 2u; voffB[i] = (unsigned)(Rb * K + C) * 2u; }
    const size_t kstep = (size_t)(BK * 2);
    const size_t hstep = (size_t)HALF * K * 2;
    const size_t tstep = 2 * hstep;
    const size_t hstepA = LDA ? (size_t)HALF * LDA * 2 : hstep, tstepA = 2 * hstepA;
    const unsigned ldsw = (unsigned)wid * 1024u;
    const int aoff = lds_byte(wr * 64 + fr, fq * 8), boff = lds_byte(wc * 32 + fr, fq * 8);
#define PG8_SA(b, h) (((b) * 2 + (h)) * HTB)
#define PG8_SB(b, h) ((4 + (b) * 2 + (h)) * HTB)
#define PG8_STAGE(bufoff, gbase, voff) do { _Pragma("unroll") for (int _i = 0; _i < 2; ++_i) \
        __builtin_amdgcn_global_load_lds((const unsigned*)((const char*)(gbase) + (voff)[_i]), (PG8_LAS unsigned*)(lds + (bufoff) + ldsw + _i * 8192), 16, 0, 0); } while (0)
#define PG8_LDA(dst, b, h) do { _Pragma("unroll") for (int m = 0; m < 4; ++m) _Pragma("unroll") for (int k = 0; k < 2; ++k) dst[m][k] = *(const PG8_LAS bf16x8*)(lds + PG8_SA(b, h) + aoff + m * 2048 + k * 1024); } while (0)
#define PG8_LDB(dst, b, h) do { _Pragma("unroll") for (int n = 0; n < 2; ++n) _Pragma("unroll") for (int k = 0; k < 2; ++k) dst[n][k] = *(const PG8_LAS bf16x8*)(lds + PG8_SB(b, h) + boff + n * 2048 + k * 1024); } while (0)
#define PG8_MMA(ai, bj, At, Bt) do { __builtin_amdgcn_s_setprio(1); _Pragma("unroll") for (int m = 0; m < 4; ++m) _Pragma("unroll") for (int n = 0; n < 2; ++n) _Pragma("unroll") for (int k = 0; k < 2; ++k) \
        acc[ai][bj][m][n] = __builtin_amdgcn_mfma_f32_16x16x32_bf16(Bt[n][k], At[m][k], acc[ai][bj][m][n], 0, 0, 0); __builtin_amdgcn_s_setprio(0); } while (0)
#define PG8_WAIT_V(n) asm volatile("s_waitcnt vmcnt(" #n ")" ::: "memory")
#define PG8_WAIT_L(n) asm volatile("s_waitcnt lgkmcnt(" #n ")" ::: "memory")
#define PG8_BAR __builtin_amdgcn_s_barrier()
#define PG8_SCHED __builtin_amdgcn_sched_barrier(0)
    Unit cur, nxt; int ui = 0;
    if (!S.next(0, cur)) return;
    f32x4 acc[2][2][4][2];
#pragma unroll
    for (int a = 0; a < 2; ++a)
#pragma unroll
        for (int b = 0; b < 2; ++b)
#pragma unroll
            for (int m = 0; m < 4; ++m)
#pragma unroll
                for (int n = 0; n < 2; ++n) acc[a][b][m][n] = (f32x4){0.f, 0.f, 0.f, 0.f};
    bf16x8 At[4][2], B0[2][2], B1[2][2];
    int nt = cur.nt;
    const char* cA = (const char*)g.A + (size_t)cur.pm * tstepA + (size_t)cur.k0 * kstep; const char* cB = (const char*)g.Bt + (size_t)cur.pn * tstep + (size_t)cur.k0 * kstep;
    S.a_ready(cur);
    if constexpr (SP2) {
        PG8_STAGE(PG8_SB(0, 0), cB, voffB); PG8_STAGE(PG8_SB(0, 1), cB + hstep, voffB); PG8_STAGE(PG8_SA(0, 0), cA, voffA); PG8_STAGE(PG8_SA(0, 1), cA + hstepA, voffA);
        if (wr == 1) PG8_BAR;
        PG8_WAIT_V(2); PG8_BAR;
        PG8_STAGE(PG8_SB(1, 0), cB + kstep, voffB); PG8_STAGE(PG8_SA(1, 0), cA + kstep, voffA); PG8_STAGE(PG8_SB(1, 1), cB + hstep + kstep, voffB);
        PG8_WAIT_V(6); PG8_BAR;
    } else {
        PG8_STAGE(PG8_SB(0, 0), cB, voffB); PG8_STAGE(PG8_SA(0, 0), cA, voffA); PG8_STAGE(PG8_SB(0, 1), cB + hstep, voffB); PG8_STAGE(PG8_SA(0, 1), cA + hstepA, voffA);
        if (wr == 1) PG8_BAR;
        PG8_WAIT_V(4); PG8_BAR;
        PG8_STAGE(PG8_SB(1, 0), cB + kstep, voffB); PG8_STAGE(PG8_SA(1, 0), cA + kstep, voffA); PG8_STAGE(PG8_SB(1, 1), cB + hstep + kstep, voffB);
        PG8_WAIT_V(6); PG8_BAR;
    }
    for (;;) {
        const bool has_next = S.next(ui + 1, nxt);
        const char* nA = has_next ? (const char*)g.A + (size_t)nxt.pm * tstepA + (size_t)nxt.k0 * kstep : cA; const char* nB = has_next ? (const char*)g.Bt + (size_t)nxt.pn * tstep + (size_t)nxt.k0 * kstep : cB;
        for (int t = 0; t < nt; t += 2) {
            const bool last = (t == nt - 2);
            const char* a1 = cA + (size_t)(t + 1) * kstep;
            const char* a2 = last ? nA : cA + (size_t)(t + 2) * kstep; const char* b2 = last ? nB : cB + (size_t)(t + 2) * kstep;
            const char* a3 = a2 + kstep; const char* b3 = b2 + kstep;
            if (last && has_next) S.a_ready(nxt);
            if constexpr (SP2) {
            PG8_LDB(B0, 0, 0); PG8_LDB(B1, 0, 1); PG8_SCHED; PG8_LDA(At, 0, 0); PG8_STAGE(PG8_SA(1, 1), a1 + hstepA, voffA);
            PG8_WAIT_V(8); PG8_WAIT_L(0); PG8_BAR; PG8_MMA(0, 0, At, B0); PG8_MMA(0, 1, At, B1); PG8_BAR; PG8_SCHED;
            PG8_LDA(At, 0, 1); PG8_STAGE(PG8_SB(0, 0), b2, voffB); PG8_STAGE(PG8_SB(0, 1), b2 + hstep, voffB); PG8_STAGE(PG8_SA(0, 0), a2, voffA);
            PG8_WAIT_V(8); PG8_WAIT_L(0); PG8_BAR; PG8_MMA(1, 0, At, B0); PG8_MMA(1, 1, At, B1); PG8_BAR; PG8_SCHED;
            PG8_LDB(B0, 1, 0); PG8_LDB(B1, 1, 1); PG8_SCHED; PG8_LDA(At, 1, 0); PG8_STAGE(PG8_SA(0, 1), a2 + hstepA, voffA);
            PG8_WAIT_V(8); PG8_WAIT_L(0); PG8_BAR; PG8_MMA(0, 0, At, B0); PG8_MMA(0, 1, At, B1); PG8_BAR; PG8_SCHED;
            PG8_LDA(At, 1, 1); PG8_STAGE(PG8_SB(1, 0), b3, voffB); PG8_STAGE(PG8_SB(1, 1), b3 + hstep, voffB); PG8_STAGE(PG8_SA(1, 0), a3, voffA);
            PG8_WAIT_V(8); PG8_WAIT_L(0); PG8_BAR; PG8_MMA(1, 0, At, B0); PG8_MMA(1, 1, At, B1); PG8_BAR; PG8_SCHED;
            } else {
            PG8_LDB(B0, 0, 0); PG8_SCHED; PG8_LDA(At, 0, 0); PG8_STAGE(PG8_SA(1, 1), a1 + hstepA, voffA);
            PG8_WAIT_L(8); PG8_BAR; PG8_WAIT_L(0); PG8_MMA(0, 0, At, B0); PG8_BAR; PG8_SCHED;
            PG8_LDB(B1, 0, 1); PG8_STAGE(PG8_SB(0, 0), b2, voffB);
            PG8_BAR; PG8_WAIT_L(0); PG8_MMA(0, 1, At, B1); PG8_BAR;
            PG8_LDA(At, 0, 1); PG8_STAGE(PG8_SA(0, 0), a2, voffA);
            PG8_BAR; PG8_WAIT_L(0); PG8_MMA(1, 0, At, B0); PG8_BAR; PG8_SCHED;
            PG8_STAGE(PG8_SB(0, 1), b2 + hstep, voffB);
            PG8_WAIT_V(6); PG8_BAR; PG8_MMA(1, 1, At, B1); PG8_BAR;
            PG8_LDB(B0, 1, 0); PG8_SCHED; PG8_LDA(At, 1, 0); PG8_STAGE(PG8_SA(0, 1), a2 + hstepA, voffA);
            PG8_WAIT_L(8); PG8_BAR; PG8_WAIT_L(0); PG8_MMA(0, 0, At, B0); PG8_BAR; PG8_SCHED;
            PG8_LDB(B1, 1, 1); PG8_STAGE(PG8_SB(1, 0), b3, voffB);
            PG8_BAR; PG8_WAIT_L(0); PG8_MMA(0, 1, At, B1); PG8_BAR;
            PG8_LDA(At, 1, 1); PG8_STAGE(PG8_SA(1, 0), a3, voffA);
            PG8_BAR; PG8_WAIT_L(0); PG8_MMA(1, 0, At, B0); PG8_BAR; PG8_SCHED;
            PG8_STAGE(PG8_SB(1, 1), b3 + hstep, voffB);
            PG8_WAIT_V(6); PG8_BAR; PG8_MMA(1, 1, At, B1); PG8_BAR;
            }
        }
        if constexpr (ALIGN_EPI) { if (wr == 0) PG8_BAR; }
        if constexpr (!Epi::AFTER_DRAIN) { E(acc, cur, wr, wc, fr, fq); S.done(cur); }
        if (!has_next) break;
#pragma unroll
        for (int a = 0; a < 2; ++a)
#pragma unroll
            for (int b = 0; b < 2; ++b)
#pragma unroll
                for (int m = 0; m < 4; ++m)
#pragma unroll
                    for (int n = 0; n < 2; ++n) acc[a][b][m][n] = (f32x4){0.f, 0.f, 0.f, 0.f};
        cur = nxt; cA = nA; cB = nB; nt = cur.nt; ++ui;
        if constexpr (ALIGN_EPI) { if (wr == 1) PG8_BAR; }
    }
    PG8_WAIT_V(0);
    if constexpr (!ALIGN_EPI) { if (wr == 0) PG8_BAR; }
    PG8_BAR;
    if constexpr (Epi::AFTER_DRAIN) { E.fused(acc, cur, wr, wc, fr, fq, lds, wid, lane); S.done(cur); }
#undef PG8_SA
#undef PG8_SB
#undef PG8_STAGE
#undef PG8_LDA
#undef PG8_LDB
#undef PG8_MMA
#undef PG8_WAIT_V
#undef PG8_WAIT_L
#undef PG8_BAR
#undef PG8_SCHED
}
}
#define LAS __attribute__((address_space(3)))
typedef __attribute__((address_space(1))) unsigned gu32;
#define XB_TMO      128
#define XB_XCNT(j)  (256  + 64 * (j))
#define XB_XSUB(j)  (1280 + 64 * (j))
#define XB_XGEN(j)  (2304 + 64 * (j))
#define XB_TOP      3328
#define XB_TOPGEN   3392
#define XCD_BAR_WORDS 3456
#define XB_SPIN_CAP (1u << 18)

__device__ __forceinline__ unsigned xb_ld(unsigned* p)              { return __hip_atomic_load(p, __ATOMIC_RELAXED, __HIP_MEMORY_SCOPE_AGENT); }
__device__ __forceinline__ unsigned xb_add(unsigned* p, unsigned v) { return __hip_atomic_fetch_add(p, v, __ATOMIC_RELAXED, __HIP_MEMORY_SCOPE_AGENT); }
__device__ __forceinline__ unsigned xb_xcc_id() { return (unsigned)__builtin_amdgcn_s_getreg((3 << 11) | 20) & 0xFu; }
#define XB_SPIN(cond, bar) do { unsigned _sp = 0; while (cond) { __builtin_amdgcn_s_sleep(1); \
    if ((++_sp & 255u) == 0u) { if (xb_ld(&(bar)[XB_TMO])) break; if (_sp > XB_SPIN_CAP) { atomicAdd(&(bar)[XB_TMO], 1u); break; } } } } while (0)

struct XcdBarrier {
    unsigned* bar; unsigned x;
    volatile LAS unsigned* st;
};

__device__ __forceinline__ XcdBarrier xcd_barrier_post(unsigned* bar, volatile LAS unsigned* st) {
    XcdBarrier b; b.bar = bar; b.x = xb_xcc_id(); b.st = st;
    if (threadIdx.x == 0) (void)xb_add(&bar[XB_XCNT(b.x)], 1u);
    return b;
}
__device__ __forceinline__ void xcd_barrier_complete(unsigned* bar, unsigned x, unsigned& nloc, unsigned& nx) {
    const unsigned G = gridDim.x * gridDim.y * gridDim.z;
    unsigned sum, cnt, mine, sp = 0u;
    for (;;) {
        sum = 0u; cnt = 0u; mine = 0u;
#pragma unroll
        for (unsigned j = 0; j < 16; ++j) { const unsigned c = xb_ld(&bar[XB_XCNT(j)]); sum += c; cnt += (c > 0u) ? 1u : 0u; mine = (j == x) ? c : mine; }
        if (sum == G) break;
        __builtin_amdgcn_s_sleep(1);
        if ((++sp & 255u) == 0u) { if (xb_ld(&bar[XB_TMO])) break; if (sp > XB_SPIN_CAP) { atomicAdd(&bar[XB_TMO], 1u); break; } }
    }
    nloc = mine > 0u ? mine : 1u; nx = cnt > 0u ? cnt : 1u;
}

__device__ __forceinline__ void xcd_barrier(const XcdBarrier& b) {
    asm volatile("s_waitcnt vmcnt(0)" ::: "memory");
    __syncthreads();
    if (threadIdx.x == 0) {
        unsigned* bar = b.bar;
        __builtin_amdgcn_s_waitcnt(0);
        unsigned nloc = b.st[0], nx = b.st[1];
        if (nloc == 0u) { xcd_barrier_complete(bar, b.x, nloc, nx); b.st[0] = nloc; b.st[1] = nx; }
        const unsigned old = xb_add(&bar[XB_XSUB(b.x)], 1u);
        const unsigned gen = old / nloc;
        if (old + 1u == (gen + 1u) * nloc) {
            __builtin_amdgcn_fence(__ATOMIC_RELEASE, "agent");
            asm volatile("s_waitcnt vmcnt(0)" ::: "memory");
            const unsigned og = xb_add(&bar[XB_TOP], 1u);
            const unsigned tg = og / nx;
            if (og + 1u == (tg + 1u) * nx) xb_add(&bar[XB_TOPGEN], 1u);
            else XB_SPIN(xb_ld(&bar[XB_TOPGEN]) == tg, bar);
            __builtin_amdgcn_fence(__ATOMIC_ACQUIRE, "agent");
            xb_add(&bar[XB_XGEN(b.x)], 1u);
            asm volatile("s_waitcnt vmcnt(0)" ::: "memory");
        } else {
            XB_SPIN(xb_ld(&bar[XB_XGEN(b.x)]) == gen, bar);
            __builtin_amdgcn_fence(__ATOMIC_ACQUIRE, "agent");
            asm volatile("s_waitcnt vmcnt(0)" ::: "memory");
        }
    }
    __syncthreads();
}

typedef unsigned short bf16;
typedef unsigned v4u __attribute__((ext_vector_type(4)));
typedef unsigned v2u __attribute__((ext_vector_type(2)));
typedef float f32x4 __attribute__((ext_vector_type(4)));
typedef float f32x16 __attribute__((ext_vector_type(16)));
typedef short bf16x8 __attribute__((ext_vector_type(8)));
typedef short s16x4 __attribute__((ext_vector_type(4)));
#define GAS __attribute__((address_space(1)))

constexpr int NWAVES = 8, NTHR = 512;
constexpr int NB = 4, SEQ = 8192, CTX = 256, TB = SEQ + CTX, MTOK = NB * TB, DM = 2048, DFF = 8192, DIN = 3664, DINP = 3840, DEPTH = 4;
constexpr int ZQ = 0, ZKV = 512, ZR = 768, ZSQ = 832, ZSK = 1856, ZSV = 1984, ZMQ = 2112, ZMK = 2368, ZMV = 2624, ZMG = 3136, ZMO = 3152;
constexpr int NSTEP = 132;
constexpr float NORM_EPS = 1e-6f;
constexpr float LOG2E = 1.4426950408889634f;

constexpr size_t MiB = 1u << 20;
constexpr size_t WS_CTL = 0, CTL_ZERO_BYTES = 1 * MiB;
constexpr size_t WS_MOD = 1 * MiB, WS_WIN = 2 * MiB, WS_WUQ = 17 * MiB, WS_WUKV = 18 * MiB, WS_WOUT = 19 * MiB, WS_W1 = 27 * MiB, WS_W2 = 59 * MiB;
constexpr size_t WS_X = 91 * MiB, WS_H = 355 * MiB, WS_GATES = 487 * MiB, WS_DC = 490 * MiB, WS_DN = 622 * MiB, WS_SC = 624 * MiB, WS_BIG = 625 * MiB;
constexpr size_t BG_Z = 0, BG_ZQN = 248 * MiB, BG_ZKVN = 281 * MiB, BG_KR = 298 * MiB, BG_QM = 303 * MiB, BG_KVM = 353 * MiB, BG_Y = 419 * MiB, BG_END = 551 * MiB;
constexpr size_t WS_SLAB = WS_BIG + BG_END;
constexpr size_t WS_STAT = WS_SLAB + 64 * MiB;
constexpr size_t WS_RS2 = WS_STAT + 5 * MiB;
constexpr size_t WS_WSET1 = WS_STAT + 8 * MiB;
constexpr size_t WSET_BYTES = 89 * MiB;
constexpr size_t WS_END = WS_WSET1 + WSET_BYTES;
constexpr int BIASW = DINP + DFF;
static_assert((size_t)MTOK * DM * 4 == 264 * MiB && (size_t)MTOK * DFF * 2 <= BG_END && (size_t)MTOK * DINP * 2 <= BG_ZQN, "ws map");
constexpr int CW_BAR = 4096;

constexpr int RING_BYTES = 131072, LDSCTL_OFF = 138240  , MISC_OFF = LDSCTL_OFF + 320, LDS_BYTES = 147456;

#define LDS_WAIT() asm volatile("s_waitcnt lgkmcnt(0)" ::: "memory")
__device__ __forceinline__ float bf2f(unsigned h) { return __uint_as_float(h << 16); }
__device__ __forceinline__ unsigned pk2(float lo, float hi) { return pg8::pkbf(lo, hi); }
__device__ __forceinline__ float wave_sum(float v) {
#pragma unroll
    for (int o = 1; o < 64; o <<= 1) v += __shfl_xor(v, o);
    return v;
}
__device__ __forceinline__ float wave_max(float v) {
#pragma unroll
    for (int o = 1; o < 64; o <<= 1) v = fmaxf(v, __shfl_xor(v, o));
    return v;
}
__device__ __forceinline__ float fexp2(float x) { return __builtin_amdgcn_exp2f(x); }
__device__ __forceinline__ float fexp(float x) { return __builtin_amdgcn_exp2f(x * LOG2E); }
__device__ __forceinline__ float sigmoidf_(float x) { return 1.f / (1.f + fexp(-x)); }
__device__ __forceinline__ float sigmoid_fast(float x) { return __builtin_amdgcn_rcpf(1.f + fexp(-x)); }
__device__ __forceinline__ float row16_sum(float v) {
    v += __int_as_float(__builtin_amdgcn_mov_dpp(__float_as_int(v), 0xB1, 0xf, 0xf, true));
    v += __int_as_float(__builtin_amdgcn_mov_dpp(__float_as_int(v), 0x4E, 0xf, 0xf, true));
    v += __int_as_float(__builtin_amdgcn_mov_dpp(__float_as_int(v), 0x124, 0xf, 0xf, true));
    v += __int_as_float(__builtin_amdgcn_mov_dpp(__float_as_int(v), 0x128, 0xf, 0xf, true));
    return v;
}
__device__ __forceinline__ float logsigf_(float x) { return fminf(x, 0.f) - log1pf(expf(-fabsf(x))); }
__device__ __forceinline__ float logsig_fast(float x) { return fminf(x, 0.f) - 0.6931471805599453f * __builtin_amdgcn_logf(1.f + fexp(-fabsf(x))); }
__device__ __forceinline__ void rope_cs(int pos, int i, float& c, float& s) {
    const float inv = fexp2(-0.8304820237218406f * (float)i);
    float rev = (float)pos * inv * 0.15915494309189535f; rev -= floorf(rev);
    c = __builtin_amdgcn_cosf(rev); s = __builtin_amdgcn_sinf(rev);
}

__device__ __forceinline__ void phase_mod(const float* c, const float* c_ctx, const float* w_mod, const float* b_mod, float* MOD, LAS unsigned char* L, int wg, int G, int tid) {
    LAS float* sv = (LAS float*)L;
    LAS float* red = (LAS float*)(L + 40960);
    for (int i = tid; i < 5 * DM; i += NTHR) { const int b = i / DM, k = i - b * DM; const float v = b < 4 ? c[b * DM + k] : c_ctx[k]; sv[i] = v / (1.f + expf(-v)); }
    __syncthreads();
    const int wave = tid >> 6, lane = tid & 63;
    for (int item = wg; item < DEPTH * 192; item += G) {
        const int l = item / 192, cg = item - l * 192;
        const float* W = w_mod + (size_t)l * DM * 12288 + cg * 64 + lane;
        float a0 = 0.f, a1 = 0.f, a2 = 0.f, a3 = 0.f, a4 = 0.f;
        const int k0 = wave * 256;
#pragma unroll 8
        for (int k = k0; k < k0 + 256; ++k) { const float w = W[(size_t)k * 12288];
            a0 += sv[k] * w; a1 += sv[DM + k] * w; a2 += sv[2 * DM + k] * w; a3 += sv[3 * DM + k] * w; a4 += sv[4 * DM + k] * w; }
        red[(wave * 5 + 0) * 64 + lane] = a0; red[(wave * 5 + 1) * 64 + lane] = a1; red[(wave * 5 + 2) * 64 + lane] = a2; red[(wave * 5 + 3) * 64 + lane] = a3; red[(wave * 5 + 4) * 64 + lane] = a4;
        __syncthreads();
        if (tid < 320) { const int b = tid >> 6, ln = tid & 63; float s = 0.f;
#pragma unroll
            for (int w = 0; w < 8; ++w) s += red[(w * 5 + b) * 64 + ln];
            MOD[(size_t)(l * 5 + b) * 12288 + cg * 64 + ln] = s + b_mod[l * 12288 + cg * 64 + ln]; }
        __syncthreads();
    }
}

__device__ __forceinline__ void transpose_item(const float* W, int K, int N, int NP, bf16* WT, LAS float* scr, int item, int lane, const LAS float* tab, long long* bias, int ldb, const float* kscale = nullptr) {
    const int nblk = NP / 32, kb = item / nblk, nb = item - kb * nblk, k0 = 64 * kb, n0 = 32 * nb;
    const int n = n0 + (lane & 31); const bool okn = n < N;
    float wv_[32];
    const float* wp = W + (size_t)(k0 + (lane >> 5)) * N + (okn ? n : 0);
#pragma unroll
    for (int i = 0; i < 32; ++i) wv_[i] = wp[(size_t)(2 * i) * N];
#pragma unroll
    for (int i = 0; i < 32; ++i) { if (!okn) wv_[i] = 0.f; if (kscale != nullptr) wv_[i] *= kscale[k0 + 2 * i + (lane >> 5)]; scr[(2 * i + (lane >> 5)) * 33 + (lane & 31)] = wv_[i]; }
    if (tab != nullptr) {
        const LAS float* tp = tab + k0 + (lane >> 5);
#pragma unroll
        for (int bp = 0; bp < 5; ++bp) { float s = 0.f;
#pragma unroll
            for (int i = 0; i < 32; ++i) s += tp[bp * 2048 + 2 * i] * wv_[i];
            s += __shfl_xor(s, 32);
            if (lane < 32) atomicAdd((unsigned long long*)(bias + (size_t)bp * ldb + n), (unsigned long long)(long long)(s * 4294967296.f)); }
    }
    LDS_WAIT(); asm volatile("" ::: "memory");
    const int c = lane & 7;
#pragma unroll
    for (int j = 0; j < 4; ++j) { const int nn = (lane >> 3) + 8 * j; const LAS float* s = scr + (8 * c) * 33 + nn;
        v4u o; o.x = pk2(s[0 * 33], s[1 * 33]); o.y = pk2(s[2 * 33], s[3 * 33]); o.z = pk2(s[4 * 33], s[5 * 33]); o.w = pk2(s[6 * 33], s[7 * 33]);
        *(v4u*)(WT + (size_t)(n0 + nn) * K + k0 + 8 * c) = o; }
    LDS_WAIT(); asm volatile("" ::: "memory");
}
struct ConvSrc { const float *w_in, *w_uq, *w_ukv, *w_out, *w1, *w2, *g_q, *g_kv; };
struct ConvDst { bf16 *win, *wuq, *wukv, *wout, *w1, *w2; };
constexpr int CV_I1 = (DM / 64) * (DFF / 32), CV_I2 = (DFF / 64) * (DM / 32), CV_IOUT = (DM / 64) * (DM / 32), CV_IIN = (DM / 64) * (DINP / 32), CV_IUQ = (512 / 64) * (768 / 32), CV_IUKV = (256 / 64) * (1024 / 32);
constexpr int CV_A_SPLIT = 4352, CV_B_SPLIT = 6400;
__device__ __forceinline__ void conv_load_tab(LAS float* tab, const float* modl, int which  , int tid) {
    __syncthreads();
    for (int i = tid; i < 5 * DM; i += NTHR) { const int bp = i / DM, k = i - bp * DM; tab[i] = modl[(size_t)bp * 12288 + which * DM + k]; }
    __syncthreads();
}
__device__ __forceinline__ void conv_A(const ConvSrc s, const ConvDst d, int l, int lo, int hi, int worker, int nworkers, LAS float* scr, const LAS float* tab, long long* biasl, int lane) {
    for (int it = lo + worker; it < hi; it += nworkers) transpose_item(s.w1 + (size_t)l * DM * DFF, DM, DFF, DFF, d.w1, scr, it, lane, tab, biasl + DINP, BIASW);
}
__device__ __forceinline__ void conv_B(const ConvSrc s, const ConvDst d, int l, int lo, int hi, int worker, int nworkers, LAS float* scr, int lane) {
    for (int it = lo + worker; it < hi; it += nworkers) transpose_item(s.w2 + (size_t)l * DFF * DM, DFF, DM, DM, d.w2, scr, it, lane, nullptr, nullptr, 0);
}
__device__ __forceinline__ void conv_CD(const ConvSrc s, const ConvDst d, int l, int worker, int nworkers, LAS float* scr, const LAS float* tab, long long* biasl, int lane) {
    for (int it = worker; it < CV_IOUT + CV_IIN + CV_IUQ + CV_IUKV; it += nworkers) {
        int r = it;
        if (r < CV_IIN) { transpose_item(s.w_in + (size_t)l * DM * DIN, DM, DIN, DINP, d.win, scr, r, lane, tab, biasl, BIASW); continue; } r -= CV_IIN;
        if (r < CV_IOUT) { transpose_item(s.w_out + (size_t)l * DM * DM, DM, DM, DM, d.wout, scr, r, lane, nullptr, nullptr, 0); continue; } r -= CV_IOUT;
        if (r < CV_IUQ) { transpose_item(s.w_uq + (size_t)l * 512 * 768, 512, 768, 768, d.wuq, scr, r, lane, nullptr, nullptr, 0, s.g_q + l * 512); continue; } r -= CV_IUQ;
        transpose_item(s.w_ukv + (size_t)l * 256 * 1024, 256, 1024, 1024, d.wukv, scr, r, lane, nullptr, nullptr, 0, s.g_kv + l * 256);
    }
}

__device__ __forceinline__ void phase_first(const float* xin, const float* ctxin, bf16* X, bf16* HX, unsigned long long* rowss, const float* g, const float* modl, int gw, int NGW, int lane) {
    const int rs = (int)(((long long)MTOK * gw) / NGW), re = (int)(((long long)MTOK * (gw + 1)) / NGW);
    f32x4 gm[4][2], cur[4][2], nxt[4][2]; int bpc = -1;
#define PF_LOAD(dst, r_) do { const int b_ = (r_) / TB, p_ = (r_) - b_ * TB; const float* s_ = (p_ < CTX ? ctxin + (size_t)(b_ * CTX + p_) * DM : xin + (size_t)(b_ * SEQ + p_ - CTX) * DM) + 8 * lane; \
        _Pragma("unroll") for (int j = 0; j < 4; ++j) { dst[j][0] = *(const f32x4*)(s_ + 512 * j); dst[j][1] = *(const f32x4*)(s_ + 512 * j + 4); } } while (0)
    if (rs < re) PF_LOAD(cur, rs);
    for (int r = rs; r < re; ++r) {
        if (r + 1 < re) PF_LOAD(nxt, r + 1);
        const int b = r / TB, p = r - b * TB, bp = p < CTX ? 4 : b;
        if (bp != bpc) { bpc = bp; const float* gp = g + 8 * lane; const float* scp = modl + (size_t)bp * 12288 + DM + 8 * lane;
#pragma unroll
            for (int j = 0; j < 4; ++j)
#pragma unroll
                for (int h = 0; h < 2; ++h) gm[j][h] = *(const f32x4*)(gp + 512 * j + 4 * h) * (*(const f32x4*)(scp + 512 * j + 4 * h) + 1.f); }
        float ss = 0.f;
#pragma unroll
        for (int j = 0; j < 4; ++j)
#pragma unroll
            for (int h = 0; h < 2; ++h) { const f32x4 v = cur[j][h]; ss += (v.x * v.x + v.y * v.y) + (v.z * v.z + v.w * v.w); }
        ss = wave_sum(ss); if (lane == 0) rowss[r] = (unsigned long long)(ss * 16777216.f);
        bf16* xo = X + (size_t)r * DM + 8 * lane; bf16* ho = HX + (size_t)r * DM + 8 * lane;
#pragma unroll
        for (int j = 0; j < 4; ++j) { const f32x4 v0 = cur[j][0], v1 = cur[j][1], h0 = v0 * gm[j][0], h1 = v1 * gm[j][1];
            *(v4u*)(xo + 512 * j) = (v4u){pk2(v0.x, v0.y), pk2(v0.z, v0.w), pk2(v1.x, v1.y), pk2(v1.z, v1.w)};
            *(v4u*)(ho + 512 * j) = (v4u){pk2(h0.x, h0.y), pk2(h0.z, h0.w), pk2(h1.x, h1.y), pk2(h1.z, h1.w)}; }
#pragma unroll
        for (int j = 0; j < 4; ++j) { cur[j][0] = nxt[j][0]; cur[j][1] = nxt[j][1]; }
    }
#undef PF_LOAD
}
__device__ __forceinline__ void phase_ctxfix(bf16* X, bf16* HX, unsigned long long* rowss, const float* slab, const float* fixgate, const float* g, const float* nsc, int gw, int NGW, int lane) {
    for (int cr = gw; cr < NB * CTX; cr += NGW) {
        const int b = cr / CTX, p = cr - b * CTX; const size_t r = (size_t)b * TB + p;
        unsigned long long* xr = (unsigned long long*)(X + r * DM) + lane; const f32x4* sp = (const f32x4*)(slab + (size_t)cr * DM) + lane; const f32x4* fg = (const f32x4*)fixgate + lane;
        f32x4 v[8]; float ss = 0.f;
#pragma unroll
        for (int j = 0; j < 8; ++j) { f32x4 acc = sp[64 * j];
#pragma unroll
            for (int s = 1; s < 8; ++s) acc = acc + sp[(size_t)s * (1024 * DM / 4) + 64 * j];
            const unsigned long long xw = xr[64 * j]; const unsigned w0 = (unsigned)xw, w1 = (unsigned)(xw >> 32);
            v[j] = (f32x4){__uint_as_float(w0 << 16), __uint_as_float(w0 & 0xffff0000u), __uint_as_float(w1 << 16), __uint_as_float(w1 & 0xffff0000u)} + fg[64 * j] * acc; ss += (v[j].x * v[j].x + v[j].y * v[j].y) + (v[j].z * v[j].z + v[j].w * v[j].w); }
        ss = wave_sum(ss); if (lane == 0) rowss[r] = (unsigned long long)(ss * 16777216.f);
        const f32x4* gp = (const f32x4*)g + lane; const f32x4* scp = (const f32x4*)nsc + lane;
        unsigned long long* o8 = (unsigned long long*)(HX + r * DM) + lane;
#pragma unroll
        for (int j = 0; j < 8; ++j) { xr[64 * j] = (unsigned long long)pk2(v[j].x, v[j].y) | ((unsigned long long)pk2(v[j].z, v[j].w) << 32); const f32x4 gg = gp[64 * j], sc = scp[64 * j];
            o8[64 * j] = (unsigned long long)pk2(v[j].x * gg.x * (1.f + sc.x), v[j].y * gg.y * (1.f + sc.y)) | ((unsigned long long)pk2(v[j].z * gg.z * (1.f + sc.z), v[j].w * gg.w * (1.f + sc.w)) << 32); }
    }
}
__device__ __forceinline__ void phase_final(const bf16* X, float* out, const float* g, int gw, int NGW, int lane) {
    const int qs = (int)(((long long)NB * SEQ * gw) / NGW), qe = (int)(((long long)NB * SEQ * (gw + 1)) / NGW);
    f32x4 gg[4][2]; v4u cur[4], nxt[4];
#pragma unroll
    for (int j = 0; j < 4; ++j) { gg[j][0] = *(const f32x4*)(g + 512 * j + 8 * lane); gg[j][1] = *(const f32x4*)(g + 512 * j + 8 * lane + 4); }
#define FN_LOAD(dst, q_) do { const int b_ = (q_) / SEQ; const bf16* s_ = X + ((size_t)b_ * TB + CTX + ((q_) - b_ * SEQ)) * DM + 8 * lane; \
        _Pragma("unroll") for (int j = 0; j < 4; ++j) dst[j] = *(const v4u*)(s_ + 512 * j); } while (0)
    if (qs < qe) FN_LOAD(cur, qs);
    for (int q = qs; q < qe; ++q) {
        if (q + 1 < qe) FN_LOAD(nxt, q + 1);
        f32x4 v[4][2]; float ss = 0.f;
#pragma unroll
        for (int j = 0; j < 4; ++j) { const v4u w = cur[j];
            v[j][0] = (f32x4){__uint_as_float(w.x << 16), __uint_as_float(w.x & 0xffff0000u), __uint_as_float(w.y << 16), __uint_as_float(w.y & 0xffff0000u)};
            v[j][1] = (f32x4){__uint_as_float(w.z << 16), __uint_as_float(w.z & 0xffff0000u), __uint_as_float(w.w << 16), __uint_as_float(w.w & 0xffff0000u)};
#pragma unroll
            for (int h = 0; h < 2; ++h) ss += (v[j][h].x * v[j][h].x + v[j][h].y * v[j][h].y) + (v[j][h].z * v[j][h].z + v[j][h].w * v[j][h].w); }
        const float rstd = rsqrtf(wave_sum(ss) * (1.f / DM) + NORM_EPS);
        float* o = out + (size_t)q * DM + 8 * lane;
#pragma unroll
        for (int j = 0; j < 4; ++j)
#pragma unroll
            for (int h = 0; h < 2; ++h) *(f32x4*)(o + 512 * j + 4 * h) = v[j][h] * rstd * gg[j][h];
#pragma unroll
        for (int j = 0; j < 4; ++j) cur[j] = nxt[j];
    }
#undef FN_LOAD
}

__device__ __forceinline__ void rope4(const bf16* src, bf16* dst, int i0, const float (&cr)[4], const float (&sr)[4], const float (&cc)[4], const float (&sc)[4]) {
    const v2u r1 = *(const v2u*)(src + i0), r2 = *(const v2u*)(src + 16 + i0), r3 = *(const v2u*)(src + 32 + i0), r4 = *(const v2u*)(src + 48 + i0);
    float x1[4] = {bf2f(r1.x & 0xffffu), bf2f(r1.x >> 16), bf2f(r1.y & 0xffffu), bf2f(r1.y >> 16)};
    float x2[4] = {bf2f(r2.x & 0xffffu), bf2f(r2.x >> 16), bf2f(r2.y & 0xffffu), bf2f(r2.y >> 16)};
    float x3[4] = {bf2f(r3.x & 0xffffu), bf2f(r3.x >> 16), bf2f(r3.y & 0xffffu), bf2f(r3.y >> 16)};
    float x4[4] = {bf2f(r4.x & 0xffffu), bf2f(r4.x >> 16), bf2f(r4.y & 0xffffu), bf2f(r4.y >> 16)};
    float o1[4], o2[4], o3[4], o4[4];
#pragma unroll
    for (int e = 0; e < 4; ++e) { o1[e] = x1[e] * cr[e] - x2[e] * sr[e]; o2[e] = x2[e] * cr[e] + x1[e] * sr[e]; o3[e] = x3[e] * cc[e] - x4[e] * sc[e]; o4[e] = x4[e] * cc[e] + x3[e] * sc[e]; }
    *(v2u*)(dst + i0) = (v2u){pk2(o1[0], o1[1]), pk2(o1[2], o1[3])}; *(v2u*)(dst + 16 + i0) = (v2u){pk2(o2[0], o2[1]), pk2(o2[2], o2[3])};
    *(v2u*)(dst + 32 + i0) = (v2u){pk2(o3[0], o3[1]), pk2(o3[2], o3[3])}; *(v2u*)(dst + 48 + i0) = (v2u){pk2(o4[0], o4[1]), pk2(o4[2], o4[3])};
}
__device__ __forceinline__ void phase_e1(bf16* Z, bf16* KR, int wg, int G, int wave, int lane, bool do_rope = true) {
    const int n5 = (NB * 4 * NSTEP / 2) % G, tot5 = 4 * n5 + 5 * (G - n5);
    const int c0 = wg < n5 ? 4 * wg : 4 * n5 + 5 * (wg - n5), c1 = wg + 1 < n5 ? 4 * (wg + 1) : 4 * n5 + 5 * (wg + 1 - n5);
    const int rs = (int)(((long long)MTOK * c0) / tot5), re = (int)(((long long)MTOK * c1) / tot5);
    const int j8 = lane & 7;
    v4u cur[3], nxt[3];
#define E1_LOAD(dst, r_) do { const bf16* z_ = Z + (size_t)(r_) * DINP + ZR + 8 * lane; dst[0] = *(const v4u*)z_; dst[1] = *(const v4u*)(z_ + 512); dst[2] = *(const v4u*)(z_ + (lane < 24 ? 1024 : 0)); } while (0)
    if (rs + wave < re) E1_LOAD(cur, rs + wave);
    for (int r = rs + wave; r < re; r += NWAVES) {
        if (r + NWAVES < re) E1_LOAD(nxt, r + NWAVES);
        const int b = r / TB, t = r - b * TB - CTX; const bool latent = t >= 0 && do_rope;
        bf16* z = Z + (size_t)r * DINP + ZR + 8 * lane; bf16* d0 = lane < 8 ? KR + (size_t)r * 64 + 8 * lane : z;
        if (latent) {
            const int pos = j8 < 4 ? (t >> 6) : (t & 63);
            float c[8], sg[8];
#pragma unroll
            for (int e = 0; e < 8; ++e) { float s_; rope_cs(pos, 8 * (j8 & 1) + e, c[e], s_); sg[e] = (j8 & 2) ? s_ : -s_; }
#pragma unroll
            for (int ps = 0; ps < 3; ++ps) { v4u o;
#pragma unroll
                for (int d = 0; d < 4; ++d) { const unsigned own = cur[ps][d], oth = (unsigned)__builtin_amdgcn_mov_dpp((int)own, 0x4E, 0xf, 0xf, true);
                    o[d] = pk2(bf2f(own & 0xffffu) * c[2 * d] + bf2f(oth & 0xffffu) * sg[2 * d], bf2f(own >> 16) * c[2 * d + 1] + bf2f(oth >> 16) * sg[2 * d + 1]); }
                if (ps == 0) *(v4u*)d0 = o; else if (ps == 1) *(v4u*)(z + 512) = o; else if (lane < 24) *(v4u*)(z + 1024) = o; }
        } else {
            if (lane < 8) *(v4u*)d0 = cur[0];
        }
#pragma unroll
        for (int ps = 0; ps < 3; ++ps) cur[ps] = nxt[ps];
    }
#undef E1_LOAD
}

#define MFMA16(a, b, c) __builtin_amdgcn_mfma_f32_16x16x32_bf16((a), (b), (c), 0, 0, 0)
__device__ __forceinline__ bf16x8 gather8(LAS const unsigned char* base, int stride) {
    bf16x8 r;
#pragma unroll
    for (int j = 0; j < 8; ++j) r[j] = *(LAS const short*)(base + j * stride);
    return r;
}
__device__ __forceinline__ bf16x8 colfrag8(LAS const unsigned char* tile, int row0, int col0, int stride, int lane) {
    typedef short v4i16_ __attribute__((ext_vector_type(4)));
    LAS const unsigned char* p = tile + (row0 + 8 * (lane >> 4) + ((lane & 15) >> 2)) * stride + (col0 + 4 * (lane & 3)) * 2;
    const s16x4 lo = __builtin_bit_cast(s16x4, __builtin_amdgcn_ds_read_tr16_b64_v4i16((LAS v4i16_*)p));
    const s16x4 hi = __builtin_bit_cast(s16x4, __builtin_amdgcn_ds_read_tr16_b64_v4i16((LAS v4i16_*)(p + 4 * stride)));
    return __builtin_shufflevector(lo, hi, 0, 1, 2, 3, 4, 5, 6, 7);
}
__device__ __forceinline__ void chain_step_rows(int dir, int i, int& seg, int& c) { seg = i >= 4; const int ii = seg ? i - 4 : i; c = dir == 0 ? ii : (seg ? 127 - ii : 3 - ii); }
__device__ __forceinline__ float scan_sum(float v, int dir, int lane) {
#pragma unroll
    for (int o = 1; o < 64; o <<= 1) { const float t = dir == 0 ? __shfl_up(v, o) : __shfl_down(v, o); const bool ok = dir == 0 ? (lane >= o) : (lane + o < 64); if (ok) v += t; }
    return v;
}
__device__ __forceinline__ float scan_max(float v, int dir, int lane) {
#pragma unroll
    for (int o = 1; o < 64; o <<= 1) { const float t = dir == 0 ? __shfl_up(v, o) : __shfl_down(v, o); const bool ok = dir == 0 ? (lane >= o) : (lane + o < 64); if (ok) v = fmaxf(v, t); }
    return v;
}

__device__ __forceinline__ void mlstm_a(const bf16* Z, const float* GATES, const float* gbias  , bf16* DC, float* DN, float* SC, LAS unsigned char* L, int wg, int G, int tid) {
    const int wave = tid >> 6, lane = tid & 63, fr = lane & 15, fq = lane >> 4, half = wave >> 2, w4 = wave & 3, t256 = tid & 255;
    LAS unsigned char* kt = L + half * 36864;
    LAS unsigned char* vt = kt + 18432;
    LAS float* wv = (LAS float*)(kt + 35840);
    constexpr int NP = NB * 4 * NSTEP / 2;
    for (int pair = wg; pair < NP; pair += G) {
        const int item = 2 * pair + half;
        const int b = item / (4 * NSTEP), h = (item / NSTEP) & 3, cc0 = item % NSTEP, seg = cc0 >= 4, c = seg ? cc0 - 4 : cc0;
        const int row0 = b * TB + (seg ? CTX : 0) + 64 * c;
        const int step0 = seg ? 4 + c : c, step1 = seg ? 4 + 127 - c : 3 - c;
        if (w4 < 2) {
            const int dir = w4; const size_t sidx = (size_t)((b * 4 + h) * 2 + dir) * NSTEP + (dir == 0 ? step0 : step1);
            const size_t row = (size_t)(row0 + lane);
            const float ip = GATES[row * 16 + (2 * dir) * 4 + h] + gbias[(2 * dir) * 4 + h];
            const float fp = GATES[row * 16 + (2 * dir + 1) * 4 + h] + gbias[(2 * dir + 1) * 4 + h];
            const float bs = scan_sum(logsigf_(fp), dir, lane);
            const float g = __shfl(bs, dir == 0 ? 63 : 0);
            const float a = g - bs + ip, amax = wave_max(a);
            wv[dir * 64 + lane] = expf(a - amax);
            if (lane == 0) { SC[sidx * 4 + 0] = g; SC[sidx * 4 + 1] = amax; }
        }
        v4u kraw[2], vraw[4];
#pragma unroll
        for (int i2 = 0; i2 < 2; ++i2) { const int c2 = t256 + 256 * i2; kraw[i2] = *(const v4u*)(Z + (size_t)(row0 + (c2 >> 3)) * DINP + ZMK + h * 64 + (c2 & 7) * 8); }
#pragma unroll
        for (int i2 = 0; i2 < 4; ++i2) { const int c2 = t256 + 256 * i2; vraw[i2] = *(const v4u*)(Z + (size_t)(row0 + (c2 >> 4)) * DINP + ZMV + h * 128 + (c2 & 15) * 8); }
        __syncthreads();
#pragma unroll
        for (int i2 = 0; i2 < 2; ++i2) { const int c2 = t256 + 256 * i2, krow_ = c2 >> 3, kcc_ = c2 & 7;
#pragma unroll
            for (int dir = 0; dir < 2; ++dir) { const float w = wv[dir * 64 + krow_]; v4u o;
#pragma unroll
                for (int e = 0; e < 4; ++e) o[e] = pk2(bf2f(kraw[i2][e] & 0xffffu) * w, bf2f(kraw[i2][e] >> 16) * w);
                *(LAS v4u*)(kt + dir * 9216 + krow_ * 144 + kcc_ * 16) = o; } }
#pragma unroll
        for (int i2 = 0; i2 < 4; ++i2) { const int c2 = t256 + 256 * i2; *(LAS v4u*)(vt + (c2 >> 4) * 272 + (c2 & 15) * 16) = vraw[i2]; }
        __syncthreads();
        if (w4 < 2) { const int dir = w4; const size_t sidx = (size_t)((b * 4 + h) * 2 + dir) * NSTEP + (dir == 0 ? step0 : step1); float s = 0.f;
#pragma unroll 8
            for (int j = 0; j < 64; ++j) s += bf2f(*(LAS const unsigned short*)(kt + dir * 9216 + j * 144 + lane * 2));
            DN[sidx * 64 + lane] = s; }
        {
            bf16x8 bfr[2][2];
#pragma unroll
            for (int et = 0; et < 2; ++et)
#pragma unroll
                for (int ks = 0; ks < 2; ++ks) bfr[et][ks] = colfrag8(vt, 32 * ks, 16 * (2 * w4 + et), 272, lane);
            const int ecol = 16 * (2 * w4 + (fq & 1)) + 4 * (fq & ~1);
#pragma unroll
            for (int dir = 0; dir < 2; ++dir) {
                bf16* dcp = DC + ((size_t)((b * 4 + h) * 2 + dir) * NSTEP + (dir == 0 ? step0 : step1)) * 8192;
#pragma unroll
                for (int dt = 0; dt < 4; ++dt) { f32x4 acc0 = {0.f, 0.f, 0.f, 0.f}, acc1 = {0.f, 0.f, 0.f, 0.f};
#pragma unroll
                    for (int ks = 0; ks < 2; ++ks) { const bf16x8 af = colfrag8(kt + dir * 9216, 32 * ks, 16 * dt, 144, lane); acc0 = MFMA16(bfr[0][ks], af, acc0); acc1 = MFMA16(bfr[1][ks], af, acc1); }
                    const auto sx = __builtin_amdgcn_permlane16_swap(pk2(acc0[0], acc0[1]), pk2(acc1[0], acc1[1]), false, false);
                    const auto sy = __builtin_amdgcn_permlane16_swap(pk2(acc0[2], acc0[3]), pk2(acc1[2], acc1[3]), false, false);
                    *(v4u*)(dcp + (16 * dt + fr) * 128 + ecol) = (v4u){sx[0], sy[0], sx[1], sy[1]}; } } }
        __syncthreads();
    }
}
__device__ __forceinline__ void mlstm_scan(bf16* DC, float* DN, float* SC, int wg, int G, int tid) {
    for (int unit = wg; unit < 32 * 8; unit += G) {
        const int chain = unit >> 3, slice = unit & 7;
        unsigned* dc = (unsigned*)(DC + (size_t)chain * NSTEP * 8192 + slice * 1024) + tid;
        float* dn = DN + (size_t)chain * NSTEP * 64 + (tid & 63);
        float* sc = SC + (size_t)chain * NSTEP * 4;
        const bool has_n = (slice == 0) && (tid < 64), rec_m = (slice == 0) && (tid == 0);
        float C0 = 0.f, C1 = 0.f, n = 0.f, m = 0.f;
        for (int i = 0; i < NSTEP; i += 12) {
            unsigned v[12]; float nv[12], g[12], am[12];
#pragma unroll
            for (int k = 0; k < 12; ++k) { v[k] = dc[(size_t)(i + k) * 4096]; g[k] = sc[(i + k) * 4]; am[k] = sc[(i + k) * 4 + 1]; nv[k] = has_n ? dn[(i + k) * 64] : 0.f; }
#pragma unroll
            for (int k = 0; k < 12; ++k) {
                const float mn = fmaxf(g[k] + m, am[k]), decay = expf(g[k] + m - mn), grow = expf(am[k] - mn);
                dc[(size_t)(i + k) * 4096] = pk2(C0, C1);
                C0 = decay * C0 + grow * bf2f(v[k] & 0xffffu); C1 = decay * C1 + grow * bf2f(v[k] >> 16);
                if (has_n) { dn[(i + k) * 64] = n; n = decay * n + grow * nv[k]; }
                if (rec_m) sc[(i + k) * 4 + 2] = m;
                m = mn;
            }
        }
    }
}
__device__ __forceinline__ void mlstm_c_phase(int u_first, int G, bool skip_ctx, const bf16* Z, const float* GATES, const float* gbias, const float* gh  , const bf16* DC, const float* DN, const float* SC,
                                              bf16* Y, LAS unsigned char* L, int tid) {
    const int wave = tid >> 6, lane = tid & 63, fr = lane & 15, fq = lane >> 4, dir = wave >> 2, w4 = wave & 3, t256 = tid & 255;
    LAS unsigned char* QS = L;
    LAS unsigned char* KS2 = L + 9216;
    LAS unsigned char* VS2 = L + 18432;
    LAS unsigned char* CS = L + 35840 + dir * 17408;
    LAS unsigned char* SS = L + 70656 + dir * 18432;
    LAS unsigned char* QW = SS + 9216;
    LAS float* HM = (LAS float*)(L + 70656);
    constexpr int HMS = 132;
    LAS float* VEC = (LAS float*)(L + 107520 + dir * 2048);
    LAS float* bq = VEC, *uu = VEC + 64, *iwv = VEC + 128, *emt = VEC + 192, *den = VEC + 256, *nin = VEC + 320;
    constexpr int NU = NB * 4 * NSTEP;
    v4u pq, pk, pv[2], pc[4]; float pig = 0.f, pfp = 0.f, pmin = 0.f, pnin = 0.f;
#define MC_DECODE(U) const int b = (U) / (4 * NSTEP), h = ((U) / NSTEP) & 3, cc0 = (U) % NSTEP, seg = cc0 >= 4, c = seg ? cc0 - 4 : cc0; \
    const int row0 = b * TB + (seg ? CTX : 0) + 64 * c; const int chain = (b * 4 + h) * 2 + dir; \
    const int step = dir == 0 ? (seg ? 4 + c : c) : (seg ? 4 + 127 - c : 3 - c); const size_t sidx = (size_t)chain * NSTEP + step
#define MC_NEXT(U) do { (U) += G; while (skip_ctx && (U) < NU && ((U) % NSTEP) < 4) (U) += G; } while (0)
#define MC_LOAD_A(U) do { MC_DECODE(U); (void)chain; (void)step; { const int row = tid >> 3, ch = tid & 7; const bf16* zr = Z + (size_t)(row0 + row) * DINP + h * 64 + ch * 8; pq = *(const v4u*)(zr + ZMQ); pk = *(const v4u*)(zr + ZMK); } \
        if (w4 == 0) { const size_t row = (size_t)(row0 + lane); pig = GATES[row * 16 + (2 * dir) * 4 + h] + gbias[(2 * dir) * 4 + h]; pfp = GATES[row * 16 + (2 * dir + 1) * 4 + h] + gbias[(2 * dir + 1) * 4 + h]; \
                       pmin = SC[sidx * 4 + 2]; pnin = DN[sidx * 64 + lane]; } } while (0)
#define MC_LOAD_C(U) do { MC_DECODE(U); (void)chain; (void)step; const bf16* cin = DC + sidx * 8192; \
        _Pragma("unroll") for (int i2 = 0; i2 < 2; ++i2) { const int c2 = tid + NTHR * i2; pv[i2] = *(const v4u*)(Z + (size_t)(row0 + (c2 >> 4)) * DINP + ZMV + h * 128 + (c2 & 15) * 8); } \
        _Pragma("unroll") for (int k = 0; k < 4; ++k) { const int c2 = t256 + 256 * k; pc[k] = *(const v4u*)(cin + (c2 >> 4) * 128 + (c2 & 15) * 8); } } while (0)
    int unit = u_first; while (skip_ctx && unit < NU && (unit % NSTEP) < 4) unit += G;
    if (unit < NU) { MC_LOAD_A(unit); MC_LOAD_C(unit); }
    for (; unit < NU; ) {
    int tl_ = tid; asm volatile("" : "+v"(tl_));
    const int wave = tl_ >> 6, lane = tl_ & 63, fr = lane & 15, fq = lane >> 4, dir = wave >> 2, w4 = wave & 3, t256 = tl_ & 255; const int tid = tl_;
    LAS unsigned char* CS = L + 35840 + dir * 17408; LAS unsigned char* SS = L + 70656 + dir * 18432; LAS unsigned char* QW = SS + 9216;
    LAS float* VEC = (LAS float*)(L + 107520 + dir * 2048); LAS float* bq = VEC, *uu = VEC + 64, *iwv = VEC + 128, *emt = VEC + 192, *den = VEC + 256, *nin = VEC + 320;
    MC_DECODE(unit); (void)chain; (void)step; (void)sidx;
    { const int row = tid >> 3, ch = tid & 7; v4u o;
#pragma unroll
      for (int e = 0; e < 4; ++e) o[e] = pk2(bf2f(pq[e] & 0xffffu) * 0.125f, bf2f(pq[e] >> 16) * 0.125f);
      *(LAS v4u*)(QS + row * 144 + ch * 16) = o;
      *(LAS v4u*)(KS2 + row * 144 + ch * 16) = pk; }
#pragma unroll
    for (int i2 = 0; i2 < 2; ++i2) { const int c2 = tid + NTHR * i2; *(LAS v4u*)(VS2 + (c2 >> 4) * 272 + (c2 & 15) * 16) = pv[i2]; }
#pragma unroll
    for (int k = 0; k < 4; ++k) { const int c2 = t256 + 256 * k; *(LAS v4u*)(CS + (c2 >> 4) * 272 + (c2 & 15) * 16) = pc[k]; }
    if (w4 == 0) {
        const float bs = scan_sum(logsigf_(pfp), dir, lane);
        const float u = pig - bs, pm = scan_max(u, dir, lane), m_in = pmin;
        const float mt = bs + fmaxf(m_in, pm);
        bq[lane] = bs - mt; uu[lane] = u; iwv[lane] = fexp(bs + m_in - mt); emt[lane] = fexp(-mt); nin[lane] = pnin;
    }
    __syncthreads();
    int unext = unit; MC_NEXT(unext);
    if (unext < NU) MC_LOAD_A(unext);
    v4u zo[2]; f32x4 ghv[2];
    { const int c8 = 8 * (lane & 15); const bf16* zp = Z + (size_t)(row0 + 8 * wave + (lane >> 4)) * DINP + ZMO + h * 128 + c8;
      zo[0] = *(const v4u*)zp; zo[1] = *(const v4u*)(zp + (size_t)4 * DINP); ghv[0] = *(const f32x4*)(gh + h * 128 + c8); ghv[1] = *(const f32x4*)(gh + h * 128 + c8 + 4); }
#pragma unroll
    for (int k = 0; k < 2; ++k) { const int c2 = t256 + 256 * k, row = c2 >> 3, ch = c2 & 7; const v4u rq = *(LAS const v4u*)(QS + row * 144 + ch * 16); const float w = iwv[row]; v4u o;
#pragma unroll
        for (int e = 0; e < 4; ++e) o[e] = pk2(bf2f(rq[e] & 0xffffu) * w, bf2f(rq[e] >> 16) * w);
        *(LAS v4u*)(QW + row * 144 + ch * 16) = o; }
    {
      const int lrow = 16 * w4 + fr; const float bql = bq[lrow]; float rsum = 0.f;
      bf16x8 qf[2];
#pragma unroll
      for (int ks = 0; ks < 2; ++ks) qf[ks] = *(LAS const bf16x8*)(QS + lrow * 144 + (32 * ks + 8 * fq) * 2);
#pragma unroll
      for (int st = 0; st < 4; ++st) { f32x4 acc = {0.f, 0.f, 0.f, 0.f};
#pragma unroll
          for (int ks = 0; ks < 2; ++ks) { const bf16x8 kf = *(LAS const bf16x8*)(KS2 + (16 * st + fr) * 144 + (32 * ks + 8 * fq) * 2); acc = MFMA16(kf, qf[ks], acc); }
          const f32x4 us4 = *(LAS const f32x4*)(uu + 16 * st + 4 * fq); float val[4];
#pragma unroll
          for (int rg = 0; rg < 4; ++rg) { const int scol = 16 * st + 4 * fq + rg; const bool valid = dir == 0 ? (scol <= lrow) : (scol >= lrow);
              val[rg] = valid ? acc[rg] * fexp(bql + us4[rg]) : 0.f; rsum += val[rg]; }
          *(LAS v2u*)(SS + lrow * 144 + (16 * st + 4 * fq) * 2) = (v2u){pk2(val[0], val[1]), pk2(val[2], val[3])}; }
      float dq = 0.f;
#pragma unroll
      for (int k2 = 0; k2 < 2; ++k2) { const v4u rq = *(LAS const v4u*)(QS + lrow * 144 + (16 * fq + 8 * k2) * 2); const f32x4 n0 = *(LAS const f32x4*)(nin + 16 * fq + 8 * k2), n1 = *(LAS const f32x4*)(nin + 16 * fq + 8 * k2 + 4);
          dq += (bf2f(rq.x & 0xffffu) * n0.x + bf2f(rq.x >> 16) * n0.y) + (bf2f(rq.y & 0xffffu) * n0.z + bf2f(rq.y >> 16) * n0.w) + (bf2f(rq.z & 0xffffu) * n1.x + bf2f(rq.z >> 16) * n1.y) + (bf2f(rq.w & 0xffffu) * n1.z + bf2f(rq.w >> 16) * n1.w); }
      float rs = rsum + iwv[lrow] * dq;
      { const auto r1 = __builtin_amdgcn_permlane16_swap(__float_as_uint(rs), __float_as_uint(rs), false, false); rs = __uint_as_float(r1[0]) + __uint_as_float(r1[1]);
        const auto r2 = __builtin_amdgcn_permlane32_swap(__float_as_uint(rs), __float_as_uint(rs), false, false); rs = __uint_as_float(r2[0]) + __uint_as_float(r2[1]); }
      if (fq == 0) den[lrow] = rs; }
    __syncthreads();
    f32x4 acc[2][4];
#pragma unroll
    for (int et = 0; et < 2; ++et) { bf16x8 bv[2], bc[2];
#pragma unroll
        for (int ks = 0; ks < 2; ++ks) { bv[ks] = colfrag8(VS2, 32 * ks, 16 * (2 * w4 + et), 272, lane); bc[ks] = colfrag8(CS, 32 * ks, 16 * (2 * w4 + et), 272, lane); }
#pragma unroll
        for (int lt = 0; lt < 4; ++lt) { acc[et][lt] = (f32x4){0.f, 0.f, 0.f, 0.f};
#pragma unroll
            for (int ks = 0; ks < 2; ++ks) { const bf16x8 a1 = *(LAS const bf16x8*)(SS + (16 * lt + fr) * 144 + (32 * ks + 8 * fq) * 2); acc[et][lt] = MFMA16(bv[ks], a1, acc[et][lt]); }
#pragma unroll
            for (int ks = 0; ks < 2; ++ks) { const bf16x8 a2 = *(LAS const bf16x8*)(QW + (16 * lt + fr) * 144 + (32 * ks + 8 * fq) * 2); acc[et][lt] = MFMA16(bc[ks], a2, acc[et][lt]); } } }
#pragma unroll
    for (int lt = 0; lt < 4; ++lt) { const int lrow = 16 * lt + fr; const float inv = __builtin_amdgcn_rcpf(fmaxf(fabsf(den[lrow]), emt[lrow]));
#pragma unroll
        for (int et = 0; et < 2; ++et) acc[et][lt] = acc[et][lt] * inv; }
    __syncthreads();
    if (dir == 1) {
#pragma unroll
        for (int et = 0; et < 2; ++et)
#pragma unroll
            for (int lt = 0; lt < 4; ++lt) *(LAS f32x4*)(HM + (16 * lt + fr) * HMS + 16 * (2 * w4 + et) + 4 * fq) = acc[et][lt];
    }
    __syncthreads();
    if (dir == 0) {
#pragma unroll
        for (int et = 0; et < 2; ++et)
#pragma unroll
            for (int lt = 0; lt < 4; ++lt) { LAS f32x4* hp = (LAS f32x4*)(HM + (16 * lt + fr) * HMS + 16 * (2 * w4 + et) + 4 * fq); *hp = *hp + acc[et][lt]; }
    }
    __syncthreads();
    if (unext < NU) MC_LOAD_C(unext);
#pragma unroll
    for (int ps = 0; ps < 2; ++ps) { const int lrow = 8 * wave + 4 * ps + (lane >> 4), c8 = 8 * (lane & 15);
        const f32x4 va = *(LAS const f32x4*)(HM + lrow * HMS + c8), vb = *(LAS const f32x4*)(HM + lrow * HMS + c8 + 4);
        const float rstd = rsqrtf(row16_sum((va.x * va.x + va.y * va.y) + (va.z * va.z + va.w * va.w) + (vb.x * vb.x + vb.y * vb.y) + (vb.z * vb.z + vb.w * vb.w)) * (1.f / 128.f) + NORM_EPS);
        const v4u z = zo[ps]; const f32x4 ga = ghv[0] * rstd, gb = ghv[1] * rstd;
        v4u o; o.x = pk2(va.x * ga.x * sigmoid_fast(bf2f(z.x & 0xffffu)), va.y * ga.y * sigmoid_fast(bf2f(z.x >> 16))); o.y = pk2(va.z * ga.z * sigmoid_fast(bf2f(z.y & 0xffffu)), va.w * ga.w * sigmoid_fast(bf2f(z.y >> 16)));
        o.z = pk2(vb.x * gb.x * sigmoid_fast(bf2f(z.z & 0xffffu)), vb.y * gb.y * sigmoid_fast(bf2f(z.z >> 16))); o.w = pk2(vb.z * gb.z * sigmoid_fast(bf2f(z.w & 0xffffu)), vb.w * gb.w * sigmoid_fast(bf2f(z.w >> 16)));
        *(v4u*)(Y + (size_t)(row0 + lrow) * DM + 1536 + h * 128 + c8) = o; }
    unit = unext;
    }
#undef MC_DECODE
#undef MC_NEXT
#undef MC_LOAD_A
#undef MC_LOAD_C
}

#define MFMA32(a, b, c) __builtin_amdgcn_mfma_f32_32x32x16_bf16((a), (b), (c), 0, 0, 0)
typedef short v4i16_t __attribute__((ext_vector_type(4)));
__device__ __forceinline__ s16x4 tr_read(LAS const unsigned char* p) { return __builtin_bit_cast(s16x4, __builtin_amdgcn_ds_read_tr16_b64_v4i16((LAS v4i16_t*)p)); }
constexpr float ATT_THR = 8.f;
#define SCHED_FENCE() __builtin_amdgcn_sched_barrier(0)
constexpr int NO_MASK = 0x40000000;
template <int DQK, int KSB>
__device__ __forceinline__ void attn_scores(LAS const unsigned char* Kt, const bf16x8 (&qf)[DQK / 16], f32x16 (&p)[2], int r32, int hi) {
    constexpr int NK = DQK / 16;
    LAS const unsigned char* kp = Kt + r32 * KSB + hi * 16;
    f32x16 p0, p1;
#pragma unroll
    for (int e = 0; e < 16; ++e) { p0[e] = 0.f; p1[e] = 0.f; }
    bf16x8 kr[3][2];
#define QK_LOAD(ks) do { kr[(ks) % 3][0] = *(LAS const bf16x8*)(kp + (ks) * 32); kr[(ks) % 3][1] = *(LAS const bf16x8*)(kp + 32 * KSB + (ks) * 32); } while (0)
    QK_LOAD(0); QK_LOAD(1); SCHED_FENCE();
#pragma unroll
    for (int ks = 0; ks < NK; ++ks) {
        if (ks + 2 < NK) QK_LOAD(ks + 2);
        p0 = MFMA32(kr[ks % 3][0], qf[ks], p0); p1 = MFMA32(kr[ks % 3][1], qf[ks], p1); SCHED_FENCE();
    }
#undef QK_LOAD
    p[0] = p0; p[1] = p1;
}
template <int DV, bool MASK>
__device__ __forceinline__ void attn_softmax(f32x16 (&p)[2], f32x16 (&o)[DV / 32], float& m, float& l, float cs, int hi, int dq) {
    if (MASK) { if (__builtin_amdgcn_readfirstlane(dq) != NO_MASK) {
#pragma unroll
        for (int kvb = 0; kvb < 2; ++kvb)
#pragma unroll
            for (int e = 0; e < 16; ++e) { const int rel = dq + 32 * kvb + (e & 3) + 8 * (e >> 2) + 4 * hi; if (rel > 128 || rel < -128) p[kvb][e] = -INFINITY; } } }
    float mx;
    {
        float a0 = fmaxf(fmaxf(p[0][0], p[0][1]), p[0][2]), a1 = fmaxf(fmaxf(p[0][8], p[0][9]), p[0][10]), a2 = fmaxf(fmaxf(p[1][0], p[1][1]), p[1][2]), a3 = fmaxf(fmaxf(p[1][8], p[1][9]), p[1][10]);
        a0 = fmaxf(fmaxf(a0, p[0][3]), p[0][4]); a1 = fmaxf(fmaxf(a1, p[0][11]), p[0][12]); a2 = fmaxf(fmaxf(a2, p[1][3]), p[1][4]); a3 = fmaxf(fmaxf(a3, p[1][11]), p[1][12]);
        a0 = fmaxf(fmaxf(a0, p[0][5]), p[0][6]); a1 = fmaxf(fmaxf(a1, p[0][13]), p[0][14]); a2 = fmaxf(fmaxf(a2, p[1][5]), p[1][6]); a3 = fmaxf(fmaxf(a3, p[1][13]), p[1][14]);
        a0 = fmaxf(a0, p[0][7]); a1 = fmaxf(a1, p[0][15]); a2 = fmaxf(a2, p[1][7]); a3 = fmaxf(a3, p[1][15]);
        mx = fmaxf(fmaxf(a0, a1), fmaxf(a2, a3));
        const auto rr = __builtin_amdgcn_permlane32_swap(__float_as_uint(mx), __float_as_uint(mx), false, false);
        mx = fmaxf(__uint_as_float(rr[0]), __uint_as_float(rr[1])); }
    const float mn = fmaxf(m, mx * cs);
    if (__any(mn - m > ATT_THR)) {
        const float alpha = fexp2(m - mn); m = mn; l *= alpha;
#pragma unroll
        for (int d = 0; d < DV / 32; ++d)
#pragma unroll
            for (int e = 0; e < 16; ++e) o[d][e] *= alpha;
    }
    float ls0 = 0.f, ls1 = 0.f, ls2 = 0.f, ls3 = 0.f;
#pragma unroll
    for (int kvb = 0; kvb < 2; ++kvb)
#pragma unroll
        for (int e = 0; e < 16; e += 4) {
            const float e0 = fexp2(fmaf(p[kvb][e], cs, -m)), e1 = fexp2(fmaf(p[kvb][e + 1], cs, -m)), e2 = fexp2(fmaf(p[kvb][e + 2], cs, -m)), e3 = fexp2(fmaf(p[kvb][e + 3], cs, -m));
            p[kvb][e] = e0; p[kvb][e + 1] = e1; p[kvb][e + 2] = e2; p[kvb][e + 3] = e3; ls0 += e0; ls1 += e1; ls2 += e2; ls3 += e3; }
    l += (ls0 + ls1) + (ls2 + ls3);
}
template <int DV, int VRB>
__device__ __forceinline__ void attn_pv(LAS const unsigned char* Vt, const f32x16 (&p)[2], f32x16 (&o)[DV / 32], int vtb) {
    constexpr int ND = DV / 32;
    LAS const unsigned char* vb = Vt + vtb;
    bf16x8 pf[4];
#pragma unroll
    for (int i = 0; i < 4; ++i) { const int kvb = i >> 1, s = i & 1;
        v4u pw; pw.x = pk2(p[kvb][8 * s + 0], p[kvb][8 * s + 1]); pw.y = pk2(p[kvb][8 * s + 2], p[kvb][8 * s + 3]); pw.z = pk2(p[kvb][8 * s + 4], p[kvb][8 * s + 5]); pw.w = pk2(p[kvb][8 * s + 6], p[kvb][8 * s + 7]);
        pf[i] = __builtin_bit_cast(bf16x8, pw); }
    s16x4 va[2 * ND], vbq[2 * ND];
#define PV_LOAD(dst, i) do { _Pragma("unroll") for (int d = 0; d < ND; ++d) { LAS const unsigned char* vp = vb + (16 * (i)) * VRB + d * 64; dst[2 * d] = tr_read(vp); dst[2 * d + 1] = tr_read(vp + 8 * VRB); } } while (0)
#define PV_MMA(src, i) do { _Pragma("unroll") for (int d = 0; d < ND; ++d) { const bf16x8 vf = __builtin_shufflevector(src[2 * d], src[2 * d + 1], 0, 1, 2, 3, 4, 5, 6, 7); o[d] = MFMA32(vf, pf[i], o[d]); } } while (0)
    PV_LOAD(va, 0); SCHED_FENCE();
    PV_LOAD(vbq, 1); PV_MMA(va, 0); SCHED_FENCE();
    PV_LOAD(va, 2); PV_MMA(vbq, 1); SCHED_FENCE();
    PV_LOAD(vbq, 3); PV_MMA(va, 2); SCHED_FENCE();
    PV_MMA(vbq, 3); SCHED_FENCE();
#undef PV_LOAD
#undef PV_MMA
}
template <int DQK, int DV, int KSB, int VRB, bool MASK>
__device__ __forceinline__ void attn_tile(LAS const unsigned char* Kt, LAS const unsigned char* Vt, const bf16x8 (&qf)[DQK / 16], f32x16 (&o)[DV / 32], float& m, float& l, float cs, int r32, int hi, int vtb, int dq) {
    __builtin_amdgcn_sched_barrier(0);
    f32x16 p[2];
    attn_scores<DQK, KSB>(Kt, qf, p, r32, hi);
    attn_softmax<DV, MASK>(p, o, m, l, cs, hi, dq);
    attn_pv<DV, VRB>(Vt, p, o, vtb);
}
template <int DV>
__device__ __forceinline__ void attn_store(bf16* yrow  , const f32x16 (&o)[DV / 32], float l, int hi) {
    const float lt = l + __shfl_xor(l, 32), inv = 1.f / lt;
    unsigned char* yb = (unsigned char*)yrow + 16 * hi;
#pragma unroll
    for (int d = 0; d < DV / 32; ++d)
#pragma unroll
        for (int kk = 0; kk < 2; ++kk) {
            unsigned ax = pk2(o[d][8 * kk] * inv, o[d][8 * kk + 1] * inv), ay = pk2(o[d][8 * kk + 2] * inv, o[d][8 * kk + 3] * inv);
            unsigned bx = pk2(o[d][8 * kk + 4] * inv, o[d][8 * kk + 5] * inv), by = pk2(o[d][8 * kk + 6] * inv, o[d][8 * kk + 7] * inv);
            const auto rx = __builtin_amdgcn_permlane32_swap(ax, bx, false, false); const auto ry = __builtin_amdgcn_permlane32_swap(ay, by, false, false);
            *(v4u*)(yb + 64 * d + 32 * kk) = (v4u){rx[0], ry[0], rx[1], ry[1]};
        }
}
constexpr int MLA_KSB = 400, MLA_KT = 64 * MLA_KSB  , MLA_VRB = 320, MLA_VT = 64 * MLA_VRB  , MLA_BUF = MLA_KT + MLA_VT;
__device__ __forceinline__ void mla_unit(const bf16* QM, const bf16* KVM, const bf16* KR, bf16* Y, int b, int h, int qrow0, int ntiles, bool latent, LAS unsigned char* L, int tid_in) {
    int tid = tid_in; asm volatile("" : "+v"(tid));
    const int wave = tid >> 6, lane = tid & 63, r32 = lane & 31, hi = lane >> 5;
    const int qrow = qrow0 + 32 * wave + r32;
    bf16x8 qf[12];
    { const bf16* qp = QM + (size_t)qrow * 768 + h * 192 + 8 * hi;
#pragma unroll
      for (int ks = 0; ks < 12; ++ks) qf[ks] = *(const bf16x8*)(qp + 16 * ks); }
    if (latent) {
        const int t = qrow - b * TB - CTX, prow = t >> 6, pcol = t & 63;
        int hl = hi; asm volatile("" : "+v"(hl));
#pragma unroll
        for (int j = 0; j < 8; ++j) { float cr, sr, cc, sc; rope_cs(prow, 8 * hl + j, cr, sr); rope_cs(pcol, 8 * hl + j, cc, sc);
            const float x1 = bf2f((unsigned short)qf[8][j]), x2 = bf2f((unsigned short)qf[9][j]), x3 = bf2f((unsigned short)qf[10][j]), x4 = bf2f((unsigned short)qf[11][j]);
            qf[8][j] = (short)(pk2(x1 * cr - x2 * sr, 0.f) & 0xffffu); qf[9][j] = (short)(pk2(x2 * cr + x1 * sr, 0.f) & 0xffffu);
            qf[10][j] = (short)(pk2(x3 * cc - x4 * sc, 0.f) & 0xffffu); qf[11][j] = (short)(pk2(x4 * cc + x3 * sc, 0.f) & 0xffffu); }
    }
    f32x16 o[4];
#pragma unroll
    for (int d = 0; d < 4; ++d)
#pragma unroll
        for (int e = 0; e < 16; ++e) o[d][e] = 0.f;
    float m = -INFINITY, l = 0.f;
    const float cs = 0.07216878364870322f * LOG2E;
    const unsigned kgo = (unsigned)(((tid >> 4) * 1024 + (tid & 15) * 8) * 2), klo = (unsigned)((tid >> 4) * MLA_KSB + (tid & 15) * 16);
    const unsigned rgo = (unsigned)(((tid >> 3) * 64 + (tid & 7) * 8) * 2), rlo = (unsigned)((tid >> 3) * MLA_KSB + 256 + (tid & 7) * 16);
    const unsigned vlo = (unsigned)((tid >> 4) * MLA_VRB + (tid & 15) * 16);
    const int vtb = (4 * hi + ((lane & 15) >> 2)) * MLA_VRB + (16 * ((lane >> 4) & 1) + 4 * (lane & 3)) * 2;
    const char* kvb0 = (const char*)(KVM + ((size_t)b * TB) * 1024 + h * 256);
    const char* krb0 = (const char*)(KR + ((size_t)b * TB) * 64);
    v4u kreg[3], vreg[2];
#define MLA_LOAD(t) do { const char* kb_ = kvb0 + (size_t)(t) * (64 * 1024 * 2); const char* rb_ = krb0 + (size_t)(t) * (64 * 64 * 2); \
        kreg[0] = *(const v4u*)(kb_ + kgo); kreg[1] = *(const v4u*)(kb_ + 32 * 1024 * 2 + kgo); kreg[2] = *(const v4u*)(rb_ + rgo); \
        vreg[0] = *(const v4u*)(kb_ + 256 + kgo); vreg[1] = *(const v4u*)(kb_ + 32 * 1024 * 2 + 256 + kgo); } while (0)
#define MLA_STORE(buf) do { LAS unsigned char* Kt_ = L + (buf) * MLA_BUF; LAS unsigned char* Vt_ = Kt_ + MLA_KT; \
        *(LAS v4u*)(Kt_ + klo) = kreg[0]; *(LAS v4u*)(Kt_ + 32 * MLA_KSB + klo) = kreg[1]; *(LAS v4u*)(Kt_ + rlo) = kreg[2]; \
        *(LAS v4u*)(Vt_ + vlo) = vreg[0]; *(LAS v4u*)(Vt_ + 32 * MLA_VRB + vlo) = vreg[1]; } while (0)
    const int half = wave >> 2;
    MLA_LOAD(0); MLA_STORE(0);
    if (ntiles > 1) { MLA_LOAD(1); MLA_STORE(1); }
    __syncthreads();
    if (half) __builtin_amdgcn_s_barrier();
    if (ntiles > 2) MLA_LOAD(2);
    int bcur = 0, bst = 2;
    for (int t = 0; t < ntiles; ++t) {
        LAS const unsigned char* Kt = L + bcur * MLA_BUF;
        f32x16 p[2];
        __builtin_amdgcn_sched_barrier(0);
        attn_scores<192, MLA_KSB>(Kt, qf, p, r32, hi);
        __syncthreads();
        attn_softmax<128, false>(p, o, m, l, cs, hi, 0);
        attn_pv<128, MLA_VRB>(Kt + MLA_KT, p, o, vtb);
        if (t + 2 < ntiles) { MLA_STORE(bst); if (t + 3 < ntiles) MLA_LOAD(t + 3); }
        __syncthreads();
        bcur = bcur == 2 ? 0 : bcur + 1; bst = bst == 2 ? 0 : bst + 1;
    }
    if (!half) __builtin_amdgcn_s_barrier();
#undef MLA_LOAD
#undef MLA_STORE
    attn_store<128>(Y + (size_t)qrow * DM + h * 128, o, l, hi);
}

constexpr int SWA_KSB = 144, SWA_KT = 64 * SWA_KSB  , SWA_VRB = 192, SWA_VT = 64 * SWA_VRB  , SWA_BUF = SWA_KT + SWA_VT;
__device__ __forceinline__ void swa_unit(const bf16* Z, const float* sink  , bf16* Y, int b, int g, int blk, int cblk, LAS unsigned char* L, int tid) {
    const int wave = tid >> 6, lane = tid & 63, r32 = lane & 31, hi = lane >> 5;
    const bool latent = blk >= 0;
    const int head = 8 * g + wave;
    const int qrow0 = b * TB + (latent ? CTX + 64 * blk : 64 * cblk);
    bf16x8 qf[2][4];
#pragma unroll
    for (int sb = 0; sb < 2; ++sb) { const bf16* qp = Z + (size_t)(qrow0 + 32 * sb + r32) * DINP + ZSQ + head * 64 + 8 * hi;
#pragma unroll
        for (int ks = 0; ks < 4; ++ks) qf[sb][ks] = *(const bf16x8*)(qp + 16 * ks); }
    f32x16 o[2][2];
#pragma unroll
    for (int sb = 0; sb < 2; ++sb)
#pragma unroll
        for (int d = 0; d < 2; ++d)
#pragma unroll
            for (int e = 0; e < 16; ++e) o[sb][d][e] = 0.f;
    const float sk = sink[head] * LOG2E;
    float m[2] = {sk, sk}, l[2] = {hi == 0 ? 1.f : 0.f, hi == 0 ? 1.f : 0.f};
    const float cs = 0.125f * LOG2E;
    int wlo = 0, nwin = 0;
    if (latent) { wlo = blk - 2 < 0 ? 0 : blk - 2; const int whi = blk + 2 > 127 ? 127 : blk + 2; nwin = whi - wlo + 1; }
    const int ntiles = 4 + nwin;
    const unsigned kgo = (unsigned)(((tid >> 3) * DINP + ZSK + (tid & 7) * 8) * 2), klo = (unsigned)((tid >> 3) * SWA_KSB + (tid & 7) * 16), vlo = (unsigned)((tid >> 3) * SWA_VRB + (tid & 7) * 16);
    const int vtb = (4 * hi + ((lane & 15) >> 2)) * SWA_VRB + (16 * ((lane >> 4) & 1) + 4 * (lane & 3)) * 2;
    const char* zb0 = (const char*)(Z + ((size_t)b * TB) * DINP + g * 64);
    v4u kreg, vreg;
#define SWA_ROW0(t) ((t) < 4 ? 64 * (t) : CTX + 64 * (wlo + (t) - 4))
#define SWA_LOAD(t) do { const char* zb_ = zb0 + (size_t)SWA_ROW0(t) * (DINP * 2); kreg = *(const v4u*)(zb_ + kgo); vreg = *(const v4u*)(zb_ + (ZSV - ZSK) * 2 + kgo); } while (0)
#define SWA_STORE(buf) do { LAS unsigned char* Kt_ = L + (buf) * SWA_BUF; *(LAS v4u*)(Kt_ + klo) = kreg; *(LAS v4u*)(Kt_ + SWA_KT + vlo) = vreg; } while (0)
    SWA_LOAD(0); SWA_STORE(0);
    __syncthreads();
    for (int t = 0; t < ntiles; ++t) {
        const bool more = t + 1 < ntiles;
        if (more) SWA_LOAD(t + 1);
        LAS const unsigned char* Kt = L + (t & 1) * SWA_BUF;
        const int kpos0 = 64 * (wlo + t - 4);
        const bool edge = t >= 4 && (wlo + t - 4 == blk - 2 || wlo + t - 4 == blk + 2);
#pragma unroll
        for (int sb = 0; sb < 2; ++sb) attn_tile<64, 64, SWA_KSB, SWA_VRB, true>(Kt, Kt + SWA_KT, qf[sb], o[sb], m[sb], l[sb], cs, r32, hi, vtb, edge ? kpos0 - (64 * blk + 32 * sb + r32) : NO_MASK);
        if (more) SWA_STORE((t + 1) & 1);
        __syncthreads();
    }
#undef SWA_ROW0
#undef SWA_LOAD
#undef SWA_STORE
#pragma unroll
    for (int sb = 0; sb < 2; ++sb) attn_store<64>(Y + (size_t)(qrow0 + 32 * sb + r32) * DM + 512 + head * 64, o[sb], l[sb], hi);
}

struct Args { const float* in[20]; float* out; unsigned char* ws; };
enum { IN_X = 0, IN_C, IN_CTX, IN_CCTX, IN_WMOD, IN_BMOD, IN_GN1, IN_GN2, IN_WIN, IN_GQ, IN_WUQ, IN_GKV, IN_WUKV, IN_SINK, IN_GBIAS, IN_GH, IN_WOUT, IN_W1, IN_W2, IN_GFINAL };

__global__ void __launch_bounds__(NTHR, 2) fwd_kernel(Args a) {
    extern __shared__ __attribute__((aligned(16))) unsigned char lds[];
    LAS unsigned char* L = (LAS unsigned char*)lds;
    const int tid0 = threadIdx.x;
    const int G = gridDim.x;
    for (int u = tid0; u < (LDS_BYTES - LDSCTL_OFF) / 4; u += NTHR) ((LAS unsigned*)(L + LDSCTL_OFF))[u] = 0u;
    __syncthreads();
    unsigned char* ws = a.ws;
    XcdBarrier bar = xcd_barrier_post((unsigned*)(ws + WS_CTL) + CW_BAR, (volatile LAS unsigned*)(L + MISC_OFF) + 8);

#define GRID_BAR(id_) do { XcdBarrier b2_ = bar; unsigned xx_ = bar.x; asm volatile("" : "+s"(xx_)); b2_.x = xx_; xcd_barrier(b2_); } while (0)
#define LAUNDER() int tid = tid0; asm volatile("" : "+v"(tid)); int wg = blockIdx.x; asm volatile("" : "+s"(wg)); const int lane = tid & 63, wave = __builtin_amdgcn_readfirstlane(tid >> 6), gw = wg * NWAVES + wave, NGW = G * NWAVES; (void)lane; (void)wave; (void)gw; (void)NGW
    float* MOD = (float*)(ws + WS_MOD);
    constexpr size_t WSET_STRIDE = WS_WSET1 - WS_WIN;
    bf16* X = (bf16*)(ws + WS_X); bf16* H = (bf16*)(ws + WS_H); float* SLAB = (float*)(ws + WS_SLAB);
    float *GATES = (float*)(ws + WS_GATES), *DN = (float*)(ws + WS_DN), *SC = (float*)(ws + WS_SC); bf16* DC = (bf16*)(ws + WS_DC);
    unsigned char* big = ws + WS_BIG;
    bf16 *Z = (bf16*)(big + BG_Z), *ZQN = (bf16*)(big + BG_ZQN), *ZKVN = (bf16*)(big + BG_ZKVN), *KR = (bf16*)(big + BG_KR), *QM = (bf16*)(big + BG_QM), *KVM = (bf16*)(big + BG_KVM), *Y = (bf16*)(big + BG_Y), *ACT = (bf16*)big;
    const ConvSrc csrc{a.in[IN_WIN], a.in[IN_WUQ], a.in[IN_WUKV], a.in[IN_WOUT], a.in[IN_W1], a.in[IN_W2], a.in[IN_GQ], a.in[IN_GKV]};

    unsigned long long* ROWSS = (unsigned long long*)(ws + WS_STAT); long long* BIAS = (long long*)(ws + WS_STAT + 3 * MiB);
    { LAUNDER(); for (int i = wg * NTHR + tid; i < (int)(8 * MiB / 8); i += G * NTHR) ROWSS[i] = 0ull;
      phase_mod(a.in[IN_C], a.in[IN_CCTX], a.in[IN_WMOD], a.in[IN_BMOD], MOD, L, wg, G, tid); }
    GRID_BAR(0);

    for (int l = 0; l < DEPTH; ++l) {
        const float* modl = MOD + (size_t)l * 5 * 12288;
        long long* biasl = BIAS + (size_t)l * 5 * BIASW;
        unsigned long long* rssA = ROWSS + (size_t)(2 * l) * MTOK;
        unsigned long long* rssB = ROWSS + (size_t)(2 * l + 1) * MTOK;
        unsigned long long* rs2 = (unsigned long long*)(ws + WS_RS2) + (size_t)(2 * l) * MTOK;
        const bool lastl = l == DEPTH - 1;
        unsigned char* wset = ws + (size_t)(l & 1) * WSET_STRIDE; unsigned char* wnext = ws + (size_t)((l + 1) & 1) * WSET_STRIDE;
        bf16 *WIN = (bf16*)(wset + WS_WIN), *WUQ = (bf16*)(wset + WS_WUQ), *WUKV = (bf16*)(wset + WS_WUKV), *WOUT = (bf16*)(wset + WS_WOUT), *W1 = (bf16*)(wset + WS_W1), *W2 = (bf16*)(wset + WS_W2);
        const ConvDst cdst{WIN, WUQ, WUKV, WOUT, W1, W2};
        const ConvDst cnext{(bf16*)(wnext + WS_WIN), (bf16*)(wnext + WS_WUQ), (bf16*)(wnext + WS_WUKV), (bf16*)(wnext + WS_WOUT), (bf16*)(wnext + WS_W1), (bf16*)(wnext + WS_W2)};
        const float* modn = MOD + (size_t)(l + 1) * 5 * 12288; long long* biasn = BIAS + (size_t)(l + 1) * 5 * BIASW;
        { LAUNDER(); LAS float* scr = (LAS float*)(L + wave * 8448); LAS float* tab = (LAS float*)(L + 8 * 8448);
          const bool g1tail = ((MTOK / 256) * (DINP / 256)) % G != 0, g4tail = ((MTOK / 256) * (DFF / 256)) % G != 0;
          const bool needA0 = l == 0 || !g1tail, needA1 = l == 0 || !g4tail;
          if (needA0 || needA1) { conv_load_tab(tab, modl, 3, tid);
              if (needA0) conv_A(csrc, cdst, l, 0, CV_A_SPLIT, gw, NGW, scr, tab, biasl, lane);
              if (needA1) { conv_A(csrc, cdst, l, CV_A_SPLIT, CV_I1, gw, NGW, scr, tab, biasl, lane); conv_B(csrc, cdst, l, 0, CV_B_SPLIT, gw, NGW, scr, lane); } }
          conv_B(csrc, cdst, l, CV_B_SPLIT, CV_I2, gw, NGW, scr, lane);
          conv_load_tab(tab, modl, 0, tid); conv_CD(csrc, cdst, l, gw, NGW, scr, tab, biasl, lane); __syncthreads(); }
        { LAUNDER();
          if (l == 0) phase_first(a.in[IN_X], a.in[IN_CTX], X, H, rssB, a.in[IN_GN1], modl, gw, NGW, lane);
          else phase_ctxfix(X, H, rssB, SLAB, MOD + (size_t)((l - 1) * 5 + 4) * 12288 + 5 * DM, a.in[IN_GN1] + l * DM, modl + (size_t)4 * 12288 + DM, gw, NGW, lane); }
        GRID_BAR(1);
        { LAUNDER(); pg8::Gemm g{H, WIN, MTOK, DINP, DM}; pg8::StaticOrder S; S.init(MTOK, DINP, DM, G, wg);
          pg8::EpiBf16<0, true, true> E{Z, DINP, GATES, rssB, biasl, BIASW, rs2, MTOK};
          pg8::gemm_phase<pg8::EpiBf16<0, true, true>, pg8::StaticOrder, true, true>(L, g, S, E);
          constexpr int NU = (MTOK / 256) * (DINP / 256); const int rem = NU % G;
          if (!lastl && rem != 0 && wg >= rem) { LAS float* scr = (LAS float*)(L + wave * 8448); LAS float* tab = (LAS float*)(L + 8 * 8448);
              conv_load_tab(tab, modn, 3, tid); conv_A(csrc, cnext, l + 1, 0, CV_A_SPLIT, (wg - rem) * NWAVES + wave, (G - rem) * NWAVES, scr, tab, biasn, lane); __syncthreads(); } }
        GRID_BAR(2);
        { LAUNDER(); phase_e1(Z, KR, wg, G, wave, lane); }
        { LAUNDER(); mlstm_a(Z, GATES, a.in[IN_GBIAS] + l * 16, DC, DN, SC, L, wg, G, tid); }
        GRID_BAR(3);
        { LAUNDER(); mlstm_scan(DC, DN, SC, wg, G, tid); }
        __syncthreads();
        { LAUNDER(); pg8::Gemm g{Z + ZQ, WUQ, MTOK, 768, 512}; pg8::StaticOrder S; S.init(MTOK, 768, 512, G, wg);
          pg8::EpiBf16<0, false, true, 512, false> E{QM, 768, nullptr, rs2, nullptr, 0};
          pg8::gemm_phase<pg8::EpiBf16<0, false, true, 512, false>, pg8::StaticOrder, true, true, DINP>(L, g, S, E); }
        { LAUNDER(); pg8::Gemm g{Z + ZKV, WUKV, MTOK, 1024, 256}; pg8::StaticOrder S; S.init(MTOK, 1024, 256, G, (wg + 116) % G);
          pg8::EpiBf16<0, false, true, 256, false> E{KVM, 1024, nullptr, rs2 + MTOK, nullptr, 0};
          pg8::gemm_phase<pg8::EpiBf16<0, false, true, 256, false>, pg8::StaticOrder, true, true, DINP>(L, g, S, E); }
        GRID_BAR(4);
#ifndef ATT_SWAP_MASK
#define ATT_SWAP_MASK 4
#endif
        for (int stage = 0; stage < 2; ++stage) {
        bool mla_now; { int wgs = blockIdx.x; asm volatile("" : "+s"(wgs)); mla_now = (stage == 0) != ((wgs & ATT_SWAP_MASK) != 0); }
        if (mla_now) { LAUNDER();
          const int n_mla = lastl ? 512 : 512 + 16;
          for (int u = wg; u < n_mla; u += G) {
            if (u < 512) { const int pair = 2 * (u & 7) + (u >> 8), qb = (u >> 3) & 31, b = pair >> 2, h = pair & 3; mla_unit(QM, KVM, KR, Y, b, h, b * TB + CTX + 256 * qb, 132, true, L, tid); }
            else { const int i = u - 512, b = i >> 2, h = i & 3; mla_unit(QM, KVM, KR, Y, b, h, b * TB, 4, false, L, tid); }
          } }
        else {
        { LAUNDER();
          const int n_swa = lastl ? 1024 : 1024 + 32;
          for (int u = (wg + 64) % G; u < n_swa; u += G) {
            if (u < 1024) swa_unit(Z, a.in[IN_SINK] + l * 16, Y, u >> 8, (u >> 7) & 1, u & 127, 0, L, tid);
            else { const int i = u - 1024; swa_unit(Z, a.in[IN_SINK] + l * 16, Y, i >> 3, (i >> 2) & 1, -1, i & 3, L, tid); }
          } }
        { LAUNDER();
          mlstm_c_phase((wg + 128) % G, G, lastl, Z, GATES, a.in[IN_GBIAS] + l * 16, a.in[IN_GH] + l * 512, DC, DN, SC, Y, L, tid); }
        }
        __syncthreads();
        }
        GRID_BAR(5);
        { LAUNDER(); pg8::Gemm g{Y, WOUT, MTOK, DM, DM}; pg8::LatentOrder S; S.init(DM, DM, G, wg, lastl ? 0 : 2);
          pg8::EpiResid E{X, modl, 2 * DM, SLAB, DM / 64, H, a.in[IN_GN2] + l * DM, modl + 4 * DM, rssA};
          pg8::gemm_phase<pg8::EpiResid, pg8::LatentOrder, true, true>(L, g, S, E); }
        GRID_BAR(6);
        if (!lastl) {
            { LAUNDER(); phase_ctxfix(X, H, rssA, SLAB, modl + (size_t)4 * 12288 + 2 * DM, a.in[IN_GN2] + l * DM, modl + (size_t)4 * 12288 + 4 * DM, gw, NGW, lane); }
            GRID_BAR(7);
        }
        { LAUNDER(); pg8::Gemm g{H, W1, MTOK, DFF, DM}; pg8::LatentOrder S; S.init(DFF, DM, G, wg, lastl ? 0 : 1);
          pg8::EpiBf16<2, false, true> E{ACT, DFF, nullptr, rssA, biasl + DINP, BIASW};
          pg8::gemm_phase<pg8::EpiBf16<2, false, true>, pg8::LatentOrder, true, true>(L, g, S, E);
          constexpr int NU = (MTOK / 256) * (DFF / 256); const int rem = NU % G;
          if (!lastl && rem != 0 && wg >= rem) { LAS float* scr = (LAS float*)(L + wave * 8448); LAS float* tab = (LAS float*)(L + 8 * 8448); const int worker = (wg - rem) * NWAVES + wave, nworkers = (G - rem) * NWAVES;
              conv_load_tab(tab, modn, 3, tid); conv_A(csrc, cnext, l + 1, CV_A_SPLIT, CV_I1, worker, nworkers, scr, tab, biasn, lane); conv_B(csrc, cnext, l + 1, 0, CV_B_SPLIT, worker, nworkers, scr, lane); __syncthreads(); } }
        GRID_BAR(8);
        { LAUNDER(); pg8::Gemm g{ACT, W2, MTOK, DM, DFF}; pg8::LatentOrder S; S.init(DM, DFF, G, wg, lastl ? 0 : 2);
          pg8::EpiResid E{X, modl, 5 * DM, SLAB, DFF / 64, lastl ? nullptr : H, a.in[IN_GN1] + (l + 1) * DM, MOD + (size_t)(l + 1) * 5 * 12288 + DM, ROWSS + (size_t)(2 * l + 3) * MTOK};
          pg8::gemm_phase<pg8::EpiResid, pg8::LatentOrder, true, true>(L, g, S, E); }
        GRID_BAR(9);
    }
    { LAUNDER(); phase_final(X, a.out, a.in[IN_GFINAL], gw, NGW, lane); }
}

extern "C" void kernel_launch(void* const* d_in, const int* in_sizes, int n_in, void* d_out, int out_size, void* d_ws, size_t ws_size, hipStream_t stream) {
    static int grid = 0;
    if (grid == 0) {
        if (n_in != 20 || in_sizes[0] != NB * SEQ * DM || out_size != NB * SEQ * DM || ws_size < WS_END) {
            fprintf(stderr, "kernel_launch: unexpected shapes (n_in %d, in0 %d, out %d, ws %zu, need %zu); nothing launched\n", n_in, n_in > 0 ? in_sizes[0] : -1, out_size, ws_size, (size_t)WS_END); grid = -1; return; }
        int dev = 0, cus = 0, per_cu = 0;
        if (hipGetDevice(&dev) != hipSuccess || hipDeviceGetAttribute(&cus, hipDeviceAttributeMultiprocessorCount, dev) != hipSuccess) { fprintf(stderr, "kernel_launch: device query failed\n"); grid = -1; return; }
        if (hipFuncSetAttribute((const void*)fwd_kernel, hipFuncAttributeMaxDynamicSharedMemorySize, LDS_BYTES) != hipSuccess) { fprintf(stderr, "kernel_launch: hipFuncSetAttribute failed\n"); grid = -1; return; }
        if (hipOccupancyMaxActiveBlocksPerMultiprocessor(&per_cu, (const void*)fwd_kernel, NTHR, LDS_BYTES) != hipSuccess || per_cu < 1)
            fprintf(stderr, "kernel_launch: note: occupancy query reports %d workgroups per CU\n", per_cu);
        (void)hipGetLastError();
        grid = cus;
    }
    if (grid < 0) return;
    if (hipMemsetAsync((char*)d_ws + WS_CTL, 0, CTL_ZERO_BYTES, stream) != hipSuccess) { fprintf(stderr, "kernel_launch: memset failed\n"); return; }
    Args a{};
    for (int i = 0; i < 20; ++i) a.in[i] = (const float*)d_in[i];
    a.out = (float*)d_out; a.ws = (unsigned char*)d_ws;
    hipLaunchKernelGGL(fwd_kernel, dim3(grid), dim3(NTHR), LDS_BYTES, stream, a);
    const hipError_t le = hipPeekAtLastError();
    if (le != hipSuccess) fprintf(stderr, "kernel_launch: launch failed: %s\n", hipGetErrorName(le));
}
```

```cpp
#include <hip/hip_runtime.h>
#include <cstdio>
#include <cstdint>
#include <cmath>


namespace pg8 {
#define PG8_LAS __attribute__((address_space(3)))
typedef unsigned short bf16_t;
typedef short bf16x8 __attribute__((ext_vector_type(8)));
typedef float f32x4 __attribute__((ext_vector_type(4)));
typedef unsigned u32x4 __attribute__((ext_vector_type(4)));
constexpr int BM = 256, BK = 64, HALF = 128, HTB = HALF * BK * 2  , STAGE_BYTES = 8 * HTB, NXCD = 8, WGM = 8;

__host__ __device__ __forceinline__ int lds_byte(int r, int c) { const int st = (r >> 4) * 2 + (c >> 5), rr = r & 15, cc = c & 31, ob = rr * 64 + cc * 2; return st * 1024 + (ob ^ (((ob >> 9) & 1) << 5)); }
__host__ __device__ __forceinline__ void stage_rc(int b, int& R, int& C) { const int st = b / 1024, sb = b % 1024, swz = sb ^ (((sb >> 9) & 1) << 5); R = (st >> 1) * 16 + swz / 64; C = (st & 1) * 32 + (swz % 64) / 2; }
__host__ __device__ __forceinline__ int perm32(int rho) { const int n = rho >> 4, i = rho & 15; return 8 * (i >> 2) + 4 * n + (i & 3); }

struct Unit { int pm, pn, k0, nt; };
struct Gemm { const bf16_t* A; const bf16_t* Bt; int M, N, K; };

struct StaticOrder {
    int nM, nN, nwg, G, c, fullnt;
    __host__ __device__ void init(int M, int N, int K, int G_, int c_) { nM = M / BM; nN = N / BM; nwg = nM * nN; G = G_; c = c_; fullnt = K / BK; }
    __host__ __device__ bool next(int i, Unit& u) const {
        const long L = (long)i * G + c; if (L >= nwg) return false;
        int wgid = (int)L; { const int q = nwg / NXCD, r = nwg % NXCD, xcd = wgid % NXCD, off = wgid / NXCD; wgid = (xcd < r ? xcd * (q + 1) : r * (q + 1) + (xcd - r) * q) + off; }
        const int nig = WGM * nN, gid = wgid / nig, fm = gid * WGM, gsz = (nM - fm) < WGM ? (nM - fm) : WGM;
        u.pm = fm + ((wgid % nig) % gsz); u.pn = (wgid % nig) / gsz; u.k0 = 0; u.nt = fullnt; return true;
    }
    __device__ __forceinline__ void a_ready(const Unit&) const {}
    __device__ __forceinline__ void done(const Unit&) const {}
};

struct LatentOrder {
    StaticOrder so; int nN, mode;
    __host__ __device__ void init(int N, int K, int G_, int c_, int mode_) { so.init(128 * BM, N, K, G_, c_); nN = N / BM; mode = mode_; }
    __host__ __device__ bool next(int i, Unit& u) const {
        if (so.next(i, u)) { u.pm = u.pm + u.pm / 32 + 1; return true; }
        const long L = (long)i * so.G + so.c - so.nwg;
        if (mode == 1) { if (L >= 4 * nN) return false; u.pm = 33 * (int)(L / nN); u.pn = (int)(L % nN); u.k0 = 0; u.nt = so.fullnt; return true; }
        if (mode == 2) { if (L >= 32 * nN) return false; const int tile = (int)(L >> 3), ks = (int)(L & 7); u.pm = 33 * (tile / nN); u.pn = tile % nN; u.nt = so.fullnt >> 3; u.k0 = ks * u.nt; return true; }
        return false;
    }
    __device__ __forceinline__ void a_ready(const Unit&) const {}
    __device__ __forceinline__ void done(const Unit&) const {}
};

__device__ __forceinline__ unsigned cvt_pk_bf16(float lo, float hi) { unsigned r; asm volatile("v_cvt_pk_bf16_f32 %0, %1, %2" : "=v"(r) : "v"(lo), "v"(hi)); return r; }
typedef float f32x2 __attribute__((ext_vector_type(2)));

typedef float f32x2v __attribute__((ext_vector_type(2))); typedef __bf16 bf16x2v __attribute__((ext_vector_type(2)));
__device__ __forceinline__ unsigned pkbf(float lo, float hi) { f32x2v v = {lo, hi}; bf16x2v b = __builtin_convertvector(v, bf16x2v); return __builtin_bit_cast(unsigned, b); }

template <int ACT, bool GATES, bool NORMED, int NW = 2048, bool BIASED = true> struct EpiBf16 {
    static constexpr bool PERM = true, AFTER_DRAIN = false;
    bf16_t* O; int ldc; float* gates; const unsigned long long* rowss; const long long* bias; int ldb; unsigned long long* rs2 = nullptr; int rs2_stride = 0;
    __device__ __forceinline__ void operator()(const f32x4 (&acc)[2][2][4][2], const Unit& u, int wr, int wc, int fr, int fq) const {
        const int row0 = u.pm * BM + wr * 64 + fr; const int col0 = u.pn * BM + wc * 32 + 8 * fq;
        f32x4 bv[2][2]; float tots[4];
        if (NORMED && BIASED) { const int bb = u.pm / 33, bp = (u.pm - bb * 33 == 0) ? 4 : bb; const long long* bptr = bias + (size_t)bp * ldb + col0;
#pragma unroll
            for (int bj = 0; bj < 2; ++bj)
#pragma unroll
                for (int n = 0; n < 2; ++n)
#pragma unroll
                    for (int e = 0; e < 4; ++e) bv[bj][n][e] = (float)bptr[bj * HALF + 4 * n + e] * 2.3283064365386963e-10f; }
#pragma unroll
        for (int ai = 0; ai < 2; ++ai)
#pragma unroll
            for (int m = 0; m < 4; ++m) { const int row = row0 + ai * HALF + m * 16; bf16_t* rowp = O + (size_t)row * ldc + col0;
                float rstd = 1.f; if (NORMED) rstd = __builtin_amdgcn_rsqf((float)rowss[row] * (1.f / (float)NW / 16777216.f) + 1e-6f);
                float ssq = 0.f;
#pragma unroll
                for (int bj = 0; bj < 2; ++bj) { f32x4 v0 = acc[ai][bj][m][0], v1 = acc[ai][bj][m][1];
                    if (NORMED) { if (BIASED) { v0 = v0 * rstd + bv[bj][0]; v1 = v1 * rstd + bv[bj][1]; } else { v0 = v0 * rstd; v1 = v1 * rstd; } }
                    if (GATES) ssq += ((v0[0] * v0[0] + v0[1] * v0[1]) + (v0[2] * v0[2] + v0[3] * v0[3])) + ((v1[0] * v1[0] + v1[1] * v1[1]) + (v1[2] * v1[2] + v1[3] * v1[3]));
                    if (GATES) { if (bj == 0 && u.pn == 12 && wc == 2 && fq < 2) { float* gp = gates + (size_t)row * 16 + 8 * fq; *(f32x4*)gp = v0; *(f32x4*)(gp + 4) = v1; } }
                    if (ACT == 2) {
#pragma unroll
                        for (int e = 0; e < 4; ++e) { float a = v0[e] > 0.f ? v0[e] : 0.f; v0[e] = a * a; float b = v1[e] > 0.f ? v1[e] : 0.f; v1[e] = b * b; } }
                    u32x4 w; w.x = pkbf(v0[0], v0[1]); w.y = pkbf(v0[2], v0[3]); w.z = pkbf(v1[0], v1[1]); w.w = pkbf(v1[2], v1[3]);
                    *(u32x4*)(rowp + bj * HALF) = w; }
                if (GATES) { if (u.pn < 3) {
                    const auto r1 = __builtin_amdgcn_permlane16_swap(__float_as_uint(ssq), __float_as_uint(ssq), false, false); ssq = __uint_as_float(r1[0]) + __uint_as_float(r1[1]);
                    const auto r2 = __builtin_amdgcn_permlane32_swap(__float_as_uint(ssq), __float_as_uint(ssq), false, false); tots[m] = __uint_as_float(r2[0]) + __uint_as_float(r2[1]);
                    if (m == 3) { const float mine = fq == 0 ? tots[0] : fq == 1 ? tots[1] : fq == 2 ? tots[2] : tots[3];
                        atomicAdd(rs2 + (size_t)(u.pn == 2 ? rs2_stride : 0) + (u.pm * BM + ai * HALF + wr * 64 + fq * 16 + fr), (unsigned long long)(mine * 16777216.f)); } } } }
    }
};
struct EpiResid {
    static constexpr bool PERM = false, AFTER_DRAIN = false;
    bf16_t* X; const float* modl; int goff; float* slab; int fullnt;
    bf16_t* hx; const float* ng; const float* nsc; unsigned long long* rowss;
    __device__ __forceinline__ void operator()(const f32x4 (&acc)[2][2][4][2], const Unit& u, int wr, int wc, int fr, int fq) const {
        const int bb = u.pm / 33, bp = (u.pm - bb * 33 == 0) ? 4 : bb;
        const int col0 = u.pn * BM + wc * 32 + 4 * fq;
        if (u.nt != fullnt) {
            float* sp0 = slab + ((size_t)(u.k0 / u.nt) * 1024 + bb * 256 + wr * 64 + fr) * 2048 + col0;
#pragma unroll
            for (int ai = 0; ai < 2; ++ai)
#pragma unroll
                for (int m = 0; m < 4; ++m) { float* sp = sp0 + (size_t)(ai * HALF + m * 16) * 2048;
#pragma unroll
                    for (int bj = 0; bj < 2; ++bj)
#pragma unroll
                        for (int n = 0; n < 2; ++n) *(f32x4*)(sp + bj * HALF + n * 16) = acc[ai][bj][m][n]; }
            return;
        }
        const float* gate = modl + (size_t)bp * 12288 + goff;
        f32x4 gv[2][2], gm[2][2];
#pragma unroll
        for (int bj = 0; bj < 2; ++bj)
#pragma unroll
            for (int n = 0; n < 2; ++n) { gv[bj][n] = *(const f32x4*)(gate + col0 + bj * HALF + n * 16);
                if (hx) { const f32x4 g4 = *(const f32x4*)(ng + col0 + bj * HALF + n * 16), s4 = *(const f32x4*)(nsc + (size_t)bp * 12288 + col0 + bj * HALF + n * 16); gm[bj][n] = g4 * (s4 + 1.f); } }
        const int hc = u.pn * BM + wc * 32 + ((fq & 1) ? 16 + 4 * (fq - 1) : 4 * fq);
        u32x4 xr[4][2]; float tots[4];
#define ER_LOAD(g) do { const bf16_t* xp_ = X + (size_t)(u.pm * BM + ((g) >> 2) * HALF + wr * 64 + ((g) & 3) * 16 + fr) * 2048 + hc; \
        _Pragma("unroll") for (int bj = 0; bj < 2; ++bj) xr[(g) & 3][bj] = *(const u32x4*)(xp_ + bj * HALF); } while (0)
        ER_LOAD(0); ER_LOAD(1); ER_LOAD(2); ER_LOAD(3);
        asm volatile("" ::: "memory");
#pragma unroll
        for (int g = 0; g < 8; ++g) { const int ai = g >> 2, m = g & 3; const int row = u.pm * BM + ai * HALF + wr * 64 + m * 16 + fr; float ss = 0.f;
#pragma unroll
            for (int bj = 0; bj < 2; ++bj) { const u32x4 raw = xr[g & 3][bj];
                const auto lx = __builtin_amdgcn_permlane16_swap(raw[0], raw[2], false, false); const auto ly = __builtin_amdgcn_permlane16_swap(raw[1], raw[3], false, false);
                unsigned xw[2][2], hw[2][2];
#pragma unroll
                for (int n = 0; n < 2; ++n) { const unsigned wx = lx[n], wy = ly[n];
                    f32x4 xv = {__uint_as_float(wx << 16), __uint_as_float(wx & 0xffff0000u), __uint_as_float(wy << 16), __uint_as_float(wy & 0xffff0000u)};
                    xv = xv + gv[bj][n] * acc[ai][bj][m][n]; xw[n][0] = pkbf(xv[0], xv[1]); xw[n][1] = pkbf(xv[2], xv[3]);
                    if (hx) { ss += (xv[0] * xv[0] + xv[1] * xv[1]) + (xv[2] * xv[2] + xv[3] * xv[3]); const f32x4 hv = xv * gm[bj][n]; hw[n][0] = pkbf(hv[0], hv[1]); hw[n][1] = pkbf(hv[2], hv[3]); } }
                { const auto sx = __builtin_amdgcn_permlane16_swap(xw[0][0], xw[1][0], false, false); const auto sy = __builtin_amdgcn_permlane16_swap(xw[0][1], xw[1][1], false, false);
                  *(u32x4*)(X + (size_t)row * 2048 + bj * HALF + hc) = (u32x4){sx[0], sy[0], sx[1], sy[1]}; }
                if (hx) { const auto rx = __builtin_amdgcn_permlane16_swap(hw[0][0], hw[1][0], false, false); const auto ry = __builtin_amdgcn_permlane16_swap(hw[0][1], hw[1][1], false, false);
                    *(u32x4*)(hx + (size_t)row * 2048 + bj * HALF + hc) = (u32x4){rx[0], ry[0], rx[1], ry[1]}; } }
            if (hx) {
                const auto r1 = __builtin_amdgcn_permlane16_swap(__float_as_uint(ss), __float_as_uint(ss), false, false); ss = __uint_as_float(r1[0]) + __uint_as_float(r1[1]);
                const auto r2 = __builtin_amdgcn_permlane32_swap(__float_as_uint(ss), __float_as_uint(ss), false, false); tots[m] = __uint_as_float(r2[0]) + __uint_as_float(r2[1]);
                if (m == 3) { const float mine = fq == 0 ? tots[0] : fq == 1 ? tots[1] : fq == 2 ? tots[2] : tots[3];
                    atomicAdd(rowss + (u.pm * BM + ai * HALF + wr * 64 + fq * 16 + fr), (unsigned long long)(mine * 16777216.f)); } }
            asm volatile("" ::: "memory");
            if (g + 4 < 8) { ER_LOAD(g + 4); asm volatile("" ::: "memory"); } }
#undef ER_LOAD
    }
};

template <class Epi, class Sched, bool ALIGN_EPI = false, bool SP2 = false, int LDA = 0>
__device__ __forceinline__ void gemm_phase(PG8_LAS unsigned char* lds, const Gemm g, const Sched& S, const Epi& E) {
    int tid_l = threadIdx.x; asm volatile("" : "+v"(tid_l));
    const int tid = tid_l, wid = __builtin_amdgcn_readfirstlane(tid >> 6), lane = tid & 63, wr = wid >> 2, wc = wid & 3, fr = lane & 15, fq = lane >> 4;
    const int K = g.K; const int lda = LDA ? LDA : K;
    unsigned voffA[2], voffB[2];
#pragma unroll
    for (int i = 0; i < 2; ++i) { int R, C; stage_rc(tid * 16 + i * 8192, R, C); const int Rb = Epi::PERM ? ((R & ~31) + perm32(R & 31)) : R;
        voffA[i] = (unsigned)(R * lda + C) * 2u; voffB[i] = (unsigned)(Rb * K + C) * 2u; }
    const size_t kstep = (size_t)(BK * 2);
    const size_t hstep = (size_t)HALF * K * 2;
    const size_t tstep = 2 * hstep;
    const size_t hstepA = LDA ? (size_t)HALF * LDA * 2 : hstep, tstepA = 2 * hstepA;
    const unsigned ldsw = (unsigned)wid * 1024u;
    const int aoff = lds_byte(wr * 64 + fr, fq * 8), boff = lds_byte(wc * 32 + fr, fq * 8);
#define PG8_SA(b, h) (((b) * 2 + (h)) * HTB)
#define PG8_SB(b, h) ((4 + (b) * 2 + (h)) * HTB)
#define PG8_STAGE(bufoff, gbase, voff) do { _Pragma("unroll") for (int _i = 0; _i < 2; ++_i) \
        __builtin_amdgcn_global_load_lds((const unsigned*)((const char*)(gbase) + (voff)[_i]), (PG8_LAS unsigned*)(lds + (bufoff) + ldsw + _i * 8192), 16, 0, 0); } while (0)
#define PG8_LDA(dst, b, h) do { _Pragma("unroll") for (int m = 0; m < 4; ++m) _Pragma("unroll") for (int k = 0; k < 2; ++k) dst[m][k] = *(const PG8_LAS bf16x8*)(lds + PG8_SA(b, h) + aoff + m * 2048 + k * 1024); } while (0)
#define PG8_LDB(dst, b, h) do { _Pragma("unroll") for (int n = 0; n < 2; ++n) _Pragma("unroll") for (int k = 0; k < 2; ++k) dst[n][k] = *(const PG8_LAS bf16x8*)(lds + PG8_SB(b, h) + boff + n * 2048 + k * 1024); } while (0)
#define PG8_MMA(ai, bj, At, Bt) do { __builtin_amdgcn_s_setprio(1); _Pragma("unroll") for (int m = 0; m < 4; ++m) _Pragma("unroll") for (int n = 0; n < 2; ++n) _Pragma("unroll") for (int k = 0; k < 2; ++k) \
        acc[ai][bj][m][n] = __builtin_amdgcn_mfma_f32_16x16x32_bf16(Bt[n][k], At[m][k], acc[ai][bj][m][n], 0, 0, 0); __builtin_amdgcn_s_setprio(0); } while (0)
#define PG8_WAIT_V(n) asm volatile("s_waitcnt vmcnt(" #n ")" ::: "memory")
#define PG8_WAIT_L(n) asm volatile("s_waitcnt lgkmcnt(" #n ")" ::: "memory")
#define PG8_BAR __builtin_amdgcn_s_barrier()
#define PG8_SCHED __builtin_amdgcn_sched_barrier(0)
    Unit cur, nxt; int ui = 0;
    if (!S.next(0, cur)) return;
    f32x4 acc[2][2][4][2];
#pragma unroll
    for (int a = 0; a < 2; ++a)
#pragma unroll
        for (int b = 0; b < 2; ++b)
#pragma unroll
            for (int m = 0; m < 4; ++m)
#pragma unroll
                for (int n = 0; n < 2; ++n) acc[a][b][m][n] = (f32x4){0.f, 0.f, 0.f, 0.f};
    bf16x8 At[4][2], B0[2][2], B1[2][2];
    int nt = cur.nt;
    const char* cA = (const char*)g.A + (size_t)cur.pm * tstepA + (size_t)cur.k0 * kstep; const char* cB = (const char*)g.Bt + (size_t)cur.pn * tstep + (size_t)cur.k0 * kstep;
    S.a_ready(cur);
    if constexpr (SP2) {
        PG8_STAGE(PG8_SB(0, 0), cB, voffB); PG8_STAGE(PG8_SB(0, 1), cB + hstep, voffB); PG8_STAGE(PG8_SA(0, 0), cA, voffA); PG8_STAGE(PG8_SA(0, 1), cA + hstepA, voffA);
        if (wr == 1) PG8_BAR;
        PG8_WAIT_V(2); PG8_BAR;
        PG8_STAGE(PG8_SB(1, 0), cB + kstep, voffB); PG8_STAGE(PG8_SA(1, 0), cA + kstep, voffA); PG8_STAGE(PG8_SB(1, 1), cB + hstep + kstep, voffB);
        PG8_WAIT_V(6); PG8_BAR;
    } else {
        PG8_STAGE(PG8_SB(0, 0), cB, voffB); PG8_STAGE(PG8_SA(0, 0), cA, voffA); PG8_STAGE(PG8_SB(0, 1), cB + hstep, voffB); PG8_STAGE(PG8_SA(0, 1), cA + hstepA, voffA);
        if (wr == 1) PG8_BAR;
        PG8_WAIT_V(4); PG8_BAR;
        PG8_STAGE(PG8_SB(1, 0), cB + kstep, voffB); PG8_STAGE(PG8_SA(1, 0), cA + kstep, voffA); PG8_STAGE(PG8_SB(1, 1), cB + hstep + kstep, voffB);
        PG8_WAIT_V(6); PG8_BAR;
    }
    for (;;) {
        const bool has_next = S.next(ui + 1, nxt);
        const char* nA = has_next ? (const char*)g.A + (size_t)nxt.pm * tstepA + (size_t)nxt.k0 * kstep : cA; const char* nB = has_next ? (const char*)g.Bt + (size_t)nxt.pn * tstep + (size_t)nxt.k0 * kstep : cB;
        for (int t = 0; t < nt; t += 2) {
            const bool last = (t == nt - 2);
            const char* a1 = cA + (size_t)(t + 1) * kstep;
            const char* a2 = last ? nA : cA + (size_t)(t + 2) * kstep; const char* b2 = last ? nB : cB + (size_t)(t + 2) * kstep;
            const char* a3 = a2 + kstep; const char* b3 = b2 + kstep;
            if (last && has_next) S.a_ready(nxt);
            if constexpr (SP2) {
            PG8_LDB(B0, 0, 0); PG8_LDB(B1, 0, 1); PG8_SCHED; PG8_LDA(At, 0, 0); PG8_STAGE(PG8_SA(1, 1), a1 + hstepA, voffA);
            PG8_WAIT_V(8); PG8_WAIT_L(0); PG8_BAR; PG8_MMA(0, 0, At, B0); PG8_MMA(0, 1, At, B1); PG8_BAR; PG8_SCHED;
            PG8_LDA(At, 0, 1); PG8_STAGE(PG8_SB(0, 0), b2, voffB); PG8_STAGE(PG8_SB(0, 1), b2 + hstep, voffB); PG8_STAGE(PG8_SA(0, 0), a2, voffA);
            PG8_WAIT_V(8); PG8_WAIT_L(0); PG8_BAR; PG8_MMA(1, 0, At, B0); PG8_MMA(1, 1, At, B1); PG8_BAR; PG8_SCHED;
            PG8_LDB(B0, 1, 0); PG8_LDB(B1, 1, 1); PG8_SCHED; PG8_LDA(At, 1, 0); PG8_STAGE(PG8_SA(0, 1), a2 + hstepA, voffA);
            PG8_WAIT_V(8); PG8_WAIT_L(0); PG8_BAR; PG8_MMA(0, 0, At, B0); PG8_MMA(0, 1, At, B1); PG8_BAR; PG8_SCHED;
            PG8_LDA(At, 1, 1); PG8_STAGE(PG8_SB(1, 0), b3, voffB); PG8_STAGE(PG8_SB(1, 1), b3 + hstep, voffB); PG8_STAGE(PG8_SA(1, 0), a3, voffA);
            PG8_WAIT_V(8); PG8_WAIT_L(0); PG8_BAR; PG8_MMA(1, 0, At, B0); PG8_MMA(1, 1, At, B1); PG8_BAR; PG8_SCHED;
            } else {
            PG8_LDB(B0, 0, 0); PG8_SCHED; PG8_LDA(At, 0, 0); PG8_STAGE(PG8_SA(1, 1), a1 + hstepA, voffA);
            PG8_WAIT_L(8); PG8_BAR; PG8_WAIT_L(0); PG8_MMA(0, 0, At, B0); PG8_BAR; PG8_SCHED;
            PG8_LDB(B1, 0, 1); PG8_STAGE(PG8_SB(0, 0), b2, voffB);
            PG8_BAR; PG8_WAIT_L(0); PG8_MMA(0, 1, At, B1); PG8_BAR;
            PG8_LDA(At, 0, 1); PG8_STAGE(PG8_SA(0, 0), a2, voffA);
            PG8_BAR; PG8_WAIT_L(0); PG8_MMA(1, 0, At, B0); PG8_BAR; PG8_SCHED;
            PG8_STAGE(PG8_SB(0, 1), b2 + hstep, voffB);
            PG8_WAIT_V(6); PG8_BAR; PG8_MMA(1, 1, At, B1); PG8_BAR;
            PG8_LDB(B0, 1, 0); PG8_SCHED; PG8_LDA(At, 1, 0); PG8_STAGE(PG8_SA(0, 1), a2 + hstepA, voffA);
            PG8_WAIT_L(8); PG8_BAR; PG8_WAIT_L(0); PG8_MMA(0, 0, At, B0); PG8_BAR; PG8_SCHED;
            PG8_LDB(B1, 1, 1); PG8_STAGE(PG8_SB(1, 0), b3, voffB);
            PG8_BAR; PG8_WAIT_L(0); PG8_MMA(0, 1, At, B1); PG8_BAR;
            PG8_LDA(At, 1, 1); PG8_STAGE(PG8_SA(1, 0), a3, voffA);
            PG8_BAR; PG8_WAIT_L(0); PG8_MMA(1, 0, At, B0); PG8_BAR; PG8_SCHED;
            PG8_STAGE(PG8_SB(1, 1), b3 + hstep, voffB);
            PG8_WAIT_V(6); PG8_BAR; PG8_MMA(1, 1, At, B1); PG8_BAR;
            }
        }
        if constexpr (ALIGN_EPI) { if (wr == 0) PG8_BAR; }
        if constexpr (!Epi::AFTER_DRAIN) { E(acc, cur, wr, wc, fr, fq); S.done(cur); }
        if (!has_next) break;
#pragma unroll
        for (int a = 0; a < 2; ++a)
#pragma unroll
            for (int b = 0; b < 2; ++b)
#pragma unroll
                for (int m = 0; m < 4; ++m)
#pragma unroll
                    for (int n = 0; n < 2; ++n) acc[a][b][m][n] = (f32x4){0.f, 0.f, 0.f, 0.f};
        cur = nxt; cA = nA; cB = nB; nt = cur.nt; ++ui;
        if constexpr (ALIGN_EPI) { if (wr == 1) PG8_BAR; }
    }
    PG8_WAIT_V(0);
    if constexpr (!ALIGN_EPI) { if (wr == 0) PG8_BAR; }
    PG8_BAR;
    if constexpr (Epi::AFTER_DRAIN) { E.fused(acc, cur, wr, wc, fr, fq, lds, wid, lane); S.done(cur); }
#undef PG8_SA
#undef PG8_SB
#undef PG8_STAGE
#undef PG8_LDA
#undef PG8_LDB
#undef PG8_MMA
#undef PG8_WAIT_V
#undef PG8_WAIT_L
#undef PG8_BAR
#undef PG8_SCHED
}
}
#define LAS __attribute__((address_space(3)))
typedef __attribute__((address_space(1))) unsigned gu32;
#define XB_TMO      128
#define XB_XCNT(j)  (256  + 64 * (j))
#define XB_XSUB(j)  (1280 + 64 * (j))
#define XB_XGEN(j)  (2304 + 64 * (j))
#define XB_TOP      3328
#define XB_TOPGEN   3392
#define XCD_BAR_WORDS 3456
#define XB_SPIN_CAP (1u << 18)

__device__ __forceinline__ unsigned xb_ld(unsigned* p)              { return __hip_atomic_load(p, __ATOMIC_RELAXED, __HIP_MEMORY_SCOPE_AGENT); }
__device__ __forceinline__ unsigned xb_add(unsigned* p, unsigned v) { return __hip_atomic_fetch_add(p, v, __ATOMIC_RELAXED, __HIP_MEMORY_SCOPE_AGENT); }
__device__ __forceinline__ unsigned xb_xcc_id() { return (unsigned)__builtin_amdgcn_s_getreg((3 << 11) | 20) & 0xFu; }
#define XB_SPIN(cond, bar) do { unsigned _sp = 0; while (cond) { __builtin_amdgcn_s_sleep(1); \
    if ((++_sp & 255u) == 0u) { if (xb_ld(&(bar)[XB_TMO])) break; if (_sp > XB_SPIN_CAP) { atomicAdd(&(bar)[XB_TMO], 1u); break; } } } } while (0)

struct XcdBarrier {
    unsigned* bar; unsigned x;
    volatile LAS unsigned* st;
};

__device__ __forceinline__ XcdBarrier xcd_barrier_post(unsigned* bar, volatile LAS unsigned* st) {
    XcdBarrier b; b.bar = bar; b.x = xb_xcc_id(); b.st = st;
    if (threadIdx.x == 0) (void)xb_add(&bar[XB_XCNT(b.x)], 1u);
    return b;
}
__device__ __forceinline__ void xcd_barrier_complete(unsigned* bar, unsigned x, unsigned& nloc, unsigned& nx) {
    const unsigned G = gridDim.x * gridDim.y * gridDim.z;
    unsigned sum, cnt, mine, sp = 0u;
    for (;;) {
        sum = 0u; cnt = 0u; mine = 0u;
#pragma unroll
        for (unsigned j = 0; j < 16; ++j) { const unsigned c = xb_ld(&bar[XB_XCNT(j)]); sum += c; cnt += (c > 0u) ? 1u : 0u; mine = (j == x) ? c : mine; }
        if (sum == G) break;
        __builtin_amdgcn_s_sleep(1);
        if ((++sp & 255u) == 0u) { if (xb_ld(&bar[XB_TMO])) break; if (sp > XB_SPIN_CAP) { atomicAdd(&bar[XB_TMO], 1u); break; } }
    }
    nloc = mine > 0u ? mine : 1u; nx = cnt > 0u ? cnt : 1u;
}

__device__ __forceinline__ void xcd_barrier(const XcdBarrier& b) {
    asm volatile("s_waitcnt vmcnt(0)" ::: "memory");
    __syncthreads();
    if (threadIdx.x == 0) {
        unsigned* bar = b.bar;
        __builtin_amdgcn_s_waitcnt(0);
        unsigned nloc = b.st[0], nx = b.st[1];
        if (nloc == 0u) { xcd_barrier_complete(bar, b.x, nloc, nx); b.st[0] = nloc; b.st[1] = nx; }
        const unsigned old = xb_add(&bar[XB_XSUB(b.x)], 1u);
        const unsigned gen = old / nloc;
        if (old + 1u == (gen + 1u) * nloc) {
            __builtin_amdgcn_fence(__ATOMIC_RELEASE, "agent");
            asm volatile("s_waitcnt vmcnt(0)" ::: "memory");
            const unsigned og = xb_add(&bar[XB_TOP], 1u);
            const unsigned tg = og / nx;
            if (og + 1u == (tg + 1u) * nx) xb_add(&bar[XB_TOPGEN], 1u);
            else XB_SPIN(xb_ld(&bar[XB_TOPGEN]) == tg, bar);
            __builtin_amdgcn_fence(__ATOMIC_ACQUIRE, "agent");
            xb_add(&bar[XB_XGEN(b.x)], 1u);
            asm volatile("s_waitcnt vmcnt(0)" ::: "memory");
        } else {
            XB_SPIN(xb_ld(&bar[XB_XGEN(b.x)]) == gen, bar);
            __builtin_amdgcn_fence(__ATOMIC_ACQUIRE, "agent");
            asm volatile("s_waitcnt vmcnt(0)" ::: "memory");
        }
    }
    __syncthreads();
}

typedef unsigned short bf16;
typedef unsigned v4u __attribute__((ext_vector_type(4)));
typedef unsigned v2u __attribute__((ext_vector_type(2)));
typedef float f32x4 __attribute__((ext_vector_type(4)));
typedef float f32x16 __attribute__((ext_vector_type(16)));
typedef short bf16x8 __attribute__((ext_vector_type(8)));
typedef short s16x4 __attribute__((ext_vector_type(4)));
#define GAS __attribute__((address_space(1)))

constexpr int NWAVES = 8, NTHR = 512;
constexpr int NB = 4, SEQ = 8192, CTX = 256, TB = SEQ + CTX, MTOK = NB * TB, DM = 2048, DFF = 8192, DIN = 3664, DINP = 3840, DEPTH = 4;
constexpr int ZQ = 0, ZKV = 512, ZR = 768, ZSQ = 832, ZSK = 1856, ZSV = 1984, ZMQ = 2112, ZMK = 2368, ZMV = 2624, ZMG = 3136, ZMO = 3152;
constexpr int NSTEP = 132;
constexpr float NORM_EPS = 1e-6f;
constexpr float LOG2E = 1.4426950408889634f;

constexpr size_t MiB = 1u << 20;
constexpr size_t WS_CTL = 0, CTL_ZERO_BYTES = 1 * MiB;
constexpr size_t WS_MOD = 1 * MiB, WS_WIN = 2 * MiB, WS_WUQ = 17 * MiB, WS_WUKV = 18 * MiB, WS_WOUT = 19 * MiB, WS_W1 = 27 * MiB, WS_W2 = 59 * MiB;
constexpr size_t WS_X = 91 * MiB, WS_H = 355 * MiB, WS_GATES = 487 * MiB, WS_DC = 490 * MiB, WS_DN = 622 * MiB, WS_SC = 624 * MiB, WS_BIG = 625 * MiB;
constexpr size_t BG_Z = 0, BG_ZQN = 248 * MiB, BG_ZKVN = 281 * MiB, BG_KR = 298 * MiB, BG_QM = 303 * MiB, BG_KVM = 353 * MiB, BG_Y = 419 * MiB, BG_END = 551 * MiB;
constexpr size_t WS_SLAB = WS_BIG + BG_END;
constexpr size_t WS_STAT = WS_SLAB + 64 * MiB;
constexpr size_t WS_RS2 = WS_STAT + 5 * MiB;
constexpr size_t WS_WSET1 = WS_STAT + 8 * MiB;
constexpr size_t WSET_BYTES = 89 * MiB;
constexpr size_t WS_END = WS_WSET1 + WSET_BYTES;
constexpr int BIASW = DINP + DFF;
static_assert((size_t)MTOK * DM * 4 == 264 * MiB && (size_t)MTOK * DFF * 2 <= BG_END && (size_t)MTOK * DINP * 2 <= BG_ZQN, "ws map");
constexpr int CW_BAR = 4096;

constexpr int RING_BYTES = 131072, LDSCTL_OFF = 138240  , MISC_OFF = LDSCTL_OFF + 320, LDS_BYTES = 147456;

#define LDS_WAIT() asm volatile("s_waitcnt lgkmcnt(0)" ::: "memory")
__device__ __forceinline__ float bf2f(unsigned h) { return __uint_as_float(h << 16); }
__device__ __forceinline__ unsigned pk2(float lo, float hi) { return pg8::pkbf(lo, hi); }
__device__ __forceinline__ float wave_sum(float v) {
#pragma unroll
    for (int o = 1; o < 64; o <<= 1) v += __shfl_xor(v, o);
    return v;
}
__device__ __forceinline__ float wave_max(float v) {
#pragma unroll
    for (int o = 1; o < 64; o <<= 1) v = fmaxf(v, __shfl_xor(v, o));
    return v;
}
__device__ __forceinline__ float fexp2(float x) { return __builtin_amdgcn_exp2f(x); }
__device__ __forceinline__ float fexp(float x) { return __builtin_amdgcn_exp2f(x * LOG2E); }
__device__ __forceinline__ float sigmoidf_(float x) { return 1.f / (1.f + fexp(-x)); }
__device__ __forceinline__ float sigmoid_fast(float x) { return __builtin_amdgcn_rcpf(1.f + fexp(-x)); }
__device__ __forceinline__ float row16_sum(float v) {
    v += __int_as_float(__builtin_amdgcn_mov_dpp(__float_as_int(v), 0xB1, 0xf, 0xf, true));
    v += __int_as_float(__builtin_amdgcn_mov_dpp(__float_as_int(v), 0x4E, 0xf, 0xf, true));
    v += __int_as_float(__builtin_amdgcn_mov_dpp(__float_as_int(v), 0x124, 0xf, 0xf, true));
    v += __int_as_float(__builtin_amdgcn_mov_dpp(__float_as_int(v), 0x128, 0xf, 0xf, true));
    return v;
}
__device__ __forceinline__ float logsigf_(float x) { return fminf(x, 0.f) - log1pf(expf(-fabsf(x))); }
__device__ __forceinline__ float logsig_fast(float x) { return fminf(x, 0.f) - 0.6931471805599453f * __builtin_amdgcn_logf(1.f + fexp(-fabsf(x))); }
__device__ __forceinline__ void rope_cs(int pos, int i, float& c, float& s) {
    const float inv = fexp2(-0.8304820237218406f * (float)i);
    float rev = (float)pos * inv * 0.15915494309189535f; rev -= floorf(rev);
    c = __builtin_amdgcn_cosf(rev); s = __builtin_amdgcn_sinf(rev);
}

__device__ __forceinline__ void phase_mod(const float* c, const float* c_ctx, const float* w_mod, const float* b_mod, float* MOD, LAS unsigned char* L, int wg, int G, int tid) {
    LAS float* sv = (LAS float*)L;
    LAS float* red = (LAS float*)(L + 40960);
    for (int i = tid; i < 5 * DM; i += NTHR) { const int b = i / DM, k = i - b * DM; const float v = b < 4 ? c[b * DM + k] : c_ctx[k]; sv[i] = v / (1.f + expf(-v)); }
    __syncthreads();
    const int wave = tid >> 6, lane = tid & 63;
    for (int item = wg; item < DEPTH * 192; item += G) {
        const int l = item / 192, cg = item - l * 192;
        const float* W = w_mod + (size_t)l * DM * 12288 + cg * 64 + lane;
        float a0 = 0.f, a1 = 0.f, a2 = 0.f, a3 = 0.f, a4 = 0.f;
        const int k0 = wave * 256;
#pragma unroll 8
        for (int k = k0; k < k0 + 256; ++k) { const float w = W[(size_t)k * 12288];
            a0 += sv[k] * w; a1 += sv[DM + k] * w; a2 += sv[2 * DM + k] * w; a3 += sv[3 * DM + k] * w; a4 += sv[4 * DM + k] * w; }
        red[(wave * 5 + 0) * 64 + lane] = a0; red[(wave * 5 + 1) * 64 + lane] = a1; red[(wave * 5 + 2) * 64 + lane] = a2; red[(wave * 5 + 3) * 64 + lane] = a3; red[(wave * 5 + 4) * 64 + lane] = a4;
        __syncthreads();
        if (tid < 320) { const int b = tid >> 6, ln = tid & 63; float s = 0.f;
#pragma unroll
            for (int w = 0; w < 8; ++w) s += red[(w * 5 + b) * 64 + ln];
            MOD[(size_t)(l * 5 + b) * 12288 + cg * 64 + ln] = s + b_mod[l * 12288 + cg * 64 + ln]; }
        __syncthreads();
    }
}

__device__ __forceinline__ void transpose_item(const float* W, int K, int N, int NP, bf16* WT, LAS float* scr, int item, int lane, const LAS float* tab, long long* bias, int ldb, const float* kscale = nullptr) {
    const int nblk = NP / 32, kb = item / nblk, nb = item - kb * nblk, k0 = 64 * kb, n0 = 32 * nb;
    const int n = n0 + (lane & 31); const bool okn = n < N;
    float wv_[32];
    const float* wp = W + (size_t)(k0 + (lane >> 5)) * N + (okn ? n : 0);
#pragma unroll
    for (int i = 0; i < 32; ++i) wv_[i] = wp[(size_t)(2 * i) * N];
#pragma unroll
    for (int i = 0; i < 32; ++i) { if (!okn) wv_[i] = 0.f; if (kscale != nullptr) wv_[i] *= kscale[k0 + 2 * i + (lane >> 5)]; scr[(2 * i + (lane >> 5)) * 33 + (lane & 31)] = wv_[i]; }
    if (tab != nullptr) {
        const LAS float* tp = tab + k0 + (lane >> 5);
#pragma unroll
        for (int bp = 0; bp < 5; ++bp) { float s = 0.f;
#pragma unroll
            for (int i = 0; i < 32; ++i) s += tp[bp * 2048 + 2 * i] * wv_[i];
            s += __shfl_xor(s, 32);
            if (lane < 32) atomicAdd((unsigned long long*)(bias + (size_t)bp * ldb + n), (unsigned long long)(long long)(s * 4294967296.f)); }
    }
    LDS_WAIT(); asm volatile("" ::: "memory");
    const int c = lane & 7;
#pragma unroll
    for (int j = 0; j < 4; ++j) { const int nn = (lane >> 3) + 8 * j; const LAS float* s = scr + (8 * c) * 33 + nn;
        v4u o; o.x = pk2(s[0 * 33], s[1 * 33]); o.y = pk2(s[2 * 33], s[3 * 33]); o.z = pk2(s[4 * 33], s[5 * 33]); o.w = pk2(s[6 * 33], s[7 * 33]);
        *(v4u*)(WT + (size_t)(n0 + nn) * K + k0 + 8 * c) = o; }
    LDS_WAIT(); asm volatile("" ::: "memory");
}
struct ConvSrc { const float *w_in, *w_uq, *w_ukv, *w_out, *w1, *w2, *g_q, *g_kv; };
struct ConvDst { bf16 *win, *wuq, *wukv, *wout, *w1, *w2; };
constexpr int CV_I1 = (DM / 64) * (DFF / 32), CV_I2 = (DFF / 64) * (DM / 32), CV_IOUT = (DM / 64) * (DM / 32), CV_IIN = (DM / 64) * (DINP / 32), CV_IUQ = (512 / 64) * (768 / 32), CV_IUKV = (256 / 64) * (1024 / 32);
constexpr int CV_A_SPLIT = 4352, CV_B_SPLIT = 6400;
__device__ __forceinline__ void conv_load_tab(LAS float* tab, const float* modl, int which  , int tid) {
    __syncthreads();
    for (int i = tid; i < 5 * DM; i += NTHR) { const int bp = i / DM, k = i - bp * DM; tab[i] = modl[(size_t)bp * 12288 + which * DM + k]; }
    __syncthreads();
}
__device__ __forceinline__ void conv_A(const ConvSrc s, const ConvDst d, int l, int lo, int hi, int worker, int nworkers, LAS float* scr, const LAS float* tab, long long* biasl, int lane) {
    for (int it = lo + worker; it < hi; it += nworkers) transpose_item(s.w1 + (size_t)l * DM * DFF, DM, DFF, DFF, d.w1, scr, it, lane, tab, biasl + DINP, BIASW);
}
__device__ __forceinline__ void conv_B(const ConvSrc s, const ConvDst d, int l, int lo, int hi, int worker, int nworkers, LAS float* scr, int lane) {
    for (int it = lo + worker; it < hi; it += nworkers) transpose_item(s.w2 + (size_t)l * DFF * DM, DFF, DM, DM, d.w2, scr, it, lane, nullptr, nullptr, 0);
}
__device__ __forceinline__ void conv_CD(const ConvSrc s, const ConvDst d, int l, int worker, int nworkers, LAS float* scr, const LAS float* tab, long long* biasl, int lane) {
    for (int it = worker; it < CV_IOUT + CV_IIN + CV_IUQ + CV_IUKV; it += nworkers) {
        int r = it;
        if (r < CV_IIN) { transpose_item(s.w_in + (size_t)l * DM * DIN, DM, DIN, DINP, d.win, scr, r, lane, tab, biasl, BIASW); continue; } r -= CV_IIN;
        if (r < CV_IOUT) { transpose_item(s.w_out + (size_t)l * DM * DM, DM, DM, DM, d.wout, scr, r, lane, nullptr, nullptr, 0); continue; } r -= CV_IOUT;
        if (r < CV_IUQ) { transpose_item(s.w_uq + (size_t)l * 512 * 768, 512, 768, 768, d.wuq, scr, r, lane, nullptr, nullptr, 0, s.g_q + l * 512); continue; } r -= CV_IUQ;
        transpose_item(s.w_ukv + (size_t)l * 256 * 1024, 256, 1024, 1024, d.wukv, scr, r, lane, nullptr, nullptr, 0, s.g_kv + l * 256);
    }
}

__device__ __forceinline__ void phase_first(const float* xin, const float* ctxin, bf16* X, bf16* HX, unsigned long long* rowss, const float* g, const float* modl, int gw, int NGW, int lane) {
    const int rs = (int)(((long long)MTOK * gw) / NGW), re = (int)(((long long)MTOK * (gw + 1)) / NGW);
    f32x4 gm[4][2], cur[4][2], nxt[4][2]; int bpc = -1;
#define PF_LOAD(dst, r_) do { const int b_ = (r_) / TB, p_ = (r_) - b_ * TB; const float* s_ = (p_ < CTX ? ctxin + (size_t)(b_ * CTX + p_) * DM : xin + (size_t)(b_ * SEQ + p_ - CTX) * DM) + 8 * lane; \
        _Pragma("unroll") for (int j = 0; j < 4; ++j) { dst[j][0] = *(const f32x4*)(s_ + 512 * j); dst[j][1] = *(const f32x4*)(s_ + 512 * j + 4); } } while (0)
    if (rs < re) PF_LOAD(cur, rs);
    for (int r = rs; r < re; ++r) {
        if (r + 1 < re) PF_LOAD(nxt, r + 1);
        const int b = r / TB, p = r - b * TB, bp = p < CTX ? 4 : b;
        if (bp != bpc) { bpc = bp; const float* gp = g + 8 * lane; const float* scp = modl + (size_t)bp * 12288 + DM + 8 * lane;
#pragma unroll
            for (int j = 0; j < 4; ++j)
#pragma unroll
                for (int h = 0; h < 2; ++h) gm[j][h] = *(const f32x4*)(gp + 512 * j + 4 * h) * (*(const f32x4*)(scp + 512 * j + 4 * h) + 1.f); }
        float ss = 0.f;
#pragma unroll
        for (int j = 0; j < 4; ++j)
#pragma unroll
            for (int h = 0; h < 2; ++h) { const f32x4 v = cur[j][h]; ss += (v.x * v.x + v.y * v.y) + (v.z * v.z + v.w * v.w); }
        ss = wave_sum(ss); if (lane == 0) rowss[r] = (unsigned long long)(ss * 16777216.f);
        bf16* xo = X + (size_t)r * DM + 8 * lane; bf16* ho = HX + (size_t)r * DM + 8 * lane;
#pragma unroll
        for (int j = 0; j < 4; ++j) { const f32x4 v0 = cur[j][0], v1 = cur[j][1], h0 = v0 * gm[j][0], h1 = v1 * gm[j][1];
            *(v4u*)(xo + 512 * j) = (v4u){pk2(v0.x, v0.y), pk2(v0.z, v0.w), pk2(v1.x, v1.y), pk2(v1.z, v1.w)};
            *(v4u*)(ho + 512 * j) = (v4u){pk2(h0.x, h0.y), pk2(h0.z, h0.w), pk2(h1.x, h1.y), pk2(h1.z, h1.w)}; }
#pragma unroll
        for (int j = 0; j < 4; ++j) { cur[j][0] = nxt[j][0]; cur[j][1] = nxt[j][1]; }
    }
#undef PF_LOAD
}
__device__ __forceinline__ void phase_ctxfix(bf16* X, bf16* HX, unsigned long long* rowss, const float* slab, const float* fixgate, const float* g, const float* nsc, int gw, int NGW, int lane) {
    for (int it = gw; it < NB * CTX * 4; it += NGW) {
        const int cr = it >> 2, col = 512 * (it & 3) + 8 * lane;
        const int b = cr / CTX, p = cr - b * CTX; const size_t r = (size_t)b * TB + p;
        const float* sp = slab + (size_t)cr * DM + col;
        f32x4 a0 = *(const f32x4*)sp, a1 = *(const f32x4*)(sp + 4);
#pragma unroll
        for (int s2 = 1; s2 < 8; ++s2) { a0 = a0 + *(const f32x4*)(sp + (size_t)s2 * 1024 * DM); a1 = a1 + *(const f32x4*)(sp + (size_t)s2 * 1024 * DM + 4); }
        const v4u xw = *(const v4u*)(X + r * DM + col);
        const f32x4 x0 = {__uint_as_float(xw.x << 16), __uint_as_float(xw.x & 0xffff0000u), __uint_as_float(xw.y << 16), __uint_as_float(xw.y & 0xffff0000u)};
        const f32x4 x1 = {__uint_as_float(xw.z << 16), __uint_as_float(xw.z & 0xffff0000u), __uint_as_float(xw.w << 16), __uint_as_float(xw.w & 0xffff0000u)};
        const f32x4 v0 = x0 + *(const f32x4*)(fixgate + col) * a0, v1 = x1 + *(const f32x4*)(fixgate + col + 4) * a1;
        float ss = ((v0.x * v0.x + v0.y * v0.y) + (v0.z * v0.z + v0.w * v0.w)) + ((v1.x * v1.x + v1.y * v1.y) + (v1.z * v1.z + v1.w * v1.w));
        ss = wave_sum(ss); if (lane == 0) atomicAdd(rowss + r, (unsigned long long)(ss * 16777216.f));
        *(v4u*)(X + r * DM + col) = (v4u){pk2(v0.x, v0.y), pk2(v0.z, v0.w), pk2(v1.x, v1.y), pk2(v1.z, v1.w)};
        const f32x4 h0 = v0 * (*(const f32x4*)(g + col) * (*(const f32x4*)(nsc + col) + 1.f)), h1 = v1 * (*(const f32x4*)(g + col + 4) * (*(const f32x4*)(nsc + col + 4) + 1.f));
        *(v4u*)(HX + r * DM + col) = (v4u){pk2(h0.x, h0.y), pk2(h0.z, h0.w), pk2(h1.x, h1.y), pk2(h1.z, h1.w)};
    }
}
__device__ __forceinline__ void phase_final(const bf16* X, float* out, const float* g, int gw, int NGW, int lane) {
    const int qs = (int)(((long long)NB * SEQ * gw) / NGW), qe = (int)(((long long)NB * SEQ * (gw + 1)) / NGW);
    f32x4 gg[4][2]; v4u cur[4], nxt[4];
#pragma unroll
    for (int j = 0; j < 4; ++j) { gg[j][0] = *(const f32x4*)(g + 512 * j + 8 * lane); gg[j][1] = *(const f32x4*)(g + 512 * j + 8 * lane + 4); }
#define FN_LOAD(dst, q_) do { const int b_ = (q_) / SEQ; const bf16* s_ = X + ((size_t)b_ * TB + CTX + ((q_) - b_ * SEQ)) * DM + 8 * lane; \
        _Pragma("unroll") for (int j = 0; j < 4; ++j) dst[j] = *(const v4u*)(s_ + 512 * j); } while (0)
    if (qs < qe) FN_LOAD(cur, qs);
    for (int q = qs; q < qe; ++q) {
        if (q + 1 < qe) FN_LOAD(nxt, q + 1);
        f32x4 v[4][2]; float ss = 0.f;
#pragma unroll
        for (int j = 0; j < 4; ++j) { const v4u w = cur[j];
            v[j][0] = (f32x4){__uint_as_float(w.x << 16), __uint_as_float(w.x & 0xffff0000u), __uint_as_float(w.y << 16), __uint_as_float(w.y & 0xffff0000u)};
            v[j][1] = (f32x4){__uint_as_float(w.z << 16), __uint_as_float(w.z & 0xffff0000u), __uint_as_float(w.w << 16), __uint_as_float(w.w & 0xffff0000u)};
#pragma unroll
            for (int h = 0; h < 2; ++h) ss += (v[j][h].x * v[j][h].x + v[j][h].y * v[j][h].y) + (v[j][h].z * v[j][h].z + v[j][h].w * v[j][h].w); }
        const float rstd = rsqrtf(wave_sum(ss) * (1.f / DM) + NORM_EPS);
        float* o = out + (size_t)q * DM + 8 * lane;
#pragma unroll
        for (int j = 0; j < 4; ++j)
#pragma unroll
            for (int h = 0; h < 2; ++h) *(f32x4*)(o + 512 * j + 4 * h) = v[j][h] * rstd * gg[j][h];
#pragma unroll
        for (int j = 0; j < 4; ++j) cur[j] = nxt[j];
    }
#undef FN_LOAD
}

__device__ __forceinline__ void rope4(const bf16* src, bf16* dst, int i0, const float (&cr)[4], const float (&sr)[4], const float (&cc)[4], const float (&sc)[4]) {
    const v2u r1 = *(const v2u*)(src + i0), r2 = *(const v2u*)(src + 16 + i0), r3 = *(const v2u*)(src + 32 + i0), r4 = *(const v2u*)(src + 48 + i0);
    float x1[4] = {bf2f(r1.x & 0xffffu), bf2f(r1.x >> 16), bf2f(r1.y & 0xffffu), bf2f(r1.y >> 16)};
    float x2[4] = {bf2f(r2.x & 0xffffu), bf2f(r2.x >> 16), bf2f(r2.y & 0xffffu), bf2f(r2.y >> 16)};
    float x3[4] = {bf2f(r3.x & 0xffffu), bf2f(r3.x >> 16), bf2f(r3.y & 0xffffu), bf2f(r3.y >> 16)};
    float x4[4] = {bf2f(r4.x & 0xffffu), bf2f(r4.x >> 16), bf2f(r4.y & 0xffffu), bf2f(r4.y >> 16)};
    float o1[4], o2[4], o3[4], o4[4];
#pragma unroll
    for (int e = 0; e < 4; ++e) { o1[e] = x1[e] * cr[e] - x2[e] * sr[e]; o2[e] = x2[e] * cr[e] + x1[e] * sr[e]; o3[e] = x3[e] * cc[e] - x4[e] * sc[e]; o4[e] = x4[e] * cc[e] + x3[e] * sc[e]; }
    *(v2u*)(dst + i0) = (v2u){pk2(o1[0], o1[1]), pk2(o1[2], o1[3])}; *(v2u*)(dst + 16 + i0) = (v2u){pk2(o2[0], o2[1]), pk2(o2[2], o2[3])};
    *(v2u*)(dst + 32 + i0) = (v2u){pk2(o3[0], o3[1]), pk2(o3[2], o3[3])}; *(v2u*)(dst + 48 + i0) = (v2u){pk2(o4[0], o4[1]), pk2(o4[2], o4[3])};
}
__device__ __forceinline__ void phase_e1(bf16* Z, bf16* KR, int wg, int G, int wave, int lane, bool do_rope = true) {
    const int n5 = (NB * 4 * NSTEP / 2) % G, tot5 = 4 * n5 + 5 * (G - n5);
    const int c0 = wg < n5 ? 4 * wg : 4 * n5 + 5 * (wg - n5), c1 = wg + 1 < n5 ? 4 * (wg + 1) : 4 * n5 + 5 * (wg + 1 - n5);
    const int rs = (int)(((long long)MTOK * c0) / tot5), re = (int)(((long long)MTOK * c1) / tot5);
    const int j8 = lane & 7;
    v4u cur[3], nxt[3];
#define E1_LOAD(dst, r_) do { const bf16* z_ = Z + (size_t)(r_) * DINP + ZR + 8 * lane; dst[0] = *(const v4u*)z_; dst[1] = *(const v4u*)(z_ + 512); dst[2] = *(const v4u*)(z_ + (lane < 24 ? 1024 : 0)); } while (0)
    if (rs + wave < re) E1_LOAD(cur, rs + wave);
    for (int r = rs + wave; r < re; r += NWAVES) {
        if (r + NWAVES < re) E1_LOAD(nxt, r + NWAVES);
        const int b = r / TB, t = r - b * TB - CTX; const bool latent = t >= 0 && do_rope;
        bf16* z = Z + (size_t)r * DINP + ZR + 8 * lane; bf16* d0 = lane < 8 ? KR + (size_t)r * 64 + 8 * lane : z;
        if (latent) {
            const int pos = j8 < 4 ? (t >> 6) : (t & 63);
            float c[8], sg[8];
#pragma unroll
            for (int e = 0; e < 8; ++e) { float s_; rope_cs(pos, 8 * (j8 & 1) + e, c[e], s_); sg[e] = (j8 & 2) ? s_ : -s_; }
#pragma unroll
            for (int ps = 0; ps < 3; ++ps) { v4u o;
#pragma unroll
                for (int d = 0; d < 4; ++d) { const unsigned own = cur[ps][d], oth = (unsigned)__builtin_amdgcn_mov_dpp((int)own, 0x4E, 0xf, 0xf, true);
                    o[d] = pk2(bf2f(own & 0xffffu) * c[2 * d] + bf2f(oth & 0xffffu) * sg[2 * d], bf2f(own >> 16) * c[2 * d + 1] + bf2f(oth >> 16) * sg[2 * d + 1]); }
                if (ps == 0) *(v4u*)d0 = o; else if (ps == 1) *(v4u*)(z + 512) = o; else if (lane < 24) *(v4u*)(z + 1024) = o; }
        } else {
            if (lane < 8) *(v4u*)d0 = cur[0];
        }
#pragma unroll
        for (int ps = 0; ps < 3; ++ps) cur[ps] = nxt[ps];
    }
#undef E1_LOAD
}

#define MFMA16(a, b, c) __builtin_amdgcn_mfma_f32_16x16x32_bf16((a), (b), (c), 0, 0, 0)
__device__ __forceinline__ bf16x8 gather8(LAS const unsigned char* base, int stride) {
    bf16x8 r;
#pragma unroll
    for (int j = 0; j < 8; ++j) r[j] = *(LAS const short*)(base + j * stride);
    return r;
}
__device__ __forceinline__ bf16x8 colfrag8(LAS const unsigned char* tile, int row0, int col0, int stride, int lane) {
    typedef short v4i16_ __attribute__((ext_vector_type(4)));
    LAS const unsigned char* p = tile + (row0 + 8 * (lane >> 4) + ((lane & 15) >> 2)) * stride + (col0 + 4 * (lane & 3)) * 2;
    const s16x4 lo = __builtin_bit_cast(s16x4, __builtin_amdgcn_ds_read_tr16_b64_v4i16((LAS v4i16_*)p));
    const s16x4 hi = __builtin_bit_cast(s16x4, __builtin_amdgcn_ds_read_tr16_b64_v4i16((LAS v4i16_*)(p + 4 * stride)));
    return __builtin_shufflevector(lo, hi, 0, 1, 2, 3, 4, 5, 6, 7);
}
__device__ __forceinline__ void chain_step_rows(int dir, int i, int& seg, int& c) { seg = i >= 4; const int ii = seg ? i - 4 : i; c = dir == 0 ? ii : (seg ? 127 - ii : 3 - ii); }
__device__ __forceinline__ float scan_sum(float v, int dir, int lane) {
#pragma unroll
    for (int o = 1; o < 64; o <<= 1) { const float t = dir == 0 ? __shfl_up(v, o) : __shfl_down(v, o); const bool ok = dir == 0 ? (lane >= o) : (lane + o < 64); if (ok) v += t; }
    return v;
}
__device__ __forceinline__ float scan_max(float v, int dir, int lane) {
#pragma unroll
    for (int o = 1; o < 64; o <<= 1) { const float t = dir == 0 ? __shfl_up(v, o) : __shfl_down(v, o); const bool ok = dir == 0 ? (lane >= o) : (lane + o < 64); if (ok) v = fmaxf(v, t); }
    return v;
}

__device__ __forceinline__ void mlstm_a(const bf16* Z, const float* GATES, const float* gbias  , bf16* DC, float* DN, float* SC, LAS unsigned char* L, int wg, int G, int tid) {
    const int wave = tid >> 6, lane = tid & 63, fr = lane & 15, fq = lane >> 4, half = wave >> 2, w4 = wave & 3, t256 = tid & 255;
    LAS unsigned char* kt = L + half * 36864;
    LAS unsigned char* vt = kt + 18432;
    LAS float* wv = (LAS float*)(kt + 35840);
    constexpr int NP = NB * 4 * NSTEP / 2;
    for (int pair = wg; pair < NP; pair += G) {
        const int item = 2 * pair + half;
        const int b = item / (4 * NSTEP), h = (item / NSTEP) & 3, cc0 = item % NSTEP, seg = cc0 >= 4, c = seg ? cc0 - 4 : cc0;
        const int row0 = b * TB + (seg ? CTX : 0) + 64 * c;
        const int step0 = seg ? 4 + c : c, step1 = seg ? 4 + 127 - c : 3 - c;
        if (w4 < 2) {
            const int dir = w4; const size_t sidx = (size_t)((b * 4 + h) * 2 + dir) * NSTEP + (dir == 0 ? step0 : step1);
            const size_t row = (size_t)(row0 + lane);
            const float ip = GATES[row * 16 + (2 * dir) * 4 + h] + gbias[(2 * dir) * 4 + h];
            const float fp = GATES[row * 16 + (2 * dir + 1) * 4 + h] + gbias[(2 * dir + 1) * 4 + h];
            const float bs = scan_sum(logsigf_(fp), dir, lane);
            const float g = __shfl(bs, dir == 0 ? 63 : 0);
            const float a = g - bs + ip, amax = wave_max(a);
            wv[dir * 64 + lane] = expf(a - amax);
            if (lane == 0) { SC[sidx * 4 + 0] = g; SC[sidx * 4 + 1] = amax; }
        }
        v4u kraw[2], vraw[4];
#pragma unroll
        for (int i2 = 0; i2 < 2; ++i2) { const int c2 = t256 + 256 * i2; kraw[i2] = *(const v4u*)(Z + (size_t)(row0 + (c2 >> 3)) * DINP + ZMK + h * 64 + (c2 & 7) * 8); }
#pragma unroll
        for (int i2 = 0; i2 < 4; ++i2) { const int c2 = t256 + 256 * i2; vraw[i2] = *(const v4u*)(Z + (size_t)(row0 + (c2 >> 4)) * DINP + ZMV + h * 128 + (c2 & 15) * 8); }
        __syncthreads();
#pragma unroll
        for (int i2 = 0; i2 < 2; ++i2) { const int c2 = t256 + 256 * i2, krow_ = c2 >> 3, kcc_ = c2 & 7;
#pragma unroll
            for (int dir = 0; dir < 2; ++dir) { const float w = wv[dir * 64 + krow_]; v4u o;
#pragma unroll
                for (int e = 0; e < 4; ++e) o[e] = pk2(bf2f(kraw[i2][e] & 0xffffu) * w, bf2f(kraw[i2][e] >> 16) * w);
                *(LAS v4u*)(kt + dir * 9216 + krow_ * 144 + kcc_ * 16) = o; } }
#pragma unroll
        for (int i2 = 0; i2 < 4; ++i2) { const int c2 = t256 + 256 * i2; *(LAS v4u*)(vt + (c2 >> 4) * 272 + (c2 & 15) * 16) = vraw[i2]; }
        __syncthreads();
        if (w4 < 2) { const int dir = w4; const size_t sidx = (size_t)((b * 4 + h) * 2 + dir) * NSTEP + (dir == 0 ? step0 : step1); float s = 0.f;
#pragma unroll 8
            for (int j = 0; j < 64; ++j) s += bf2f(*(LAS const unsigned short*)(kt + dir * 9216 + j * 144 + lane * 2));
            DN[sidx * 64 + lane] = s; }
        {
            bf16x8 bfr[2][2];
#pragma unroll
            for (int et = 0; et < 2; ++et)
#pragma unroll
                for (int ks = 0; ks < 2; ++ks) bfr[et][ks] = colfrag8(vt, 32 * ks, 16 * (2 * w4 + et), 272, lane);
            const int ecol = 16 * (2 * w4 + (fq & 1)) + 4 * (fq & ~1);
#pragma unroll
            for (int dir = 0; dir < 2; ++dir) {
                bf16* dcp = DC + ((size_t)((b * 4 + h) * 2 + dir) * NSTEP + (dir == 0 ? step0 : step1)) * 8192;
#pragma unroll
                for (int dt = 0; dt < 4; ++dt) { f32x4 acc0 = {0.f, 0.f, 0.f, 0.f}, acc1 = {0.f, 0.f, 0.f, 0.f};
#pragma unroll
                    for (int ks = 0; ks < 2; ++ks) { const bf16x8 af = colfrag8(kt + dir * 9216, 32 * ks, 16 * dt, 144, lane); acc0 = MFMA16(bfr[0][ks], af, acc0); acc1 = MFMA16(bfr[1][ks], af, acc1); }
                    const auto sx = __builtin_amdgcn_permlane16_swap(pk2(acc0[0], acc0[1]), pk2(acc1[0], acc1[1]), false, false);
                    const auto sy = __builtin_amdgcn_permlane16_swap(pk2(acc0[2], acc0[3]), pk2(acc1[2], acc1[3]), false, false);
                    *(v4u*)(dcp + (16 * dt + fr) * 128 + ecol) = (v4u){sx[0], sy[0], sx[1], sy[1]}; } } }
        __syncthreads();
    }
}
__device__ __forceinline__ void mlstm_scan(bf16* DC, float* DN, float* SC, int wg, int G, int tid) {
    for (int unit = wg; unit < 32 * 8; unit += G) {
        const int chain = unit >> 3, slice = unit & 7;
        unsigned* dc = (unsigned*)(DC + (size_t)chain * NSTEP * 8192 + slice * 1024) + tid;
        float* dn = DN + (size_t)chain * NSTEP * 64 + (tid & 63);
        float* sc = SC + (size_t)chain * NSTEP * 4;
        const bool has_n = (slice == 0) && (tid < 64), rec_m = (slice == 0) && (tid == 0);
        float C0 = 0.f, C1 = 0.f, n = 0.f, m = 0.f;
        for (int i = 0; i < NSTEP; i += 12) {
            unsigned v[12]; float nv[12], g[12], am[12];
#pragma unroll
            for (int k = 0; k < 12; ++k) { v[k] = dc[(size_t)(i + k) * 4096]; g[k] = sc[(i + k) * 4]; am[k] = sc[(i + k) * 4 + 1]; nv[k] = has_n ? dn[(i + k) * 64] : 0.f; }
#pragma unroll
            for (int k = 0; k < 12; ++k) {
                const float mn = fmaxf(g[k] + m, am[k]), decay = expf(g[k] + m - mn), grow = expf(am[k] - mn);
                dc[(size_t)(i + k) * 4096] = pk2(C0, C1);
                C0 = decay * C0 + grow * bf2f(v[k] & 0xffffu); C1 = decay * C1 + grow * bf2f(v[k] >> 16);
                if (has_n) { dn[(i + k) * 64] = n; n = decay * n + grow * nv[k]; }
                if (rec_m) sc[(i + k) * 4 + 2] = m;
                m = mn;
            }
        }
    }
}
__device__ __forceinline__ void mlstm_c_phase(int u_first, int G, bool skip_ctx, const bf16* Z, const float* GATES, const float* gbias, const float* gh  , const bf16* DC, const float* DN, const float* SC,
                                              bf16* Y, LAS unsigned char* L, int tid) {
    const int wave = tid >> 6, lane = tid & 63, fr = lane & 15, fq = lane >> 4, dir = wave >> 2, w4 = wave & 3, t256 = tid & 255;
    LAS unsigned char* QS = L;
    LAS unsigned char* KS2 = L + 9216;
    LAS unsigned char* VS2 = L + 18432;
    LAS unsigned char* CS = L + 35840 + dir * 17408;
    LAS unsigned char* SS = L + 70656 + dir * 18432;
    LAS unsigned char* QW = SS + 9216;
    LAS float* HM = (LAS float*)(L + 70656);
    constexpr int HMS = 132;
    LAS float* VEC = (LAS float*)(L + 107520 + dir * 2048);
    LAS float* bq = VEC, *uu = VEC + 64, *iwv = VEC + 128, *emt = VEC + 192, *den = VEC + 256, *nin = VEC + 320;
    constexpr int NU = NB * 4 * NSTEP;
    v4u pq, pk, pv[2], pc[4]; float pig = 0.f, pfp = 0.f, pmin = 0.f, pnin = 0.f;
#define MC_DECODE(U) const int b = (U) / (4 * NSTEP), h = ((U) / NSTEP) & 3, cc0 = (U) % NSTEP, seg = cc0 >= 4, c = seg ? cc0 - 4 : cc0; \
    const int row0 = b * TB + (seg ? CTX : 0) + 64 * c; const int chain = (b * 4 + h) * 2 + dir; \
    const int step = dir == 0 ? (seg ? 4 + c : c) : (seg ? 4 + 127 - c : 3 - c); const size_t sidx = (size_t)chain * NSTEP + step
#define MC_NEXT(U) do { (U) += G; while (skip_ctx && (U) < NU && ((U) % NSTEP) < 4) (U) += G; } while (0)
#define MC_LOAD_A(U) do { MC_DECODE(U); (void)chain; (void)step; { const int row = tid >> 3, ch = tid & 7; const bf16* zr = Z + (size_t)(row0 + row) * DINP + h * 64 + ch * 8; pq = *(const v4u*)(zr + ZMQ); pk = *(const v4u*)(zr + ZMK); } \
        if (w4 == 0) { const size_t row = (size_t)(row0 + lane); pig = GATES[row * 16 + (2 * dir) * 4 + h] + gbias[(2 * dir) * 4 + h]; pfp = GATES[row * 16 + (2 * dir + 1) * 4 + h] + gbias[(2 * dir + 1) * 4 + h]; \
                       pmin = SC[sidx * 4 + 2]; pnin = DN[sidx * 64 + lane]; } } while (0)
#define MC_LOAD_C(U) do { MC_DECODE(U); (void)chain; (void)step; const bf16* cin = DC + sidx * 8192; \
        _Pragma("unroll") for (int i2 = 0; i2 < 2; ++i2) { const int c2 = tid + NTHR * i2; pv[i2] = *(const v4u*)(Z + (size_t)(row0 + (c2 >> 4)) * DINP + ZMV + h * 128 + (c2 & 15) * 8); } \
        _Pragma("unroll") for (int k = 0; k < 4; ++k) { const int c2 = t256 + 256 * k; pc[k] = *(const v4u*)(cin + (c2 >> 4) * 128 + (c2 & 15) * 8); } } while (0)
    int unit = u_first; while (skip_ctx && unit < NU && (unit % NSTEP) < 4) unit += G;
    if (unit < NU) { MC_LOAD_A(unit); MC_LOAD_C(unit); }
    for (; unit < NU; ) {
    int tl_ = tid; asm volatile("" : "+v"(tl_));
    const int wave = tl_ >> 6, lane = tl_ & 63, fr = lane & 15, fq = lane >> 4, dir = wave >> 2, w4 = wave & 3, t256 = tl_ & 255; const int tid = tl_;
    LAS unsigned char* CS = L + 35840 + dir * 17408; LAS unsigned char* SS = L + 70656 + dir * 18432; LAS unsigned char* QW = SS + 9216;
    LAS float* VEC = (LAS float*)(L + 107520 + dir * 2048); LAS float* bq = VEC, *uu = VEC + 64, *iwv = VEC + 128, *emt = VEC + 192, *den = VEC + 256, *nin = VEC + 320;
    MC_DECODE(unit); (void)chain; (void)step; (void)sidx;
    { const int row = tid >> 3, ch = tid & 7; v4u o;
#pragma unroll
      for (int e = 0; e < 4; ++e) o[e] = pk2(bf2f(pq[e] & 0xffffu) * 0.125f, bf2f(pq[e] >> 16) * 0.125f);
      *(LAS v4u*)(QS + row * 144 + ch * 16) = o;
      *(LAS v4u*)(KS2 + row * 144 + ch * 16) = pk; }
#pragma unroll
    for (int i2 = 0; i2 < 2; ++i2) { const int c2 = tid + NTHR * i2; *(LAS v4u*)(VS2 + (c2 >> 4) * 272 + (c2 & 15) * 16) = pv[i2]; }
#pragma unroll
    for (int k = 0; k < 4; ++k) { const int c2 = t256 + 256 * k; *(LAS v4u*)(CS + (c2 >> 4) * 272 + (c2 & 15) * 16) = pc[k]; }
    if (w4 == 0) {
        const float bs = scan_sum(logsigf_(pfp), dir, lane);
        const float u = pig - bs, pm = scan_max(u, dir, lane), m_in = pmin;
        const float mt = bs + fmaxf(m_in, pm);
        bq[lane] = bs - mt; uu[lane] = u; iwv[lane] = fexp(bs + m_in - mt); emt[lane] = fexp(-mt); nin[lane] = pnin;
    }
    __syncthreads();
    int unext = unit; MC_NEXT(unext);
    if (unext < NU) MC_LOAD_A(unext);
    v4u zo[2]; f32x4 ghv[2];
    { const int c8 = 8 * (lane & 15); const bf16* zp = Z + (size_t)(row0 + 8 * wave + (lane >> 4)) * DINP + ZMO + h * 128 + c8;
      zo[0] = *(const v4u*)zp; zo[1] = *(const v4u*)(zp + (size_t)4 * DINP); ghv[0] = *(const f32x4*)(gh + h * 128 + c8); ghv[1] = *(const f32x4*)(gh + h * 128 + c8 + 4); }
#pragma unroll
    for (int k = 0; k < 2; ++k) { const int c2 = t256 + 256 * k, row = c2 >> 3, ch = c2 & 7; const v4u rq = *(LAS const v4u*)(QS + row * 144 + ch * 16); const float w = iwv[row]; v4u o;
#pragma unroll
        for (int e = 0; e < 4; ++e) o[e] = pk2(bf2f(rq[e] & 0xffffu) * w, bf2f(rq[e] >> 16) * w);
        *(LAS v4u*)(QW + row * 144 + ch * 16) = o; }
    {
      const int lrow = 16 * w4 + fr; const float bql = bq[lrow]; float rsum = 0.f;
      bf16x8 qf[2];
#pragma unroll
      for (int ks = 0; ks < 2; ++ks) qf[ks] = *(LAS const bf16x8*)(QS + lrow * 144 + (32 * ks + 8 * fq) * 2);
#pragma unroll
      for (int st = 0; st < 4; ++st) { f32x4 acc = {0.f, 0.f, 0.f, 0.f};
#pragma unroll
          for (int ks = 0; ks < 2; ++ks) { const bf16x8 kf = *(LAS const bf16x8*)(KS2 + (16 * st + fr) * 144 + (32 * ks + 8 * fq) * 2); acc = MFMA16(kf, qf[ks], acc); }
          const f32x4 us4 = *(LAS const f32x4*)(uu + 16 * st + 4 * fq); float val[4];
#pragma unroll
          for (int rg = 0; rg < 4; ++rg) { const int scol = 16 * st + 4 * fq + rg; const bool valid = dir == 0 ? (scol <= lrow) : (scol >= lrow);
              val[rg] = valid ? acc[rg] * fexp(bql + us4[rg]) : 0.f; rsum += val[rg]; }
          *(LAS v2u*)(SS + lrow * 144 + (16 * st + 4 * fq) * 2) = (v2u){pk2(val[0], val[1]), pk2(val[2], val[3])}; }
      float dq = 0.f;
#pragma unroll
      for (int k2 = 0; k2 < 2; ++k2) { const v4u rq = *(LAS const v4u*)(QS + lrow * 144 + (16 * fq + 8 * k2) * 2); const f32x4 n0 = *(LAS const f32x4*)(nin + 16 * fq + 8 * k2), n1 = *(LAS const f32x4*)(nin + 16 * fq + 8 * k2 + 4);
          dq += (bf2f(rq.x & 0xffffu) * n0.x + bf2f(rq.x >> 16) * n0.y) + (bf2f(rq.y & 0xffffu) * n0.z + bf2f(rq.y >> 16) * n0.w) + (bf2f(rq.z & 0xffffu) * n1.x + bf2f(rq.z >> 16) * n1.y) + (bf2f(rq.w & 0xffffu) * n1.z + bf2f(rq.w >> 16) * n1.w); }
      float rs = rsum + iwv[lrow] * dq;
      { const auto r1 = __builtin_amdgcn_permlane16_swap(__float_as_uint(rs), __float_as_uint(rs), false, false); rs = __uint_as_float(r1[0]) + __uint_as_float(r1[1]);
        const auto r2 = __builtin_amdgcn_permlane32_swap(__float_as_uint(rs), __float_as_uint(rs), false, false); rs = __uint_as_float(r2[0]) + __uint_as_float(r2[1]); }
      if (fq == 0) den[lrow] = rs; }
    __syncthreads();
    f32x4 acc[2][4];
#pragma unroll
    for (int et = 0; et < 2; ++et) { bf16x8 bv[2], bc[2];
#pragma unroll
        for (int ks = 0; ks < 2; ++ks) { bv[ks] = colfrag8(VS2, 32 * ks, 16 * (2 * w4 + et), 272, lane); bc[ks] = colfrag8(CS, 32 * ks, 16 * (2 * w4 + et), 272, lane); }
#pragma unroll
        for (int lt = 0; lt < 4; ++lt) { acc[et][lt] = (f32x4){0.f, 0.f, 0.f, 0.f};
#pragma unroll
            for (int ks = 0; ks < 2; ++ks) { const bf16x8 a1 = *(LAS const bf16x8*)(SS + (16 * lt + fr) * 144 + (32 * ks + 8 * fq) * 2); acc[et][lt] = MFMA16(bv[ks], a1, acc[et][lt]); }
#pragma unroll
            for (int ks = 0; ks < 2; ++ks) { const bf16x8 a2 = *(LAS const bf16x8*)(QW + (16 * lt + fr) * 144 + (32 * ks + 8 * fq) * 2); acc[et][lt] = MFMA16(bc[ks], a2, acc[et][lt]); } } }
#pragma unroll
    for (int lt = 0; lt < 4; ++lt) { const int lrow = 16 * lt + fr; const float inv = __builtin_amdgcn_rcpf(fmaxf(fabsf(den[lrow]), emt[lrow]));
#pragma unroll
        for (int et = 0; et < 2; ++et) acc[et][lt] = acc[et][lt] * inv; }
    __syncthreads();
    if (dir == 1) {
#pragma unroll
        for (int et = 0; et < 2; ++et)
#pragma unroll
            for (int lt = 0; lt < 4; ++lt) *(LAS f32x4*)(HM + (16 * lt + fr) * HMS + 16 * (2 * w4 + et) + 4 * fq) = acc[et][lt];
    }
    __syncthreads();
    if (dir == 0) {
#pragma unroll
        for (int et = 0; et < 2; ++et)
#pragma unroll
            for (int lt = 0; lt < 4; ++lt) { LAS f32x4* hp = (LAS f32x4*)(HM + (16 * lt + fr) * HMS + 16 * (2 * w4 + et) + 4 * fq); *hp = *hp + acc[et][lt]; }
    }
    __syncthreads();
    if (unext < NU) MC_LOAD_C(unext);
#pragma unroll
    for (int ps = 0; ps < 2; ++ps) { const int lrow = 8 * wave + 4 * ps + (lane >> 4), c8 = 8 * (lane & 15);
        const f32x4 va = *(LAS const f32x4*)(HM + lrow * HMS + c8), vb = *(LAS const f32x4*)(HM + lrow * HMS + c8 + 4);
        const float rstd = rsqrtf(row16_sum((va.x * va.x + va.y * va.y) + (va.z * va.z + va.w * va.w) + (vb.x * vb.x + vb.y * vb.y) + (vb.z * vb.z + vb.w * vb.w)) * (1.f / 128.f) + NORM_EPS);
        const v4u z = zo[ps]; const f32x4 ga = ghv[0] * rstd, gb = ghv[1] * rstd;
        v4u o; o.x = pk2(va.x * ga.x * sigmoid_fast(bf2f(z.x & 0xffffu)), va.y * ga.y * sigmoid_fast(bf2f(z.x >> 16))); o.y = pk2(va.z * ga.z * sigmoid_fast(bf2f(z.y & 0xffffu)), va.w * ga.w * sigmoid_fast(bf2f(z.y >> 16)));
        o.z = pk2(vb.x * gb.x * sigmoid_fast(bf2f(z.z & 0xffffu)), vb.y * gb.y * sigmoid_fast(bf2f(z.z >> 16))); o.w = pk2(vb.z * gb.z * sigmoid_fast(bf2f(z.w & 0xffffu)), vb.w * gb.w * sigmoid_fast(bf2f(z.w >> 16)));
        *(v4u*)(Y + (size_t)(row0 + lrow) * DM + 1536 + h * 128 + c8) = o; }
    unit = unext;
    }
#undef MC_DECODE
#undef MC_NEXT
#undef MC_LOAD_A
#undef MC_LOAD_C
}

#define MFMA32(a, b, c) __builtin_amdgcn_mfma_f32_32x32x16_bf16((a), (b), (c), 0, 0, 0)
typedef short v4i16_t __attribute__((ext_vector_type(4)));
__device__ __forceinline__ s16x4 tr_read(LAS const unsigned char* p) { return __builtin_bit_cast(s16x4, __builtin_amdgcn_ds_read_tr16_b64_v4i16((LAS v4i16_t*)p)); }
constexpr float ATT_THR = 8.f;
#define SCHED_FENCE() __builtin_amdgcn_sched_barrier(0)
constexpr int NO_MASK = 0x40000000;
template <int DQK, int KSB>
__device__ __forceinline__ void attn_scores(LAS const unsigned char* Kt, const bf16x8 (&qf)[DQK / 16], f32x16 (&p)[2], int r32, int hi) {
    constexpr int NK = DQK / 16;
    LAS const unsigned char* kp = Kt + r32 * KSB + hi * 16;
    f32x16 p0, p1;
#pragma unroll
    for (int e = 0; e < 16; ++e) { p0[e] = 0.f; p1[e] = 0.f; }
    bf16x8 kr[3][2];
#define QK_LOAD(ks) do { kr[(ks) % 3][0] = *(LAS const bf16x8*)(kp + (ks) * 32); kr[(ks) % 3][1] = *(LAS const bf16x8*)(kp + 32 * KSB + (ks) * 32); } while (0)
    QK_LOAD(0); QK_LOAD(1); SCHED_FENCE();
#pragma unroll
    for (int ks = 0; ks < NK; ++ks) {
        if (ks + 2 < NK) QK_LOAD(ks + 2);
        p0 = MFMA32(kr[ks % 3][0], qf[ks], p0); p1 = MFMA32(kr[ks % 3][1], qf[ks], p1); SCHED_FENCE();
    }
#undef QK_LOAD
    p[0] = p0; p[1] = p1;
}
template <int DV, bool MASK>
__device__ __forceinline__ void attn_softmax(f32x16 (&p)[2], f32x16 (&o)[DV / 32], float& m, float& l, float cs, int hi, int dq) {
    if (MASK) { if (__builtin_amdgcn_readfirstlane(dq) != NO_MASK) {
#pragma unroll
        for (int kvb = 0; kvb < 2; ++kvb)
#pragma unroll
            for (int e = 0; e < 16; ++e) { const int rel = dq + 32 * kvb + (e & 3) + 8 * (e >> 2) + 4 * hi; if (rel > 128 || rel < -128) p[kvb][e] = -INFINITY; } } }
    float mx;
    {
        float a0 = fmaxf(fmaxf(p[0][0], p[0][1]), p[0][2]), a1 = fmaxf(fmaxf(p[0][8], p[0][9]), p[0][10]), a2 = fmaxf(fmaxf(p[1][0], p[1][1]), p[1][2]), a3 = fmaxf(fmaxf(p[1][8], p[1][9]), p[1][10]);
        a0 = fmaxf(fmaxf(a0, p[0][3]), p[0][4]); a1 = fmaxf(fmaxf(a1, p[0][11]), p[0][12]); a2 = fmaxf(fmaxf(a2, p[1][3]), p[1][4]); a3 = fmaxf(fmaxf(a3, p[1][11]), p[1][12]);
        a0 = fmaxf(fmaxf(a0, p[0][5]), p[0][6]); a1 = fmaxf(fmaxf(a1, p[0][13]), p[0][14]); a2 = fmaxf(fmaxf(a2, p[1][5]), p[1][6]); a3 = fmaxf(fmaxf(a3, p[1][13]), p[1][14]);
        a0 = fmaxf(a0, p[0][7]); a1 = fmaxf(a1, p[0][15]); a2 = fmaxf(a2, p[1][7]); a3 = fmaxf(a3, p[1][15]);
        mx = fmaxf(fmaxf(a0, a1), fmaxf(a2, a3));
        const auto rr = __builtin_amdgcn_permlane32_swap(__float_as_uint(mx), __float_as_uint(mx), false, false);
        mx = fmaxf(__uint_as_float(rr[0]), __uint_as_float(rr[1])); }
    const float mn = fmaxf(m, mx * cs);
    if (__any(mn - m > ATT_THR)) {
        const float alpha = fexp2(m - mn); m = mn; l *= alpha;
#pragma unroll
        for (int d = 0; d < DV / 32; ++d)
#pragma unroll
            for (int e = 0; e < 16; ++e) o[d][e] *= alpha;
    }
    float ls0 = 0.f, ls1 = 0.f, ls2 = 0.f, ls3 = 0.f;
#pragma unroll
    for (int kvb = 0; kvb < 2; ++kvb)
#pragma unroll
        for (int e = 0; e < 16; e += 4) {
            const float e0 = fexp2(fmaf(p[kvb][e], cs, -m)), e1 = fexp2(fmaf(p[kvb][e + 1], cs, -m)), e2 = fexp2(fmaf(p[kvb][e + 2], cs, -m)), e3 = fexp2(fmaf(p[kvb][e + 3], cs, -m));
            p[kvb][e] = e0; p[kvb][e + 1] = e1; p[kvb][e + 2] = e2; p[kvb][e + 3] = e3; ls0 += e0; ls1 += e1; ls2 += e2; ls3 += e3; }
    l += (ls0 + ls1) + (ls2 + ls3);
}
template <int DV, int VRB>
__device__ __forceinline__ void attn_pv(LAS const unsigned char* Vt, const f32x16 (&p)[2], f32x16 (&o)[DV / 32], int vtb) {
    constexpr int ND = DV / 32;
    LAS const unsigned char* vb = Vt + vtb;
    bf16x8 pf[4];
#pragma unroll
    for (int i = 0; i < 4; ++i) { const int kvb = i >> 1, s = i & 1;
        v4u pw; pw.x = pk2(p[kvb][8 * s + 0], p[kvb][8 * s + 1]); pw.y = pk2(p[kvb][8 * s + 2], p[kvb][8 * s + 3]); pw.z = pk2(p[kvb][8 * s + 4], p[kvb][8 * s + 5]); pw.w = pk2(p[kvb][8 * s + 6], p[kvb][8 * s + 7]);
        pf[i] = __builtin_bit_cast(bf16x8, pw); }
    s16x4 va[2 * ND], vbq[2 * ND];
#define PV_LOAD(dst, i) do { _Pragma("unroll") for (int d = 0; d < ND; ++d) { LAS const unsigned char* vp = vb + (16 * (i)) * VRB + d * 64; dst[2 * d] = tr_read(vp); dst[2 * d + 1] = tr_read(vp + 8 * VRB); } } while (0)
#define PV_MMA(src, i) do { _Pragma("unroll") for (int d = 0; d < ND; ++d) { const bf16x8 vf = __builtin_shufflevector(src[2 * d], src[2 * d + 1], 0, 1, 2, 3, 4, 5, 6, 7); o[d] = MFMA32(vf, pf[i], o[d]); } } while (0)
    PV_LOAD(va, 0); SCHED_FENCE();
    PV_LOAD(vbq, 1); PV_MMA(va, 0); SCHED_FENCE();
    PV_LOAD(va, 2); PV_MMA(vbq, 1); SCHED_FENCE();
    PV_LOAD(vbq, 3); PV_MMA(va, 2); SCHED_FENCE();
    PV_MMA(vbq, 3); SCHED_FENCE();
#undef PV_LOAD
#undef PV_MMA
}
template <int DQK, int DV, int KSB, int VRB, bool MASK>
__device__ __forceinline__ void attn_tile(LAS const unsigned char* Kt, LAS const unsigned char* Vt, const bf16x8 (&qf)[DQK / 16], f32x16 (&o)[DV / 32], float& m, float& l, float cs, int r32, int hi, int vtb, int dq) {
    __builtin_amdgcn_sched_barrier(0);
    f32x16 p[2];
    attn_scores<DQK, KSB>(Kt, qf, p, r32, hi);
    attn_softmax<DV, MASK>(p, o, m, l, cs, hi, dq);
    attn_pv<DV, VRB>(Vt, p, o, vtb);
}
template <int DV>
__device__ __forceinline__ void attn_store(bf16* yrow  , const f32x16 (&o)[DV / 32], float l, int hi) {
    const float lt = l + __shfl_xor(l, 32), inv = 1.f / lt;
    unsigned char* yb = (unsigned char*)yrow + 16 * hi;
#pragma unroll
    for (int d = 0; d < DV / 32; ++d)
#pragma unroll
        for (int kk = 0; kk < 2; ++kk) {
            unsigned ax = pk2(o[d][8 * kk] * inv, o[d][8 * kk + 1] * inv), ay = pk2(o[d][8 * kk + 2] * inv, o[d][8 * kk + 3] * inv);
            unsigned bx = pk2(o[d][8 * kk + 4] * inv, o[d][8 * kk + 5] * inv), by = pk2(o[d][8 * kk + 6] * inv, o[d][8 * kk + 7] * inv);
            const auto rx = __builtin_amdgcn_permlane32_swap(ax, bx, false, false); const auto ry = __builtin_amdgcn_permlane32_swap(ay, by, false, false);
            *(v4u*)(yb + 64 * d + 32 * kk) = (v4u){rx[0], ry[0], rx[1], ry[1]};
        }
}
constexpr int MLA_KSB = 400, MLA_KT = 64 * MLA_KSB  , MLA_VRB = 320, MLA_VT = 64 * MLA_VRB  , MLA_BUF = MLA_KT + MLA_VT;
__device__ __forceinline__ void mla_unit(const bf16* QM, const bf16* KVM, const bf16* KR, bf16* Y, int b, int h, int qrow0, int ntiles, bool latent, LAS unsigned char* L, int tid_in) {
    int tid = tid_in; asm volatile("" : "+v"(tid));
    const int wave = tid >> 6, lane = tid & 63, r32 = lane & 31, hi = lane >> 5;
    const int qrow = qrow0 + 32 * wave + r32;
    bf16x8 qf[12];
    { const bf16* qp = QM + (size_t)qrow * 768 + h * 192 + 8 * hi;
#pragma unroll
      for (int ks = 0; ks < 12; ++ks) qf[ks] = *(const bf16x8*)(qp + 16 * ks); }
    if (latent) {
        const int t = qrow - b * TB - CTX, prow = t >> 6, pcol = t & 63;
        int hl = hi; asm volatile("" : "+v"(hl));
#pragma unroll
        for (int j = 0; j < 8; ++j) { float cr, sr, cc, sc; rope_cs(prow, 8 * hl + j, cr, sr); rope_cs(pcol, 8 * hl + j, cc, sc);
            const float x1 = bf2f((unsigned short)qf[8][j]), x2 = bf2f((unsigned short)qf[9][j]), x3 = bf2f((unsigned short)qf[10][j]), x4 = bf2f((unsigned short)qf[11][j]);
            qf[8][j] = (short)(pk2(x1 * cr - x2 * sr, 0.f) & 0xffffu); qf[9][j] = (short)(pk2(x2 * cr + x1 * sr, 0.f) & 0xffffu);
            qf[10][j] = (short)(pk2(x3 * cc - x4 * sc, 0.f) & 0xffffu); qf[11][j] = (short)(pk2(x4 * cc + x3 * sc, 0.f) & 0xffffu); }
    }
    f32x16 o[4];
#pragma unroll
    for (int d = 0; d < 4; ++d)
#pragma unroll
        for (int e = 0; e < 16; ++e) o[d][e] = 0.f;
    float m = -INFINITY, l = 0.f;
    const float cs = 0.07216878364870322f * LOG2E;
    const unsigned kgo = (unsigned)(((tid >> 4) * 1024 + (tid & 15) * 8) * 2), klo = (unsigned)((tid >> 4) * MLA_KSB + (tid & 15) * 16);
    const unsigned rgo = (unsigned)(((tid >> 3) * 64 + (tid & 7) * 8) * 2), rlo = (unsigned)((tid >> 3) * MLA_KSB + 256 + (tid & 7) * 16);
    const unsigned vlo = (unsigned)((tid >> 4) * MLA_VRB + (tid & 15) * 16);
    const int vtb = (4 * hi + ((lane & 15) >> 2)) * MLA_VRB + (16 * ((lane >> 4) & 1) + 4 * (lane & 3)) * 2;
    const char* kvb0 = (const char*)(KVM + ((size_t)b * TB) * 1024 + h * 256);
    const char* krb0 = (const char*)(KR + ((size_t)b * TB) * 64);
    v4u kreg[3], vreg[2];
#define MLA_LOAD(t) do { const char* kb_ = kvb0 + (size_t)(t) * (64 * 1024 * 2); const char* rb_ = krb0 + (size_t)(t) * (64 * 64 * 2); \
        kreg[0] = *(const v4u*)(kb_ + kgo); kreg[1] = *(const v4u*)(kb_ + 32 * 1024 * 2 + kgo); kreg[2] = *(const v4u*)(rb_ + rgo); \
        vreg[0] = *(const v4u*)(kb_ + 256 + kgo); vreg[1] = *(const v4u*)(kb_ + 32 * 1024 * 2 + 256 + kgo); } while (0)
#define MLA_STORE(buf) do { LAS unsigned char* Kt_ = L + (buf) * MLA_BUF; LAS unsigned char* Vt_ = Kt_ + MLA_KT; \
        *(LAS v4u*)(Kt_ + klo) = kreg[0]; *(LAS v4u*)(Kt_ + 32 * MLA_KSB + klo) = kreg[1]; *(LAS v4u*)(Kt_ + rlo) = kreg[2]; \
        *(LAS v4u*)(Vt_ + vlo) = vreg[0]; *(LAS v4u*)(Vt_ + 32 * MLA_VRB + vlo) = vreg[1]; } while (0)
    const int half = wave >> 2;
    MLA_LOAD(0); MLA_STORE(0);
    if (ntiles > 1) { MLA_LOAD(1); MLA_STORE(1); }
    __syncthreads();
    if (half) __builtin_amdgcn_s_barrier();
    if (ntiles > 2) MLA_LOAD(2);
    int bcur = 0, bst = 2;
    for (int t = 0; t < ntiles; ++t) {
        LAS const unsigned char* Kt = L + bcur * MLA_BUF;
        f32x16 p[2];
        __builtin_amdgcn_sched_barrier(0);
        attn_scores<192, MLA_KSB>(Kt, qf, p, r32, hi);
        __syncthreads();
        attn_softmax<128, false>(p, o, m, l, cs, hi, 0);
        attn_pv<128, MLA_VRB>(Kt + MLA_KT, p, o, vtb);
        if (t + 2 < ntiles) { MLA_STORE(bst); if (t + 3 < ntiles) MLA_LOAD(t + 3); }
        __syncthreads();
        bcur = bcur == 2 ? 0 : bcur + 1; bst = bst == 2 ? 0 : bst + 1;
    }
    if (!half) __builtin_amdgcn_s_barrier();
#undef MLA_LOAD
#undef MLA_STORE
    attn_store<128>(Y + (size_t)qrow * DM + h * 128, o, l, hi);
}

constexpr int SWA_KSB = 144, SWA_KT = 64 * SWA_KSB  , SWA_VRB = 192, SWA_VT = 64 * SWA_VRB  , SWA_BUF = SWA_KT + SWA_VT;
__device__ __forceinline__ void swa_unit(const bf16* Z, const float* sink  , bf16* Y, int b, int g, int blk, int cblk, LAS unsigned char* L, int tid) {
    const int wave = tid >> 6, lane = tid & 63, r32 = lane & 31, hi = lane >> 5;
    const bool latent = blk >= 0;
    const int head = 8 * g + wave;
    const int qrow0 = b * TB + (latent ? CTX + 64 * blk : 64 * cblk);
    bf16x8 qf[2][4];
#pragma unroll
    for (int sb = 0; sb < 2; ++sb) { const bf16* qp = Z + (size_t)(qrow0 + 32 * sb + r32) * DINP + ZSQ + head * 64 + 8 * hi;
#pragma unroll
        for (int ks = 0; ks < 4; ++ks) qf[sb][ks] = *(const bf16x8*)(qp + 16 * ks); }
    f32x16 o[2][2];
#pragma unroll
    for (int sb = 0; sb < 2; ++sb)
#pragma unroll
        for (int d = 0; d < 2; ++d)
#pragma unroll
            for (int e = 0; e < 16; ++e) o[sb][d][e] = 0.f;
    const float sk = sink[head] * LOG2E;
    float m[2] = {sk, sk}, l[2] = {hi == 0 ? 1.f : 0.f, hi == 0 ? 1.f : 0.f};
    const float cs = 0.125f * LOG2E;
    int wlo = 0, nwin = 0;
    if (latent) { wlo = blk - 2 < 0 ? 0 : blk - 2; const int whi = blk + 2 > 127 ? 127 : blk + 2; nwin = whi - wlo + 1; }
    const int ntiles = 4 + nwin;
    const unsigned kgo = (unsigned)(((tid >> 3) * DINP + ZSK + (tid & 7) * 8) * 2), klo = (unsigned)((tid >> 3) * SWA_KSB + (tid & 7) * 16), vlo = (unsigned)((tid >> 3) * SWA_VRB + (tid & 7) * 16);
    const int vtb = (4 * hi + ((lane & 15) >> 2)) * SWA_VRB + (16 * ((lane >> 4) & 1) + 4 * (lane & 3)) * 2;
    const char* zb0 = (const char*)(Z + ((size_t)b * TB) * DINP + g * 64);
    v4u kreg, vreg;
#define SWA_ROW0(t) ((t) < 4 ? 64 * (t) : CTX + 64 * (wlo + (t) - 4))
#define SWA_LOAD(t) do { const char* zb_ = zb0 + (size_t)SWA_ROW0(t) * (DINP * 2); kreg = *(const v4u*)(zb_ + kgo); vreg = *(const v4u*)(zb_ + (ZSV - ZSK) * 2 + kgo); } while (0)
#define SWA_STORE(buf) do { LAS unsigned char* Kt_ = L + (buf) * SWA_BUF; *(LAS v4u*)(Kt_ + klo) = kreg; *(LAS v4u*)(Kt_ + SWA_KT + vlo) = vreg; } while (0)
    SWA_LOAD(0); SWA_STORE(0);
    __syncthreads();
    for (int t = 0; t < ntiles; ++t) {
        const bool more = t + 1 < ntiles;
        if (more) SWA_LOAD(t + 1);
        LAS const unsigned char* Kt = L + (t & 1) * SWA_BUF;
        const int kpos0 = 64 * (wlo + t - 4);
        const bool edge = t >= 4 && (wlo + t - 4 == blk - 2 || wlo + t - 4 == blk + 2);
#pragma unroll
        for (int sb = 0; sb < 2; ++sb) attn_tile<64, 64, SWA_KSB, SWA_VRB, true>(Kt, Kt + SWA_KT, qf[sb], o[sb], m[sb], l[sb], cs, r32, hi, vtb, edge ? kpos0 - (64 * blk + 32 * sb + r32) : NO_MASK);
        if (more) SWA_STORE((t + 1) & 1);
        __syncthreads();
    }
#undef SWA_ROW0
#undef SWA_LOAD
#undef SWA_STORE
#pragma unroll
    for (int sb = 0; sb < 2; ++sb) attn_store<64>(Y + (size_t)(qrow0 + 32 * sb + r32) * DM + 512 + head * 64, o[sb], l[sb], hi);
}

struct Args { const float* in[20]; float* out; unsigned char* ws; };
enum { IN_X = 0, IN_C, IN_CTX, IN_CCTX, IN_WMOD, IN_BMOD, IN_GN1, IN_GN2, IN_WIN, IN_GQ, IN_WUQ, IN_GKV, IN_WUKV, IN_SINK, IN_GBIAS, IN_GH, IN_WOUT, IN_W1, IN_W2, IN_GFINAL };

__global__ void __launch_bounds__(NTHR, 2) fwd_kernel(Args a) {
    extern __shared__ __attribute__((aligned(16))) unsigned char lds[];
    LAS unsigned char* L = (LAS unsigned char*)lds;
    const int tid0 = threadIdx.x;
    const int G = gridDim.x;
    for (int u = tid0; u < (LDS_BYTES - LDSCTL_OFF) / 4; u += NTHR) ((LAS unsigned*)(L + LDSCTL_OFF))[u] = 0u;
    __syncthreads();
    unsigned char* ws = a.ws;
    XcdBarrier bar = xcd_barrier_post((unsigned*)(ws + WS_CTL) + CW_BAR, (volatile LAS unsigned*)(L + MISC_OFF) + 8);

#define GRID_BAR(id_) do { XcdBarrier b2_ = bar; unsigned xx_ = bar.x; asm volatile("" : "+s"(xx_)); b2_.x = xx_; xcd_barrier(b2_); } while (0)
#define LAUNDER() int tid = tid0; asm volatile("" : "+v"(tid)); int wg = blockIdx.x; asm volatile("" : "+s"(wg)); const int lane = tid & 63, wave = __builtin_amdgcn_readfirstlane(tid >> 6), gw = wg * NWAVES + wave, NGW = G * NWAVES; (void)lane; (void)wave; (void)gw; (void)NGW
    float* MOD = (float*)(ws + WS_MOD);
    constexpr size_t WSET_STRIDE = WS_WSET1 - WS_WIN;
    bf16* X = (bf16*)(ws + WS_X); bf16* H = (bf16*)(ws + WS_H); float* SLAB = (float*)(ws + WS_SLAB);
    float *GATES = (float*)(ws + WS_GATES), *DN = (float*)(ws + WS_DN), *SC = (float*)(ws + WS_SC); bf16* DC = (bf16*)(ws + WS_DC);
    unsigned char* big = ws + WS_BIG;
    bf16 *Z = (bf16*)(big + BG_Z), *ZQN = (bf16*)(big + BG_ZQN), *ZKVN = (bf16*)(big + BG_ZKVN), *KR = (bf16*)(big + BG_KR), *QM = (bf16*)(big + BG_QM), *KVM = (bf16*)(big + BG_KVM), *Y = (bf16*)(big + BG_Y), *ACT = (bf16*)big;
    const ConvSrc csrc{a.in[IN_WIN], a.in[IN_WUQ], a.in[IN_WUKV], a.in[IN_WOUT], a.in[IN_W1], a.in[IN_W2], a.in[IN_GQ], a.in[IN_GKV]};

    unsigned long long* ROWSS = (unsigned long long*)(ws + WS_STAT); long long* BIAS = (long long*)(ws + WS_STAT + 3 * MiB);
    { LAUNDER(); for (int i = wg * NTHR + tid; i < (int)(8 * MiB / 8); i += G * NTHR) ROWSS[i] = 0ull;
      phase_mod(a.in[IN_C], a.in[IN_CCTX], a.in[IN_WMOD], a.in[IN_BMOD], MOD, L, wg, G, tid); }
    GRID_BAR(0);

    for (int l = 0; l < DEPTH; ++l) {
        const float* modl = MOD + (size_t)l * 5 * 12288;
        long long* biasl = BIAS + (size_t)l * 5 * BIASW;
        unsigned long long* rssA = ROWSS + (size_t)(2 * l) * MTOK;
        unsigned long long* rssB = ROWSS + (size_t)(2 * l + 1) * MTOK;
        unsigned long long* rs2 = (unsigned long long*)(ws + WS_RS2) + (size_t)(2 * l) * MTOK;
        const bool lastl = l == DEPTH - 1;
        unsigned char* wset = ws + (size_t)(l & 1) * WSET_STRIDE; unsigned char* wnext = ws + (size_t)((l + 1) & 1) * WSET_STRIDE;
        bf16 *WIN = (bf16*)(wset + WS_WIN), *WUQ = (bf16*)(wset + WS_WUQ), *WUKV = (bf16*)(wset + WS_WUKV), *WOUT = (bf16*)(wset + WS_WOUT), *W1 = (bf16*)(wset + WS_W1), *W2 = (bf16*)(wset + WS_W2);
        const ConvDst cdst{WIN, WUQ, WUKV, WOUT, W1, W2};
        const ConvDst cnext{(bf16*)(wnext + WS_WIN), (bf16*)(wnext + WS_WUQ), (bf16*)(wnext + WS_WUKV), (bf16*)(wnext + WS_WOUT), (bf16*)(wnext + WS_W1), (bf16*)(wnext + WS_W2)};
        const float* modn = MOD + (size_t)(l + 1) * 5 * 12288; long long* biasn = BIAS + (size_t)(l + 1) * 5 * BIASW;
        { LAUNDER(); LAS float* scr = (LAS float*)(L + wave * 8448); LAS float* tab = (LAS float*)(L + 8 * 8448);
          const bool g1tail = ((MTOK / 256) * (DINP / 256)) % G != 0, g4tail = ((MTOK / 256) * (DFF / 256)) % G != 0;
          const bool needA0 = l == 0 || !g1tail, needA1 = l == 0 || !g4tail;
          if (needA0 || needA1) { conv_load_tab(tab, modl, 3, tid);
              if (needA0) conv_A(csrc, cdst, l, 0, CV_A_SPLIT, gw, NGW, scr, tab, biasl, lane);
              if (needA1) { conv_A(csrc, cdst, l, CV_A_SPLIT, CV_I1, gw, NGW, scr, tab, biasl, lane); conv_B(csrc, cdst, l, 0, CV_B_SPLIT, gw, NGW, scr, lane); } }
          conv_B(csrc, cdst, l, CV_B_SPLIT, CV_I2, gw, NGW, scr, lane);
          conv_load_tab(tab, modl, 0, tid); conv_CD(csrc, cdst, l, gw, NGW, scr, tab, biasl, lane); __syncthreads(); }
        { LAUNDER();
          if (l == 0) phase_first(a.in[IN_X], a.in[IN_CTX], X, H, rssB, a.in[IN_GN1], modl, gw, NGW, lane);
          else phase_ctxfix(X, H, rssB, SLAB, MOD + (size_t)((l - 1) * 5 + 4) * 12288 + 5 * DM, a.in[IN_GN1] + l * DM, modl + (size_t)4 * 12288 + DM, gw, NGW, lane); }
        GRID_BAR(1);
        { LAUNDER(); pg8::Gemm g{H, WIN, MTOK, DINP, DM}; pg8::StaticOrder S; S.init(MTOK, DINP, DM, G, wg);
          pg8::EpiBf16<0, true, true> E{Z, DINP, GATES, rssB, biasl, BIASW, rs2, MTOK};
          pg8::gemm_phase<pg8::EpiBf16<0, true, true>, pg8::StaticOrder, true, true>(L, g, S, E);
          constexpr int NU = (MTOK / 256) * (DINP / 256); const int rem = NU % G;
          if (!lastl && rem != 0 && wg >= rem) { LAS float* scr = (LAS float*)(L + wave * 8448); LAS float* tab = (LAS float*)(L + 8 * 8448);
              conv_load_tab(tab, modn, 3, tid); conv_A(csrc, cnext, l + 1, 0, CV_A_SPLIT, (wg - rem) * NWAVES + wave, (G - rem) * NWAVES, scr, tab, biasn, lane); __syncthreads(); } }
        GRID_BAR(2);
        { LAUNDER(); phase_e1(Z, KR, wg, G, wave, lane); }
        { LAUNDER(); mlstm_a(Z, GATES, a.in[IN_GBIAS] + l * 16, DC, DN, SC, L, wg, G, tid); }
        GRID_BAR(3);
        { LAUNDER(); mlstm_scan(DC, DN, SC, wg, G, tid); }
        __syncthreads();
        { LAUNDER(); pg8::Gemm g{Z + ZQ, WUQ, MTOK, 768, 512}; pg8::StaticOrder S; S.init(MTOK, 768, 512, G, wg);
          pg8::EpiBf16<0, false, true, 512, false> E{QM, 768, nullptr, rs2, nullptr, 0};
          pg8::gemm_phase<pg8::EpiBf16<0, false, true, 512, false>, pg8::StaticOrder, true, true, DINP>(L, g, S, E); }
        { LAUNDER(); pg8::Gemm g{Z + ZKV, WUKV, MTOK, 1024, 256}; pg8::StaticOrder S; S.init(MTOK, 1024, 256, G, (wg + 116) % G);
          pg8::EpiBf16<0, false, true, 256, false> E{KVM, 1024, nullptr, rs2 + MTOK, nullptr, 0};
          pg8::gemm_phase<pg8::EpiBf16<0, false, true, 256, false>, pg8::StaticOrder, true, true, DINP>(L, g, S, E); }
        GRID_BAR(4);
#ifndef ATT_SWAP_MASK
#define ATT_SWAP_MASK 4
#endif
        for (int stage = 0; stage < 2; ++stage) {
        bool mla_now; { int wgs = blockIdx.x; asm volatile("" : "+s"(wgs)); mla_now = (stage == 0) != ((wgs & ATT_SWAP_MASK) != 0); }
        if (mla_now) { LAUNDER();
          const int n_mla = lastl ? 512 : 512 + 16;
          for (int u = wg; u < n_mla; u += G) {
            if (u < 512) { const int pair = 2 * (u & 7) + (u >> 8), qb = (u >> 3) & 31, b = pair >> 2, h = pair & 3; mla_unit(QM, KVM, KR, Y, b, h, b * TB + CTX + 256 * qb, 132, true, L, tid); }
            else { const int i = u - 512, b = i >> 2, h = i & 3; mla_unit(QM, KVM, KR, Y, b, h, b * TB, 4, false, L, tid); }
          } }
        else {
        { LAUNDER();
          const int n_swa = lastl ? 1024 : 1024 + 32;
          for (int u = (wg + 64) % G; u < n_swa; u += G) {
            if (u < 1024) swa_unit(Z, a.in[IN_SINK] + l * 16, Y, u >> 8, (u >> 7) & 1, u & 127, 0, L, tid);
            else { const int i = u - 1024; swa_unit(Z, a.in[IN_SINK] + l * 16, Y, i >> 3, (i >> 2) & 1, -1, i & 3, L, tid); }
          } }
        { LAUNDER();
          mlstm_c_phase((wg + 128) % G, G, lastl, Z, GATES, a.in[IN_GBIAS] + l * 16, a.in[IN_GH] + l * 512, DC, DN, SC, Y, L, tid); }
        }
        __syncthreads();
        }
        GRID_BAR(5);
        { LAUNDER(); pg8::Gemm g{Y, WOUT, MTOK, DM, DM}; pg8::LatentOrder S; S.init(DM, DM, G, wg, lastl ? 0 : 2);
          pg8::EpiResid E{X, modl, 2 * DM, SLAB, DM / 64, H, a.in[IN_GN2] + l * DM, modl + 4 * DM, rssA};
          pg8::gemm_phase<pg8::EpiResid, pg8::LatentOrder, true, true>(L, g, S, E); }
        GRID_BAR(6);
        if (!lastl) {
            { LAUNDER(); phase_ctxfix(X, H, rssA, SLAB, modl + (size_t)4 * 12288 + 2 * DM, a.in[IN_GN2] + l * DM, modl + (size_t)4 * 12288 + 4 * DM, gw, NGW, lane); }
            GRID_BAR(7);
        }
        { LAUNDER(); pg8::Gemm g{H, W1, MTOK, DFF, DM}; pg8::LatentOrder S; S.init(DFF, DM, G, wg, lastl ? 0 : 1);
          pg8::EpiBf16<2, false, true> E{ACT, DFF, nullptr, rssA, biasl + DINP, BIASW};
          pg8::gemm_phase<pg8::EpiBf16<2, false, true>, pg8::LatentOrder, true, true>(L, g, S, E);
          constexpr int NU = (MTOK / 256) * (DFF / 256); const int rem = NU % G;
          if (!lastl && rem != 0 && wg >= rem) { LAS float* scr = (LAS float*)(L + wave * 8448); LAS float* tab = (LAS float*)(L + 8 * 8448); const int worker = (wg - rem) * NWAVES + wave, nworkers = (G - rem) * NWAVES;
              conv_load_tab(tab, modn, 3, tid); conv_A(csrc, cnext, l + 1, CV_A_SPLIT, CV_I1, worker, nworkers, scr, tab, biasn, lane); conv_B(csrc, cnext, l + 1, 0, CV_B_SPLIT, worker, nworkers, scr, lane); __syncthreads(); } }
        GRID_BAR(8);
        { LAUNDER(); pg8::Gemm g{ACT, W2, MTOK, DM, DFF}; pg8::LatentOrder S; S.init(DM, DFF, G, wg, lastl ? 0 : 2);
          pg8::EpiResid E{X, modl, 5 * DM, SLAB, DFF / 64, lastl ? nullptr : H, a.in[IN_GN1] + (l + 1) * DM, MOD + (size_t)(l + 1) * 5 * 12288 + DM, ROWSS + (size_t)(2 * l + 3) * MTOK};
          pg8::gemm_phase<pg8::EpiResid, pg8::LatentOrder, true, true>(L, g, S, E); }
        GRID_BAR(9);
    }
    { LAUNDER(); phase_final(X, a.out, a.in[IN_GFINAL], gw, NGW, lane); }
}

extern "C" void kernel_launch(void* const* d_in, const int* in_sizes, int n_in, void* d_out, int out_size, void* d_ws, size_t ws_size, hipStream_t stream) {
    static int grid = 0;
    if (grid == 0) {
        if (n_in != 20 || in_sizes[0] != NB * SEQ * DM || out_size != NB * SEQ * DM || ws_size < WS_END) {
            fprintf(stderr, "kernel_launch: unexpected shapes (n_in %d, in0 %d, out %d, ws %zu, need %zu); nothing launched\n", n_in, n_in > 0 ? in_sizes[0] : -1, out_size, ws_size, (size_t)WS_END); grid = -1; return; }
        int dev = 0, cus = 0, per_cu = 0;
        if (hipGetDevice(&dev) != hipSuccess || hipDeviceGetAttribute(&cus, hipDeviceAttributeMultiprocessorCount, dev) != hipSuccess) { fprintf(stderr, "kernel_launch: device query failed\n"); grid = -1; return; }
        if (hipFuncSetAttribute((const void*)fwd_kernel, hipFuncAttributeMaxDynamicSharedMemorySize, LDS_BYTES) != hipSuccess) { fprintf(stderr, "kernel_launch: hipFuncSetAttribute failed\n"); grid = -1; return; }
        if (hipOccupancyMaxActiveBlocksPerMultiprocessor(&per_cu, (const void*)fwd_kernel, NTHR, LDS_BYTES) != hipSuccess || per_cu < 1)
            fprintf(stderr, "kernel_launch: note: occupancy query reports %d workgroups per CU\n", per_cu);
        (void)hipGetLastError();
        grid = cus;
    }
    if (grid < 0) return;
    if (hipMemsetAsync((char*)d_ws + WS_CTL, 0, CTL_ZERO_BYTES, stream) != hipSuccess) { fprintf(stderr, "kernel_launch: memset failed\n"); return; }
    Args a{};
    for (int i = 0; i < 20; ++i) a.in[i] = (const float*)d_in[i];
    a.out = (float*)d_out; a.ws = (unsigned char*)d_ws;
    hipLaunchKernelGGL(fwd_kernel, dim3(grid), dim3(NTHR), LDS_BYTES, stream, a);
    const hipError_t le = hipPeekAtLastError();
    if (le != hipSuccess) fprintf(stderr, "kernel_launch: launch failed: %s\n", hipGetErrorName(le));
}
```

```cpp
#include <hip/hip_runtime.h>
#include <cstdio>
#include <cstdint>
#include <cmath>


namespace pg8 {
#define PG8_LAS __attribute__((address_space(3)))
typedef unsigned short bf16_t;
typedef short bf16x8 __attribute__((ext_vector_type(8)));
typedef float f32x4 __attribute__((ext_vector_type(4)));
typedef unsigned u32x4 __attribute__((ext_vector_type(4)));
constexpr int BM = 256, BK = 64, HALF = 128, HTB = HALF * BK * 2  , STAGE_BYTES = 8 * HTB, NXCD = 8, WGM = 8;

__host__ __device__ __forceinline__ int lds_byte(int r, int c) { const int st = (r >> 4) * 2 + (c >> 5), rr = r & 15, cc = c & 31, ob = rr * 64 + cc * 2; return st * 1024 + (ob ^ (((ob >> 9) & 1) << 5)); }
__host__ __device__ __forceinline__ void stage_rc(int b, int& R, int& C) { const int st = b / 1024, sb = b % 1024, swz = sb ^ (((sb >> 9) & 1) << 5); R = (st >> 1) * 16 + swz / 64; C = (st & 1) * 32 + (swz % 64) / 2; }
__host__ __device__ __forceinline__ int perm32(int rho) { const int n = rho >> 4, i = rho & 15; return 8 * (i >> 2) + 4 * n + (i & 3); }

struct Unit { int pm, pn, k0, nt; };
struct Gemm { const bf16_t* A; const bf16_t* Bt; int M, N, K; };

struct StaticOrder {
    int nM, nN, nwg, G, c, fullnt;
    __host__ __device__ void init(int M, int N, int K, int G_, int c_) { nM = M / BM; nN = N / BM; nwg = nM * nN; G = G_; c = c_; fullnt = K / BK; }
    __host__ __device__ bool next(int i, Unit& u) const {
        const long L = (long)i * G + c; if (L >= nwg) return false;
        int wgid = (int)L; { const int q = nwg / NXCD, r = nwg % NXCD, xcd = wgid % NXCD, off = wgid / NXCD; wgid = (xcd < r ? xcd * (q + 1) : r * (q + 1) + (xcd - r) * q) + off; }
        const int nig = WGM * nN, gid = wgid / nig, fm = gid * WGM, gsz = (nM - fm) < WGM ? (nM - fm) : WGM;
        u.pm = fm + ((wgid % nig) % gsz); u.pn = (wgid % nig) / gsz; u.k0 = 0; u.nt = fullnt; return true;
    }
    __device__ __forceinline__ void a_ready(const Unit&) const {}
    __device__ __forceinline__ void done(const Unit&) const {}
};

struct LatentOrder {
    StaticOrder so; int nN, mode;
    __host__ __device__ void init(int N, int K, int G_, int c_, int mode_) { so.init(128 * BM, N, K, G_, c_); nN = N / BM; mode = mode_; }
    __host__ __device__ bool next(int i, Unit& u) const {
        if (so.next(i, u)) { u.pm = u.pm + u.pm / 32 + 1; return true; }
        const long L = (long)i * so.G + so.c - so.nwg;
        if (mode == 1) { if (L >= 4 * nN) return false; u.pm = 33 * (int)(L / nN); u.pn = (int)(L % nN); u.k0 = 0; u.nt = so.fullnt; return true; }
        if (mode == 2) { if (L >= 32 * nN) return false; const int tile = (int)(L >> 3), ks = (int)(L & 7); u.pm = 33 * (tile / nN); u.pn = tile % nN; u.nt = so.fullnt >> 3; u.k0 = ks * u.nt; return true; }
        return false;
    }
    __device__ __forceinline__ void a_ready(const Unit&) const {}
    __device__ __forceinline__ void done(const Unit&) const {}
};

__device__ __forceinline__ unsigned cvt_pk_bf16(float lo, float hi) { unsigned r; asm volatile("v_cvt_pk_bf16_f32 %0, %1, %2" : "=v"(r) : "v"(lo), "v"(hi)); return r; }
typedef float f32x2 __attribute__((ext_vector_type(2)));

typedef float f32x2v __attribute__((ext_vector_type(2))); typedef __bf16 bf16x2v __attribute__((ext_vector_type(2)));
__device__ __forceinline__ unsigned pkbf(float lo, float hi) { f32x2v v = {lo, hi}; bf16x2v b = __builtin_convertvector(v, bf16x2v); return __builtin_bit_cast(unsigned, b); }

template <int ACT, bool GATES, bool NORMED, int NW = 2048, bool BIASED = true, bool BF32 = false> struct EpiBf16 {
    static constexpr bool PERM = true, AFTER_DRAIN = false;
    bf16_t* O; int ldc; float* gates; const unsigned long long* rowss; const long long* bias; int ldb; unsigned long long* rs2 = nullptr; int rs2_stride = 0;
    __device__ __forceinline__ void operator()(const f32x4 (&acc)[2][2][4][2], const Unit& u, int wr, int wc, int fr, int fq) const {
        const int row0 = u.pm * BM + wr * 64 + fr; const int col0 = u.pn * BM + wc * 32 + 8 * fq;
        f32x4 bv[2][2]; float tots[4];
        if (NORMED && BIASED) { const int bb = u.pm / 33, bp = (u.pm - bb * 33 == 0) ? 4 : bb; const long long* bptr = bias + (size_t)bp * ldb + col0;
            if (BF32) { const float* bf = (const float*)bias + (size_t)bp * ldb + col0;
#pragma unroll
                for (int bj = 0; bj < 2; ++bj)
#pragma unroll
                    for (int n = 0; n < 2; ++n) bv[bj][n] = *(const f32x4*)(bf + bj * HALF + 4 * n);
            } else {
#pragma unroll
            for (int bj = 0; bj < 2; ++bj)
#pragma unroll
                for (int n = 0; n < 2; ++n)
#pragma unroll
                    for (int e = 0; e < 4; ++e) bv[bj][n][e] = (float)bptr[bj * HALF + 4 * n + e] * 2.3283064365386963e-10f; } }
#pragma unroll
        for (int ai = 0; ai < 2; ++ai)
#pragma unroll
            for (int m = 0; m < 4; ++m) { const int row = row0 + ai * HALF + m * 16; bf16_t* rowp = O + (size_t)row * ldc + col0;
                float rstd = 1.f; if (NORMED) rstd = __builtin_amdgcn_rsqf((float)rowss[row] * (1.f / (float)NW / 16777216.f) + 1e-6f);
                float ssq = 0.f;
#pragma unroll
                for (int bj = 0; bj < 2; ++bj) { f32x4 v0 = acc[ai][bj][m][0], v1 = acc[ai][bj][m][1];
                    if (NORMED) { if (BIASED) { v0 = v0 * rstd + bv[bj][0]; v1 = v1 * rstd + bv[bj][1]; } else { v0 = v0 * rstd; v1 = v1 * rstd; } }
                    if (GATES) ssq += ((v0[0] * v0[0] + v0[1] * v0[1]) + (v0[2] * v0[2] + v0[3] * v0[3])) + ((v1[0] * v1[0] + v1[1] * v1[1]) + (v1[2] * v1[2] + v1[3] * v1[3]));
                    if (GATES) { if (bj == 0 && u.pn == 12 && wc == 2 && fq < 2) { float* gp = gates + (size_t)row * 16 + 8 * fq; *(f32x4*)gp = v0; *(f32x4*)(gp + 4) = v1; } }
                    if (ACT == 2) {
#pragma unroll
                        for (int e = 0; e < 4; ++e) { float a = v0[e] > 0.f ? v0[e] : 0.f; v0[e] = a * a; float b = v1[e] > 0.f ? v1[e] : 0.f; v1[e] = b * b; } }
                    u32x4 w; w.x = pkbf(v0[0], v0[1]); w.y = pkbf(v0[2], v0[3]); w.z = pkbf(v1[0], v1[1]); w.w = pkbf(v1[2], v1[3]);
                    *(u32x4*)(rowp + bj * HALF) = w; }
                if (GATES) { if (u.pn < 3) {
                    const auto r1 = __builtin_amdgcn_permlane16_swap(__float_as_uint(ssq), __float_as_uint(ssq), false, false); ssq = __uint_as_float(r1[0]) + __uint_as_float(r1[1]);
                    const auto r2 = __builtin_amdgcn_permlane32_swap(__float_as_uint(ssq), __float_as_uint(ssq), false, false); tots[m] = __uint_as_float(r2[0]) + __uint_as_float(r2[1]);
                    if (m == 3) { const float mine = fq == 0 ? tots[0] : fq == 1 ? tots[1] : fq == 2 ? tots[2] : tots[3];
                        atomicAdd(rs2 + (size_t)(u.pn == 2 ? rs2_stride : 0) + (u.pm * BM + ai * HALF + wr * 64 + fq * 16 + fr), (unsigned long long)(mine * 16777216.f)); } } } }
    }
};
struct EpiResid {
    static constexpr bool PERM = false, AFTER_DRAIN = false;
    bf16_t* X; const float* modl; int goff; float* slab; int fullnt;
    bf16_t* hx; const float* ng; const float* nsc; unsigned long long* rowss;
    __device__ __forceinline__ void operator()(const f32x4 (&acc)[2][2][4][2], const Unit& u, int wr, int wc, int fr, int fq) const {
        const int bb = u.pm / 33, bp = (u.pm - bb * 33 == 0) ? 4 : bb;
        const int col0 = u.pn * BM + wc * 32 + 4 * fq;
        if (u.nt != fullnt) {
            float* sp0 = slab + ((size_t)(u.k0 / u.nt) * 1024 + bb * 256 + wr * 64 + fr) * 2048 + col0;
#pragma unroll
            for (int ai = 0; ai < 2; ++ai)
#pragma unroll
                for (int m = 0; m < 4; ++m) { float* sp = sp0 + (size_t)(ai * HALF + m * 16) * 2048;
#pragma unroll
                    for (int bj = 0; bj < 2; ++bj)
#pragma unroll
                        for (int n = 0; n < 2; ++n) *(f32x4*)(sp + bj * HALF + n * 16) = acc[ai][bj][m][n]; }
            return;
        }
        const float* gate = modl + (size_t)bp * 12288 + goff;
        f32x4 gv[2][2], gm[2][2];
#pragma unroll
        for (int bj = 0; bj < 2; ++bj)
#pragma unroll
            for (int n = 0; n < 2; ++n) { gv[bj][n] = *(const f32x4*)(gate + col0 + bj * HALF + n * 16);
                if (hx) { const f32x4 g4 = *(const f32x4*)(ng + col0 + bj * HALF + n * 16), s4 = *(const f32x4*)(nsc + (size_t)bp * 12288 + col0 + bj * HALF + n * 16); gm[bj][n] = g4 * (s4 + 1.f); } }
        const int hc = u.pn * BM + wc * 32 + ((fq & 1) ? 16 + 4 * (fq - 1) : 4 * fq);
        u32x4 xr[4][2]; float tots[4];
#define ER_LOAD(g) do { const bf16_t* xp_ = X + (size_t)(u.pm * BM + ((g) >> 2) * HALF + wr * 64 + ((g) & 3) * 16 + fr) * 2048 + hc; \
        _Pragma("unroll") for (int bj = 0; bj < 2; ++bj) xr[(g) & 3][bj] = *(const u32x4*)(xp_ + bj * HALF); } while (0)
        ER_LOAD(0); ER_LOAD(1); ER_LOAD(2); ER_LOAD(3);
        asm volatile("" ::: "memory");
#pragma unroll
        for (int g = 0; g < 8; ++g) { const int ai = g >> 2, m = g & 3; const int row = u.pm * BM + ai * HALF + wr * 64 + m * 16 + fr; float ss = 0.f;
#pragma unroll
            for (int bj = 0; bj < 2; ++bj) { const u32x4 raw = xr[g & 3][bj];
                const auto lx = __builtin_amdgcn_permlane16_swap(raw[0], raw[2], false, false); const auto ly = __builtin_amdgcn_permlane16_swap(raw[1], raw[3], false, false);
                unsigned xw[2][2], hw[2][2];
#pragma unroll
                for (int n = 0; n < 2; ++n) { const unsigned wx = lx[n], wy = ly[n];
                    f32x4 xv = {__uint_as_float(wx << 16), __uint_as_float(wx & 0xffff0000u), __uint_as_float(wy << 16), __uint_as_float(wy & 0xffff0000u)};
                    xv = xv + gv[bj][n] * acc[ai][bj][m][n]; xw[n][0] = pkbf(xv[0], xv[1]); xw[n][1] = pkbf(xv[2], xv[3]);
                    if (hx) { ss += (xv[0] * xv[0] + xv[1] * xv[1]) + (xv[2] * xv[2] + xv[3] * xv[3]); const f32x4 hv = xv * gm[bj][n]; hw[n][0] = pkbf(hv[0], hv[1]); hw[n][1] = pkbf(hv[2], hv[3]); } }
                { const auto sx = __builtin_amdgcn_permlane16_swap(xw[0][0], xw[1][0], false, false); const auto sy = __builtin_amdgcn_permlane16_swap(xw[0][1], xw[1][1], false, false);
                  *(u32x4*)(X + (size_t)row * 2048 + bj * HALF + hc) = (u32x4){sx[0], sy[0], sx[1], sy[1]}; }
                if (hx) { const auto rx = __builtin_amdgcn_permlane16_swap(hw[0][0], hw[1][0], false, false); const auto ry = __builtin_amdgcn_permlane16_swap(hw[0][1], hw[1][1], false, false);
                    *(u32x4*)(hx + (size_t)row * 2048 + bj * HALF + hc) = (u32x4){rx[0], ry[0], rx[1], ry[1]}; } }
            if (hx) {
                const auto r1 = __builtin_amdgcn_permlane16_swap(__float_as_uint(ss), __float_as_uint(ss), false, false); ss = __uint_as_float(r1[0]) + __uint_as_float(r1[1]);
                const auto r2 = __builtin_amdgcn_permlane32_swap(__float_as_uint(ss), __float_as_uint(ss), false, false); tots[m] = __uint_as_float(r2[0]) + __uint_as_float(r2[1]);
                if (m == 3) { const float mine = fq == 0 ? tots[0] : fq == 1 ? tots[1] : fq == 2 ? tots[2] : tots[3];
                    atomicAdd(rowss + (u.pm * BM + ai * HALF + wr * 64 + fq * 16 + fr), (unsigned long long)(mine * 16777216.f)); } }
            asm volatile("" ::: "memory");
            if (g + 4 < 8) { ER_LOAD(g + 4); asm volatile("" ::: "memory"); } }
#undef ER_LOAD
    }
};

template <class Epi, class Sched, bool ALIGN_EPI = false, bool SP2 = false, int LDA = 0>
__device__ __forceinline__ void gemm_phase(PG8_LAS unsigned char* lds, const Gemm g, const Sched& S, const Epi& E) {
    int tid_l = threadIdx.x; asm volatile("" : "+v"(tid_l));
    const int tid = tid_l, wid = __builtin_amdgcn_readfirstlane(tid >> 6), lane = tid & 63, wr = wid >> 2, wc = wid & 3, fr = lane & 15, fq = lane >> 4;
    const int K = g.K; const int lda = LDA ? LDA : K;
    unsigned voffA[2], voffB[2];
#pragma unroll
    for (int i = 0; i < 2; ++i) { int R, C; stage_rc(tid * 16 + i * 8192, R, C); const int Rb = Epi::PERM ? ((R & ~31) + perm32(R & 31)) : R;
        voffA[i] = (unsigned)(R * lda + C) * 2u; voffB[i] = (unsigned)(Rb * K + C) * 2u; }
    const size_t kstep = (size_t)(BK * 2);
    const size_t hstep = (size_t)HALF * K * 2;
    const size_t tstep = 2 * hstep;
    const size_t hstepA = LDA ? (size_t)HALF * LDA * 2 : hstep, tstepA = 2 * hstepA;
    const unsigned ldsw = (unsigned)wid * 1024u;
    const int aoff = lds_byte(wr * 64 + fr, fq * 8), boff = lds_byte(wc * 32 + fr, fq * 8);
#define PG8_SA(b, h) (((b) * 2 + (h)) * HTB)
#define PG8_SB(b, h) ((4 + (b) * 2 + (h)) * HTB)
#define PG8_STAGE(bufoff, gbase, voff) do { _Pragma("unroll") for (int _i = 0; _i < 2; ++_i) \
        __builtin_amdgcn_global_load_lds((const unsigned*)((const char*)(gbase) + (voff)[_i]), (PG8_LAS unsigned*)(lds + (bufoff) + ldsw + _i * 8192), 16, 0, 0); } while (0)
#define PG8_LDA(dst, b, h) do { _Pragma("unroll") for (int m = 0; m < 4; ++m) _Pragma("unroll") for (int k = 0; k < 2; ++k) dst[m][k] = *(const PG8_LAS bf16x8*)(lds + PG8_SA(b, h) + aoff + m * 2048 + k * 1024); } while (0)
#define PG8_LDB(dst, b, h) do { _Pragma("unroll") for (int n = 0; n < 2; ++n) _Pragma("unroll") for (int k = 0; k < 2; ++k) dst[n][k] = *(const PG8_LAS bf16x8*)(lds + PG8_SB(b, h) + boff + n * 2048 + k * 1024); } while (0)
#define PG8_MMA(ai, bj, At, Bt) do { __builtin_amdgcn_s_setprio(1); _Pragma("unroll") for (int m = 0; m < 4; ++m) _Pragma("unroll") for (int n = 0; n < 2; ++n) _Pragma("unroll") for (int k = 0; k < 2; ++k) \
        acc[ai][bj][m][n] = __builtin_amdgcn_mfma_f32_16x16x32_bf16(Bt[n][k], At[m][k], acc[ai][bj][m][n], 0, 0, 0); __builtin_amdgcn_s_setprio(0); } while (0)
#define PG8_WAIT_V(n) asm volatile("s_waitcnt vmcnt(" #n ")" ::: "memory")
#define PG8_WAIT_L(n) asm volatile("s_waitcnt lgkmcnt(" #n ")" ::: "memory")
#define PG8_BAR __builtin_amdgcn_s_barrier()
#define PG8_SCHED __builtin_amdgcn_sched_barrier(0)
    Unit cur, nxt; int ui = 0;
    if (!S.next(0, cur)) return;
    f32x4 acc[2][2][4][2];
#pragma unroll
    for (int a = 0; a < 2; ++a)
#pragma unroll
        for (int b = 0; b < 2; ++b)
#pragma unroll
            for (int m = 0; m < 4; ++m)
#pragma unroll
                for (int n = 0; n < 2; ++n) acc[a][b][m][n] = (f32x4){0.f, 0.f, 0.f, 0.f};
    bf16x8 At[4][2], B0[2][2], B1[2][2];
    int nt = cur.nt;
    const char* cA = (const char*)g.A + (size_t)cur.pm * tstepA + (size_t)cur.k0 * kstep; const char* cB = (const char*)g.Bt + (size_t)cur.pn * tstep + (size_t)cur.k0 * kstep;
    S.a_ready(cur);
    if constexpr (SP2) {
        PG8_STAGE(PG8_SB(0, 0), cB, voffB); PG8_STAGE(PG8_SB(0, 1), cB + hstep, voffB); PG8_STAGE(PG8_SA(0, 0), cA, voffA); PG8_STAGE(PG8_SA(0, 1), cA + hstepA, voffA);
        if (wr == 1) PG8_BAR;
        PG8_WAIT_V(2); PG8_BAR;
        PG8_STAGE(PG8_SB(1, 0), cB + kstep, voffB); PG8_STAGE(PG8_SA(1, 0), cA + kstep, voffA); PG8_STAGE(PG8_SB(1, 1), cB + hstep + kstep, voffB);
        PG8_WAIT_V(6); PG8_BAR;
    } else {
        PG8_STAGE(PG8_SB(0, 0), cB, voffB); PG8_STAGE(PG8_SA(0, 0), cA, voffA); PG8_STAGE(PG8_SB(0, 1), cB + hstep, voffB); PG8_STAGE(PG8_SA(0, 1), cA + hstepA, voffA);
        if (wr == 1) PG8_BAR;
        PG8_WAIT_V(4); PG8_BAR;
        PG8_STAGE(PG8_SB(1, 0), cB + kstep, voffB); PG8_STAGE(PG8_SA(1, 0), cA + kstep, voffA); PG8_STAGE(PG8_SB(1, 1), cB + hstep + kstep, voffB);
        PG8_WAIT_V(6); PG8_BAR;
    }
    for (;;) {
        const bool has_next = S.next(ui + 1, nxt);
        const char* nA = has_next ? (const char*)g.A + (size_t)nxt.pm * tstepA + (size_t)nxt.k0 * kstep : cA; const char* nB = has_next ? (const char*)g.Bt + (size_t)nxt.pn * tstep + (size_t)nxt.k0 * kstep : cB;
        for (int t = 0; t < nt; t += 2) {
            const bool last = (t == nt - 2);
            const char* a1 = cA + (size_t)(t + 1) * kstep;
            const char* a2 = last ? nA : cA + (size_t)(t + 2) * kstep; const char* b2 = last ? nB : cB + (size_t)(t + 2) * kstep;
            const char* a3 = a2 + kstep; const char* b3 = b2 + kstep;
            if (last && has_next) S.a_ready(nxt);
            if constexpr (SP2) {
            PG8_LDB(B0, 0, 0); PG8_LDB(B1, 0, 1); PG8_SCHED; PG8_LDA(At, 0, 0); PG8_STAGE(PG8_SA(1, 1), a1 + hstepA, voffA);
            PG8_WAIT_V(8); PG8_WAIT_L(0); PG8_BAR; PG8_MMA(0, 0, At, B0); PG8_MMA(0, 1, At, B1); PG8_BAR; PG8_SCHED;
            PG8_LDA(At, 0, 1); PG8_STAGE(PG8_SB(0, 0), b2, voffB); PG8_STAGE(PG8_SB(0, 1), b2 + hstep, voffB); PG8_STAGE(PG8_SA(0, 0), a2, voffA);
            PG8_WAIT_V(8); PG8_WAIT_L(0); PG8_BAR; PG8_MMA(1, 0, At, B0); PG8_MMA(1, 1, At, B1); PG8_BAR; PG8_SCHED;
            PG8_LDB(B0, 1, 0); PG8_LDB(B1, 1, 1); PG8_SCHED; PG8_LDA(At, 1, 0); PG8_STAGE(PG8_SA(0, 1), a2 + hstepA, voffA);
            PG8_WAIT_V(8); PG8_WAIT_L(0); PG8_BAR; PG8_MMA(0, 0, At, B0); PG8_MMA(0, 1, At, B1); PG8_BAR; PG8_SCHED;
            PG8_LDA(At, 1, 1); PG8_STAGE(PG8_SB(1, 0), b3, voffB); PG8_STAGE(PG8_SB(1, 1), b3 + hstep, voffB); PG8_STAGE(PG8_SA(1, 0), a3, voffA);
            PG8_WAIT_V(8); PG8_WAIT_L(0); PG8_BAR; PG8_MMA(1, 0, At, B0); PG8_MMA(1, 1, At, B1); PG8_BAR; PG8_SCHED;
            } else {
            PG8_LDB(B0, 0, 0); PG8_SCHED; PG8_LDA(At, 0, 0); PG8_STAGE(PG8_SA(1, 1), a1 + hstepA, voffA);
            PG8_WAIT_L(8); PG8_BAR; PG8_WAIT_L(0); PG8_MMA(0, 0, At, B0); PG8_BAR; PG8_SCHED;
            PG8_LDB(B1, 0, 1); PG8_STAGE(PG8_SB(0, 0), b2, voffB);
            PG8_BAR; PG8_WAIT_L(0); PG8_MMA(0, 1, At, B1); PG8_BAR;
            PG8_LDA(At, 0, 1); PG8_STAGE(PG8_SA(0, 0), a2, voffA);
            PG8_BAR; PG8_WAIT_L(0); PG8_MMA(1, 0, At, B0); PG8_BAR; PG8_SCHED;
            PG8_STAGE(PG8_SB(0, 1), b2 + hstep, voffB);
            PG8_WAIT_V(6); PG8_BAR; PG8_MMA(1, 1, At, B1); PG8_BAR;
            PG8_LDB(B0, 1, 0); PG8_SCHED; PG8_LDA(At, 1, 0); PG8_STAGE(PG8_SA(0, 1), a2 + hstepA, voffA);
            PG8_WAIT_L(8); PG8_BAR; PG8_WAIT_L(0); PG8_MMA(0, 0, At, B0); PG8_BAR; PG8_SCHED;
            PG8_LDB(B1, 1, 1); PG8_STAGE(PG8_SB(1, 0), b3, voffB);
            PG8_BAR; PG8_WAIT_L(0); PG8_MMA(0, 1, At, B1); PG8_BAR;
            PG8_LDA(At, 1, 1); PG8_STAGE(PG8_SA(1, 0), a3, voffA);
            PG8_BAR; PG8_WAIT_L(0); PG8_MMA(1, 0, At, B0); PG8_BAR; PG8_SCHED;
            PG8_STAGE(PG8_SB(1, 1), b3 + hstep, voffB);
            PG8_WAIT_V(6); PG8_BAR; PG8_MMA(1, 1, At, B1); PG8_BAR;
            }
        }
        if constexpr (ALIGN_EPI) { if (wr == 0) PG8_BAR; }
        if constexpr (!Epi::AFTER_DRAIN) { E(acc, cur, wr, wc, fr, fq); S.done(cur); }
        if (!has_next) break;
#pragma unroll
        for (int a = 0; a < 2; ++a)
#pragma unroll
            for (int b = 0; b < 2; ++b)
#pragma unroll
                for (int m = 0; m < 4; ++m)
#pragma unroll
                    for (int n = 0; n < 2; ++n) acc[a][b][m][n] = (f32x4){0.f, 0.f, 0.f, 0.f};
        cur = nxt; cA = nA; cB = nB; nt = cur.nt; ++ui;
        if constexpr (ALIGN_EPI) { if (wr == 1) PG8_BAR; }
    }
    PG8_WAIT_V(0);
    if constexpr (!ALIGN_EPI) { if (wr == 0) PG8_BAR; }
    PG8_BAR;
    if constexpr (Epi::AFTER_DRAIN) { E.fused(acc, cur, wr, wc, fr, fq, lds, wid, lane); S.done(cur); }
#undef PG8_SA
#undef PG8_SB
#undef PG8_STAGE
#undef PG8_LDA
#undef PG8_LDB
#undef PG8_MMA
#undef PG8_WAIT_V
#undef PG8_WAIT_L
#undef PG8_BAR
#undef PG8_SCHED
}
}
#define LAS __attribute__((address_space(3)))
typedef __attribute__((address_space(1))) unsigned gu32;
#define XB_TMO      128
#define XB_XCNT(j)  (256  + 64 * (j))
#define XB_XSUB(j)  (1280 + 64 * (j))
#define XB_XGEN(j)  (2304 + 64 * (j))
#define XB_TOP      3328
#define XB_TOPGEN   3392
#define XCD_BAR_WORDS 3456
#define XB_SPIN_CAP (1u << 18)

__device__ __forceinline__ unsigned xb_ld(unsigned* p)              { return __hip_atomic_load(p, __ATOMIC_RELAXED, __HIP_MEMORY_SCOPE_AGENT); }
__device__ __forceinline__ unsigned xb_add(unsigned* p, unsigned v) { return __hip_atomic_fetch_add(p, v, __ATOMIC_RELAXED, __HIP_MEMORY_SCOPE_AGENT); }
__device__ __forceinline__ unsigned xb_xcc_id() { return (unsigned)__builtin_amdgcn_s_getreg((3 << 11) | 20) & 0xFu; }
#define XB_SPIN(cond, bar) do { unsigned _sp = 0; while (cond) { __builtin_amdgcn_s_sleep(1); \
    if ((++_sp & 255u) == 0u) { if (xb_ld(&(bar)[XB_TMO])) break; if (_sp > XB_SPIN_CAP) { atomicAdd(&(bar)[XB_TMO], 1u); break; } } } } while (0)

struct XcdBarrier {
    unsigned* bar; unsigned x;
    volatile LAS unsigned* st;
};

__device__ __forceinline__ XcdBarrier xcd_barrier_post(unsigned* bar, volatile LAS unsigned* st) {
    XcdBarrier b; b.bar = bar; b.x = xb_xcc_id(); b.st = st;
    if (threadIdx.x == 0) (void)xb_add(&bar[XB_XCNT(b.x)], 1u);
    return b;
}
__device__ __forceinline__ void xcd_barrier_complete(unsigned* bar, unsigned x, unsigned& nloc, unsigned& nx) {
    const unsigned G = gridDim.x * gridDim.y * gridDim.z;
    unsigned sum, cnt, mine, sp = 0u;
    for (;;) {
        sum = 0u; cnt = 0u; mine = 0u;
#pragma unroll
        for (unsigned j = 0; j < 16; ++j) { const unsigned c = xb_ld(&bar[XB_XCNT(j)]); sum += c; cnt += (c > 0u) ? 1u : 0u; mine = (j == x) ? c : mine; }
        if (sum == G) break;
        __builtin_amdgcn_s_sleep(1);
        if ((++sp & 255u) == 0u) { if (xb_ld(&bar[XB_TMO])) break; if (sp > XB_SPIN_CAP) { atomicAdd(&bar[XB_TMO], 1u); break; } }
    }
    nloc = mine > 0u ? mine : 1u; nx = cnt > 0u ? cnt : 1u;
}

__device__ __forceinline__ void xcd_barrier(const XcdBarrier& b) {
    asm volatile("s_waitcnt vmcnt(0)" ::: "memory");
    __syncthreads();
    if (threadIdx.x == 0) {
        unsigned* bar = b.bar;
        __builtin_amdgcn_s_waitcnt(0);
        unsigned nloc = b.st[0], nx = b.st[1];
        if (nloc == 0u) { xcd_barrier_complete(bar, b.x, nloc, nx); b.st[0] = nloc; b.st[1] = nx; }
        const unsigned old = xb_add(&bar[XB_XSUB(b.x)], 1u);
        const unsigned gen = old / nloc;
        if (old + 1u == (gen + 1u) * nloc) {
            __builtin_amdgcn_fence(__ATOMIC_RELEASE, "agent");
            asm volatile("s_waitcnt vmcnt(0)" ::: "memory");
            const unsigned og = xb_add(&bar[XB_TOP], 1u);
            const unsigned tg = og / nx;
            if (og + 1u == (tg + 1u) * nx) xb_add(&bar[XB_TOPGEN], 1u);
            else XB_SPIN(xb_ld(&bar[XB_TOPGEN]) == tg, bar);
            __builtin_amdgcn_fence(__ATOMIC_ACQUIRE, "agent");
            xb_add(&bar[XB_XGEN(b.x)], 1u);
            asm volatile("s_waitcnt vmcnt(0)" ::: "memory");
        } else {
            XB_SPIN(xb_ld(&bar[XB_XGEN(b.x)]) == gen, bar);
            __builtin_amdgcn_fence(__ATOMIC_ACQUIRE, "agent");
            asm volatile("s_waitcnt vmcnt(0)" ::: "memory");
        }
    }
    __syncthreads();
}

typedef unsigned short bf16;
typedef unsigned v4u __attribute__((ext_vector_type(4)));
typedef unsigned v2u __attribute__((ext_vector_type(2)));
typedef float f32x4 __attribute__((ext_vector_type(4)));
typedef float f32x16 __attribute__((ext_vector_type(16)));
typedef short bf16x8 __attribute__((ext_vector_type(8)));
typedef short s16x4 __attribute__((ext_vector_type(4)));
#define GAS __attribute__((address_space(1)))

constexpr int NWAVES = 8, NTHR = 512;
constexpr int NB = 4, SEQ = 8192, CTX = 256, TB = SEQ + CTX, MTOK = NB * TB, DM = 2048, DFF = 8192, DIN = 3664, DINP = 3840, DEPTH = 4;
constexpr int ZQ = 0, ZKV = 512, ZR = 768, ZSQ = 832, ZSK = 1856, ZSV = 1984, ZMQ = 2112, ZMK = 2368, ZMV = 2624, ZMG = 3136, ZMO = 3152;
constexpr int NSTEP = 132;
constexpr float NORM_EPS = 1e-6f;
constexpr float LOG2E = 1.4426950408889634f;

constexpr size_t MiB = 1u << 20;
constexpr size_t WS_CTL = 0, CTL_ZERO_BYTES = 1 * MiB;
constexpr size_t WS_MOD = 1 * MiB, WS_WIN = 2 * MiB, WS_WUQ = 17 * MiB, WS_WUKV = 18 * MiB, WS_WOUT = 19 * MiB, WS_W1 = 27 * MiB, WS_W2 = 59 * MiB;
constexpr size_t WS_X = 91 * MiB, WS_H = 355 * MiB, WS_GATES = 487 * MiB, WS_DC = 490 * MiB, WS_DN = 622 * MiB, WS_SC = 624 * MiB, WS_BIG = 625 * MiB;
constexpr size_t BG_Z = 0, BG_ZQN = 248 * MiB, BG_ZKVN = 281 * MiB, BG_KR = 298 * MiB, BG_QM = 303 * MiB, BG_KVM = 353 * MiB, BG_Y = 419 * MiB, BG_END = 551 * MiB;
constexpr size_t WS_SLAB = WS_BIG + BG_END;
constexpr size_t WS_STAT = WS_SLAB + 64 * MiB;
constexpr size_t WS_RS2 = WS_STAT + 5 * MiB;
constexpr size_t WS_BIASF = WS_RS2 + 2304 * 1024;
constexpr size_t WS_WSET1 = WS_STAT + 8 * MiB;
constexpr size_t WSET_BYTES = 89 * MiB;
constexpr size_t WS_END = WS_WSET1 + WSET_BYTES;
constexpr int BIASW = DINP + DFF;
static_assert((size_t)MTOK * DM * 4 == 264 * MiB && (size_t)MTOK * DFF * 2 <= BG_END && (size_t)MTOK * DINP * 2 <= BG_ZQN, "ws map");
constexpr int CW_BAR = 4096;

constexpr int RING_BYTES = 131072, LDSCTL_OFF = 138240  , MISC_OFF = LDSCTL_OFF + 320, LDS_BYTES = 147456;

#define LDS_WAIT() asm volatile("s_waitcnt lgkmcnt(0)" ::: "memory")
__device__ __forceinline__ float bf2f(unsigned h) { return __uint_as_float(h << 16); }
__device__ __forceinline__ unsigned pk2(float lo, float hi) { return pg8::pkbf(lo, hi); }
__device__ __forceinline__ float wave_sum(float v) {
#pragma unroll
    for (int o = 1; o < 64; o <<= 1) v += __shfl_xor(v, o);
    return v;
}
__device__ __forceinline__ float wave_max(float v) {
#pragma unroll
    for (int o = 1; o < 64; o <<= 1) v = fmaxf(v, __shfl_xor(v, o));
    return v;
}
__device__ __forceinline__ float fexp2(float x) { return __builtin_amdgcn_exp2f(x); }
__device__ __forceinline__ float fexp(float x) { return __builtin_amdgcn_exp2f(x * LOG2E); }
__device__ __forceinline__ float sigmoidf_(float x) { return 1.f / (1.f + fexp(-x)); }
__device__ __forceinline__ float sigmoid_fast(float x) { return __builtin_amdgcn_rcpf(1.f + fexp(-x)); }
__device__ __forceinline__ float row16_sum(float v) {
    v += __int_as_float(__builtin_amdgcn_mov_dpp(__float_as_int(v), 0xB1, 0xf, 0xf, true));
    v += __int_as_float(__builtin_amdgcn_mov_dpp(__float_as_int(v), 0x4E, 0xf, 0xf, true));
    v += __int_as_float(__builtin_amdgcn_mov_dpp(__float_as_int(v), 0x124, 0xf, 0xf, true));
    v += __int_as_float(__builtin_amdgcn_mov_dpp(__float_as_int(v), 0x128, 0xf, 0xf, true));
    return v;
}
__device__ __forceinline__ float logsigf_(float x) { return fminf(x, 0.f) - log1pf(expf(-fabsf(x))); }
__device__ __forceinline__ float logsig_fast(float x) { return fminf(x, 0.f) - 0.6931471805599453f * __builtin_amdgcn_logf(1.f + fexp(-fabsf(x))); }
__device__ __forceinline__ void rope_cs(int pos, int i, float& c, float& s) {
    const float inv = fexp2(-0.8304820237218406f * (float)i);
    float rev = (float)pos * inv * 0.15915494309189535f; rev -= floorf(rev);
    c = __builtin_amdgcn_cosf(rev); s = __builtin_amdgcn_sinf(rev);
}

__device__ __forceinline__ void phase_mod(const float* c, const float* c_ctx, const float* w_mod, const float* b_mod, float* MOD, LAS unsigned char* L, int wg, int G, int tid) {
    LAS float* sv = (LAS float*)L;
    LAS float* red = (LAS float*)(L + 40960);
    for (int i = tid; i < 5 * DM; i += NTHR) { const int b = i / DM, k = i - b * DM; const float v = b < 4 ? c[b * DM + k] : c_ctx[k]; sv[i] = v / (1.f + expf(-v)); }
    __syncthreads();
    const int wave = tid >> 6, lane = tid & 63, fr = lane & 15, fq = lane >> 4;
    LAS float* red4 = (LAS float*)(L + 40960);
    for (int item = wg; item < DEPTH * 192; item += G) {
        const int l = item / 192, cg = item - l * 192;
        const float* W = w_mod + (size_t)l * DM * 12288 + cg * 64 + 4 * fr;
        f32x4 a0 = {0.f, 0.f, 0.f, 0.f}, a1 = a0, a2 = a0, a3 = a0, a4 = a0;
        const int k0 = wave * 256 + fq;
#pragma unroll 8
        for (int k = k0; k < k0 + 256; k += 4) { const f32x4 w = *(const f32x4*)(W + (size_t)k * 12288);
            a0 = a0 + w * sv[k]; a1 = a1 + w * sv[DM + k]; a2 = a2 + w * sv[2 * DM + k]; a3 = a3 + w * sv[3 * DM + k]; a4 = a4 + w * sv[4 * DM + k]; }
        { LAS float* rp = red4 + ((wave * 4 + fq) * 5) * 64 + 4 * fr;
          *(LAS f32x4*)rp = a0; *(LAS f32x4*)(rp + 64) = a1; *(LAS f32x4*)(rp + 128) = a2; *(LAS f32x4*)(rp + 192) = a3; *(LAS f32x4*)(rp + 256) = a4; }
        __syncthreads();
        if (tid < 320) { const int b = tid >> 6, ln = tid & 63; float s = 0.f;
#pragma unroll
            for (int w = 0; w < 32; ++w) s += red4[(w * 5 + b) * 64 + ln];
            MOD[(size_t)(l * 5 + b) * 12288 + cg * 64 + ln] = s + b_mod[l * 12288 + cg * 64 + ln]; }
        __syncthreads();
    }
}

__device__ __forceinline__ void transpose_item(const float* W, int K, int N, int NP, bf16* WT, LAS float* scr, int item, int lane, const LAS float* tab, long long* bias, int ldb, const float* kscale = nullptr) {
    const int nblk = NP / 32, kb = item / nblk, nb = item - kb * nblk, k0 = 64 * kb, n0 = 32 * nb;
    const int n = n0 + (lane & 31); const bool okn = n < N;
    float wv_[32];
    const float* wp = W + (size_t)(k0 + (lane >> 5)) * N + (okn ? n : 0);
#pragma unroll
    for (int i = 0; i < 32; ++i) wv_[i] = wp[(size_t)(2 * i) * N];
#pragma unroll
    for (int i = 0; i < 32; ++i) { if (!okn) wv_[i] = 0.f; if (kscale != nullptr) wv_[i] *= kscale[k0 + 2 * i + (lane >> 5)]; scr[(2 * i + (lane >> 5)) * 33 + (lane & 31)] = wv_[i]; }
    if (tab != nullptr) {
        const LAS float* tp = tab + k0 + (lane >> 5);
#pragma unroll
        for (int bp = 0; bp < 5; ++bp) { float s = 0.f;
#pragma unroll
            for (int i = 0; i < 32; ++i) s += tp[bp * 2048 + 2 * i] * wv_[i];
            s += __shfl_xor(s, 32);
            if (lane < 32) atomicAdd((unsigned long long*)(bias + (size_t)bp * ldb + n), (unsigned long long)(long long)(s * 4294967296.f)); }
    }
    LDS_WAIT(); asm volatile("" ::: "memory");
    const int c = lane & 7;
#pragma unroll
    for (int j = 0; j < 4; ++j) { const int nn = (lane >> 3) + 8 * j; const LAS float* s = scr + (8 * c) * 33 + nn;
        v4u o; o.x = pk2(s[0 * 33], s[1 * 33]); o.y = pk2(s[2 * 33], s[3 * 33]); o.z = pk2(s[4 * 33], s[5 * 33]); o.w = pk2(s[6 * 33], s[7 * 33]);
        *(v4u*)(WT + (size_t)(n0 + nn) * K + k0 + 8 * c) = o; }
    LDS_WAIT(); asm volatile("" ::: "memory");
}
struct ConvSrc { const float *w_in, *w_uq, *w_ukv, *w_out, *w1, *w2, *g_q, *g_kv; };
struct ConvDst { bf16 *win, *wuq, *wukv, *wout, *w1, *w2; };
constexpr int CV_I1 = (DM / 64) * (DFF / 32), CV_I2 = (DFF / 64) * (DM / 32), CV_IOUT = (DM / 64) * (DM / 32), CV_IIN = (DM / 64) * (DINP / 32), CV_IUQ = (512 / 64) * (768 / 32), CV_IUKV = (256 / 64) * (1024 / 32);
constexpr int CV_A_SPLIT = 4352, CV_B_SPLIT = 6400;
__device__ __forceinline__ void conv_load_tab(LAS float* tab, const float* modl, int which  , int tid) {
    __syncthreads();
    for (int i = tid; i < 5 * DM; i += NTHR) { const int bp = i / DM, k = i - bp * DM; tab[i] = modl[(size_t)bp * 12288 + which * DM + k]; }
    __syncthreads();
}
__device__ __forceinline__ void conv_A(const ConvSrc s, const ConvDst d, int l, int lo, int hi, int worker, int nworkers, LAS float* scr, const LAS float* tab, long long* biasl, int lane) {
    for (int it = lo + worker; it < hi; it += nworkers) transpose_item(s.w1 + (size_t)l * DM * DFF, DM, DFF, DFF, d.w1, scr, it, lane, tab, biasl + DINP, BIASW);
}
__device__ __forceinline__ void conv_B(const ConvSrc s, const ConvDst d, int l, int lo, int hi, int worker, int nworkers, LAS float* scr, int lane) {
    for (int it = lo + worker; it < hi; it += nworkers) transpose_item(s.w2 + (size_t)l * DFF * DM, DFF, DM, DM, d.w2, scr, it, lane, nullptr, nullptr, 0);
}
__device__ __forceinline__ void conv_CD(const ConvSrc s, const ConvDst d, int l, int worker, int nworkers, LAS float* scr, const LAS float* tab, long long* biasl, int lane) {
    for (int it = worker; it < CV_IOUT + CV_IIN + CV_IUQ + CV_IUKV; it += nworkers) {
        int r = it;
        if (r < CV_IIN) { transpose_item(s.w_in + (size_t)l * DM * DIN, DM, DIN, DINP, d.win, scr, r, lane, tab, biasl, BIASW); continue; } r -= CV_IIN;
        if (r < CV_IOUT) { transpose_item(s.w_out + (size_t)l * DM * DM, DM, DM, DM, d.wout, scr, r, lane, nullptr, nullptr, 0); continue; } r -= CV_IOUT;
        if (r < CV_IUQ) { transpose_item(s.w_uq + (size_t)l * 512 * 768, 512, 768, 768, d.wuq, scr, r, lane, nullptr, nullptr, 0, s.g_q + l * 512); continue; } r -= CV_IUQ;
        transpose_item(s.w_ukv + (size_t)l * 256 * 1024, 256, 1024, 1024, d.wukv, scr, r, lane, nullptr, nullptr, 0, s.g_kv + l * 256);
    }
}

__device__ __forceinline__ void phase_first(const float* xin, const float* ctxin, bf16* X, bf16* HX, unsigned long long* rowss, const float* g, const float* modl, int gw, int NGW, int lane) {
    const int rs = (int)(((long long)MTOK * gw) / NGW), re = (int)(((long long)MTOK * (gw + 1)) / NGW);
    f32x4 gm[4][2], cur[4][2], nxt[4][2]; int bpc = -1;
#define PF_LOAD(dst, r_) do { const int b_ = (r_) / TB, p_ = (r_) - b_ * TB; const float* s_ = (p_ < CTX ? ctxin + (size_t)(b_ * CTX + p_) * DM : xin + (size_t)(b_ * SEQ + p_ - CTX) * DM) + 8 * lane; \
        _Pragma("unroll") for (int j = 0; j < 4; ++j) { dst[j][0] = *(const f32x4*)(s_ + 512 * j); dst[j][1] = *(const f32x4*)(s_ + 512 * j + 4); } } while (0)
    if (rs < re) PF_LOAD(cur, rs);
    for (int r = rs; r < re; ++r) {
        if (r + 1 < re) PF_LOAD(nxt, r + 1);
        const int b = r / TB, p = r - b * TB, bp = p < CTX ? 4 : b;
        if (bp != bpc) { bpc = bp; const float* gp = g + 8 * lane; const float* scp = modl + (size_t)bp * 12288 + DM + 8 * lane;
#pragma unroll
            for (int j = 0; j < 4; ++j)
#pragma unroll
                for (int h = 0; h < 2; ++h) gm[j][h] = *(const f32x4*)(gp + 512 * j + 4 * h) * (*(const f32x4*)(scp + 512 * j + 4 * h) + 1.f); }
        float ss = 0.f;
#pragma unroll
        for (int j = 0; j < 4; ++j)
#pragma unroll
            for (int h = 0; h < 2; ++h) { const f32x4 v = cur[j][h]; ss += (v.x * v.x + v.y * v.y) + (v.z * v.z + v.w * v.w); }
        ss = wave_sum(ss); if (lane == 0) rowss[r] = (unsigned long long)(ss * 16777216.f);
        bf16* xo = X + (size_t)r * DM + 8 * lane; bf16* ho = HX + (size_t)r * DM + 8 * lane;
#pragma unroll
        for (int j = 0; j < 4; ++j) { const f32x4 v0 = cur[j][0], v1 = cur[j][1], h0 = v0 * gm[j][0], h1 = v1 * gm[j][1];
            *(v4u*)(xo + 512 * j) = (v4u){pk2(v0.x, v0.y), pk2(v0.z, v0.w), pk2(v1.x, v1.y), pk2(v1.z, v1.w)};
            *(v4u*)(ho + 512 * j) = (v4u){pk2(h0.x, h0.y), pk2(h0.z, h0.w), pk2(h1.x, h1.y), pk2(h1.z, h1.w)}; }
#pragma unroll
        for (int j = 0; j < 4; ++j) { cur[j][0] = nxt[j][0]; cur[j][1] = nxt[j][1]; }
    }
#undef PF_LOAD
}
__device__ __forceinline__ void phase_ctxfix(bf16* X, bf16* HX, unsigned long long* rowss, const float* slab, const float* fixgate, const float* g, const float* nsc, int gw, int NGW, int lane) {
    for (int it = gw; it < NB * CTX * 4; it += NGW) {
        const int cr = it >> 2, col = 512 * (it & 3) + 8 * lane;
        const int b = cr / CTX, p = cr - b * CTX; const size_t r = (size_t)b * TB + p;
        const float* sp = slab + (size_t)cr * DM + col;
        f32x4 a0 = *(const f32x4*)sp, a1 = *(const f32x4*)(sp + 4);
#pragma unroll
        for (int s2 = 1; s2 < 8; ++s2) { a0 = a0 + *(const f32x4*)(sp + (size_t)s2 * 1024 * DM); a1 = a1 + *(const f32x4*)(sp + (size_t)s2 * 1024 * DM + 4); }
        const v4u xw = *(const v4u*)(X + r * DM + col);
        const f32x4 x0 = {__uint_as_float(xw.x << 16), __uint_as_float(xw.x & 0xffff0000u), __uint_as_float(xw.y << 16), __uint_as_float(xw.y & 0xffff0000u)};
        const f32x4 x1 = {__uint_as_float(xw.z << 16), __uint_as_float(xw.z & 0xffff0000u), __uint_as_float(xw.w << 16), __uint_as_float(xw.w & 0xffff0000u)};
        const f32x4 v0 = x0 + *(const f32x4*)(fixgate + col) * a0, v1 = x1 + *(const f32x4*)(fixgate + col + 4) * a1;
        float ss = ((v0.x * v0.x + v0.y * v0.y) + (v0.z * v0.z + v0.w * v0.w)) + ((v1.x * v1.x + v1.y * v1.y) + (v1.z * v1.z + v1.w * v1.w));
        ss = wave_sum(ss); if (lane == 0) atomicAdd(rowss + r, (unsigned long long)(ss * 16777216.f));
        *(v4u*)(X + r * DM + col) = (v4u){pk2(v0.x, v0.y), pk2(v0.z, v0.w), pk2(v1.x, v1.y), pk2(v1.z, v1.w)};
        const f32x4 h0 = v0 * (*(const f32x4*)(g + col) * (*(const f32x4*)(nsc + col) + 1.f)), h1 = v1 * (*(const f32x4*)(g + col + 4) * (*(const f32x4*)(nsc + col + 4) + 1.f));
        *(v4u*)(HX + r * DM + col) = (v4u){pk2(h0.x, h0.y), pk2(h0.z, h0.w), pk2(h1.x, h1.y), pk2(h1.z, h1.w)};
    }
}
__device__ __forceinline__ void phase_final(const bf16* X, float* out, const float* g, int gw, int NGW, int lane) {
    const int qs = (int)(((long long)NB * SEQ * gw) / NGW), qe = (int)(((long long)NB * SEQ * (gw + 1)) / NGW);
    f32x4 gg[4][2]; v4u cur[4], nxt[4];
#pragma unroll
    for (int j = 0; j < 4; ++j) { gg[j][0] = *(const f32x4*)(g + 512 * j + 8 * lane); gg[j][1] = *(const f32x4*)(g + 512 * j + 8 * lane + 4); }
#define FN_LOAD(dst, q_) do { const int b_ = (q_) / SEQ; const bf16* s_ = X + ((size_t)b_ * TB + CTX + ((q_) - b_ * SEQ)) * DM + 8 * lane; \
        _Pragma("unroll") for (int j = 0; j < 4; ++j) dst[j] = *(const v4u*)(s_ + 512 * j); } while (0)
    if (qs < qe) FN_LOAD(cur, qs);
    for (int q = qs; q < qe; ++q) {
        if (q + 1 < qe) FN_LOAD(nxt, q + 1);
        f32x4 v[4][2]; float ss = 0.f;
#pragma unroll
        for (int j = 0; j < 4; ++j) { const v4u w = cur[j];
            v[j][0] = (f32x4){__uint_as_float(w.x << 16), __uint_as_float(w.x & 0xffff0000u), __uint_as_float(w.y << 16), __uint_as_float(w.y & 0xffff0000u)};
            v[j][1] = (f32x4){__uint_as_float(w.z << 16), __uint_as_float(w.z & 0xffff0000u), __uint_as_float(w.w << 16), __uint_as_float(w.w & 0xffff0000u)};
#pragma unroll
            for (int h = 0; h < 2; ++h) ss += (v[j][h].x * v[j][h].x + v[j][h].y * v[j][h].y) + (v[j][h].z * v[j][h].z + v[j][h].w * v[j][h].w); }
        const float rstd = rsqrtf(wave_sum(ss) * (1.f / DM) + NORM_EPS);
        float* o = out + (size_t)q * DM + 8 * lane;
#pragma unroll
        for (int j = 0; j < 4; ++j)
#pragma unroll
            for (int h = 0; h < 2; ++h) *(f32x4*)(o + 512 * j + 4 * h) = v[j][h] * rstd * gg[j][h];
#pragma unroll
        for (int j = 0; j < 4; ++j) cur[j] = nxt[j];
    }
#undef FN_LOAD
}

__device__ __forceinline__ void rope4(const bf16* src, bf16* dst, int i0, const float (&cr)[4], const float (&sr)[4], const float (&cc)[4], const float (&sc)[4]) {
    const v2u r1 = *(const v2u*)(src + i0), r2 = *(const v2u*)(src + 16 + i0), r3 = *(const v2u*)(src + 32 + i0), r4 = *(const v2u*)(src + 48 + i0);
    float x1[4] = {bf2f(r1.x & 0xffffu), bf2f(r1.x >> 16), bf2f(r1.y & 0xffffu), bf2f(r1.y >> 16)};
    float x2[4] = {bf2f(r2.x & 0xffffu), bf2f(r2.x >> 16), bf2f(r2.y & 0xffffu), bf2f(r2.y >> 16)};
    float x3[4] = {bf2f(r3.x & 0xffffu), bf2f(r3.x >> 16), bf2f(r3.y & 0xffffu), bf2f(r3.y >> 16)};
    float x4[4] = {bf2f(r4.x & 0xffffu), bf2f(r4.x >> 16), bf2f(r4.y & 0xffffu), bf2f(r4.y >> 16)};
    float o1[4], o2[4], o3[4], o4[4];
#pragma unroll
    for (int e = 0; e < 4; ++e) { o1[e] = x1[e] * cr[e] - x2[e] * sr[e]; o2[e] = x2[e] * cr[e] + x1[e] * sr[e]; o3[e] = x3[e] * cc[e] - x4[e] * sc[e]; o4[e] = x4[e] * cc[e] + x3[e] * sc[e]; }
    *(v2u*)(dst + i0) = (v2u){pk2(o1[0], o1[1]), pk2(o1[2], o1[3])}; *(v2u*)(dst + 16 + i0) = (v2u){pk2(o2[0], o2[1]), pk2(o2[2], o2[3])};
    *(v2u*)(dst + 32 + i0) = (v2u){pk2(o3[0], o3[1]), pk2(o3[2], o3[3])}; *(v2u*)(dst + 48 + i0) = (v2u){pk2(o4[0], o4[1]), pk2(o4[2], o4[3])};
}
__device__ __forceinline__ void phase_e1(bf16* Z, bf16* KR, int wg, int G, int wave, int lane, bool do_rope = true) {
    const int n5 = (NB * 4 * NSTEP / 2) % G, tot5 = 4 * n5 + 5 * (G - n5);
    const int c0 = wg < n5 ? 4 * wg : 4 * n5 + 5 * (wg - n5), c1 = wg + 1 < n5 ? 4 * (wg + 1) : 4 * n5 + 5 * (wg + 1 - n5);
    const int rs = (int)(((long long)MTOK * c0) / tot5), re = (int)(((long long)MTOK * c1) / tot5);
    const int j8 = lane & 7;
    v4u cur[3], nxt[3];
#define E1_LOAD(dst, r_) do { const bf16* z_ = Z + (size_t)(r_) * DINP + ZR + 8 * lane; dst[0] = *(const v4u*)z_; dst[1] = *(const v4u*)(z_ + 512); dst[2] = *(const v4u*)(z_ + (lane < 24 ? 1024 : 0)); } while (0)
    if (rs + wave < re) E1_LOAD(cur, rs + wave);
    for (int r = rs + wave; r < re; r += NWAVES) {
        if (r + NWAVES < re) E1_LOAD(nxt, r + NWAVES);
        const int b = r / TB, t = r - b * TB - CTX; const bool latent = t >= 0 && do_rope;
        bf16* z = Z + (size_t)r * DINP + ZR + 8 * lane; bf16* d0 = lane < 8 ? KR + (size_t)r * 64 + 8 * lane : z;
        if (latent) {
            const int pos = j8 < 4 ? (t >> 6) : (t & 63);
            float c[8], sg[8];
#pragma unroll
            for (int e = 0; e < 8; ++e) { float s_; rope_cs(pos, 8 * (j8 & 1) + e, c[e], s_); sg[e] = (j8 & 2) ? s_ : -s_; }
#pragma unroll
            for (int ps = 0; ps < 3; ++ps) { v4u o;
#pragma unroll
                for (int d = 0; d < 4; ++d) { const unsigned own = cur[ps][d], oth = (unsigned)__builtin_amdgcn_mov_dpp((int)own, 0x4E, 0xf, 0xf, true);
                    o[d] = pk2(bf2f(own & 0xffffu) * c[2 * d] + bf2f(oth & 0xffffu) * sg[2 * d], bf2f(own >> 16) * c[2 * d + 1] + bf2f(oth >> 16) * sg[2 * d + 1]); }
                if (ps == 0) *(v4u*)d0 = o; else if (ps == 1) *(v4u*)(z + 512) = o; else if (lane < 24) *(v4u*)(z + 1024) = o; }
        } else {
            if (lane < 8) *(v4u*)d0 = cur[0];
        }
#pragma unroll
        for (int ps = 0; ps < 3; ++ps) cur[ps] = nxt[ps];
    }
#undef E1_LOAD
}

#define MFMA16(a, b, c) __builtin_amdgcn_mfma_f32_16x16x32_bf16((a), (b), (c), 0, 0, 0)
__device__ __forceinline__ bf16x8 gather8(LAS const unsigned char* base, int stride) {
    bf16x8 r;
#pragma unroll
    for (int j = 0; j < 8; ++j) r[j] = *(LAS const short*)(base + j * stride);
    return r;
}
__device__ __forceinline__ bf16x8 colfrag8(LAS const unsigned char* tile, int row0, int col0, int stride, int lane) {
    typedef short v4i16_ __attribute__((ext_vector_type(4)));
    LAS const unsigned char* p = tile + (row0 + 8 * (lane >> 4) + ((lane & 15) >> 2)) * stride + (col0 + 4 * (lane & 3)) * 2;
    const s16x4 lo = __builtin_bit_cast(s16x4, __builtin_amdgcn_ds_read_tr16_b64_v4i16((LAS v4i16_*)p));
    const s16x4 hi = __builtin_bit_cast(s16x4, __builtin_amdgcn_ds_read_tr16_b64_v4i16((LAS v4i16_*)(p + 4 * stride)));
    return __builtin_shufflevector(lo, hi, 0, 1, 2, 3, 4, 5, 6, 7);
}
__device__ __forceinline__ void chain_step_rows(int dir, int i, int& seg, int& c) { seg = i >= 4; const int ii = seg ? i - 4 : i; c = dir == 0 ? ii : (seg ? 127 - ii : 3 - ii); }
__device__ __forceinline__ float scan_sum(float v, int dir, int lane) {
#pragma unroll
    for (int o = 1; o < 64; o <<= 1) { const float t = dir == 0 ? __shfl_up(v, o) : __shfl_down(v, o); const bool ok = dir == 0 ? (lane >= o) : (lane + o < 64); if (ok) v += t; }
    return v;
}
__device__ __forceinline__ float scan_max(float v, int dir, int lane) {
#pragma unroll
    for (int o = 1; o < 64; o <<= 1) { const float t = dir == 0 ? __shfl_up(v, o) : __shfl_down(v, o); const bool ok = dir == 0 ? (lane >= o) : (lane + o < 64); if (ok) v = fmaxf(v, t); }
    return v;
}

__device__ __forceinline__ void mlstm_a(const bf16* Z, const float* GATES, const float* gbias  , bf16* DC, float* DN, float* SC, LAS unsigned char* L, int wg, int G, int tid) {
    const int wave = tid >> 6, lane = tid & 63, fr = lane & 15, fq = lane >> 4, half = wave >> 2, w4 = wave & 3, t256 = tid & 255;
    LAS unsigned char* kt = L + half * 36864;
    LAS unsigned char* vt = kt + 18432;
    LAS float* wv = (LAS float*)(kt + 35840);
    constexpr int NP = NB * 4 * NSTEP / 2;
    for (int pair = wg; pair < NP; pair += G) {
        const int item = 2 * pair + half;
        const int b = item / (4 * NSTEP), h = (item / NSTEP) & 3, cc0 = item % NSTEP, seg = cc0 >= 4, c = seg ? cc0 - 4 : cc0;
        const int row0 = b * TB + (seg ? CTX : 0) + 64 * c;
        const int step0 = seg ? 4 + c : c, step1 = seg ? 4 + 127 - c : 3 - c;
        if (w4 < 2) {
            const int dir = w4; const size_t sidx = (size_t)((b * 4 + h) * 2 + dir) * NSTEP + (dir == 0 ? step0 : step1);
            const size_t row = (size_t)(row0 + lane);
            const float ip = GATES[row * 16 + (2 * dir) * 4 + h] + gbias[(2 * dir) * 4 + h];
            const float fp = GATES[row * 16 + (2 * dir + 1) * 4 + h] + gbias[(2 * dir + 1) * 4 + h];
            const float bs = scan_sum(logsigf_(fp), dir, lane);
            const float g = __shfl(bs, dir == 0 ? 63 : 0);
            const float a = g - bs + ip, amax = wave_max(a);
            wv[dir * 64 + lane] = expf(a - amax);
            if (lane == 0) { SC[sidx * 4 + 0] = g; SC[sidx * 4 + 1] = amax; }
        }
        v4u kraw[2], vraw[4];
#pragma unroll
        for (int i2 = 0; i2 < 2; ++i2) { const int c2 = t256 + 256 * i2; kraw[i2] = *(const v4u*)(Z + (size_t)(row0 + (c2 >> 3)) * DINP + ZMK + h * 64 + (c2 & 7) * 8); }
#pragma unroll
        for (int i2 = 0; i2 < 4; ++i2) { const int c2 = t256 + 256 * i2; vraw[i2] = *(const v4u*)(Z + (size_t)(row0 + (c2 >> 4)) * DINP + ZMV + h * 128 + (c2 & 15) * 8); }
        __syncthreads();
#pragma unroll
        for (int i2 = 0; i2 < 2; ++i2) { const int c2 = t256 + 256 * i2, krow_ = c2 >> 3, kcc_ = c2 & 7;
#pragma unroll
            for (int dir = 0; dir < 2; ++dir) { const float w = wv[dir * 64 + krow_]; v4u o;
#pragma unroll
                for (int e = 0; e < 4; ++e) o[e] = pk2(bf2f(kraw[i2][e] & 0xffffu) * w, bf2f(kraw[i2][e] >> 16) * w);
                *(LAS v4u*)(kt + dir * 9216 + krow_ * 144 + kcc_ * 16) = o; } }
#pragma unroll
        for (int i2 = 0; i2 < 4; ++i2) { const int c2 = t256 + 256 * i2; *(LAS v4u*)(vt + (c2 >> 4) * 272 + (c2 & 15) * 16) = vraw[i2]; }
        __syncthreads();
        if (w4 < 2) { const int dir = w4; const size_t sidx = (size_t)((b * 4 + h) * 2 + dir) * NSTEP + (dir == 0 ? step0 : step1); float s = 0.f;
#pragma unroll 8
            for (int j = 0; j < 64; ++j) s += bf2f(*(LAS const unsigned short*)(kt + dir * 9216 + j * 144 + lane * 2));
            DN[sidx * 64 + lane] = s; }
        {
            bf16x8 bfr[2][2];
#pragma unroll
            for (int et = 0; et < 2; ++et)
#pragma unroll
                for (int ks = 0; ks < 2; ++ks) bfr[et][ks] = colfrag8(vt, 32 * ks, 16 * (2 * w4 + et), 272, lane);
            const int ecol = 16 * (2 * w4 + (fq & 1)) + 4 * (fq & ~1);
#pragma unroll
            for (int dir = 0; dir < 2; ++dir) {
                bf16* dcp = DC + ((size_t)((b * 4 + h) * 2 + dir) * NSTEP + (dir == 0 ? step0 : step1)) * 8192;
#pragma unroll
                for (int dt = 0; dt < 4; ++dt) { f32x4 acc0 = {0.f, 0.f, 0.f, 0.f}, acc1 = {0.f, 0.f, 0.f, 0.f};
#pragma unroll
                    for (int ks = 0; ks < 2; ++ks) { const bf16x8 af = colfrag8(kt + dir * 9216, 32 * ks, 16 * dt, 144, lane); acc0 = MFMA16(bfr[0][ks], af, acc0); acc1 = MFMA16(bfr[1][ks], af, acc1); }
                    const auto sx = __builtin_amdgcn_permlane16_swap(pk2(acc0[0], acc0[1]), pk2(acc1[0], acc1[1]), false, false);
                    const auto sy = __builtin_amdgcn_permlane16_swap(pk2(acc0[2], acc0[3]), pk2(acc1[2], acc1[3]), false, false);
                    *(v4u*)(dcp + (16 * dt + fr) * 128 + ecol) = (v4u){sx[0], sy[0], sx[1], sy[1]}; } } }
        __syncthreads();
    }
}
__device__ __forceinline__ void mlstm_scan(bf16* DC, float* DN, float* SC, int wg, int G, int tid) {
    for (int unit = wg; unit < 32 * 8; unit += G) {
        const int chain = unit >> 3, slice = unit & 7;
        unsigned* dc = (unsigned*)(DC + (size_t)chain * NSTEP * 8192 + slice * 1024) + tid;
        float* dn = DN + (size_t)chain * NSTEP * 64 + (tid & 63);
        float* sc = SC + (size_t)chain * NSTEP * 4;
        const bool has_n = (slice == 0) && (tid < 64), rec_m = (slice == 0) && (tid == 0);
        float C0 = 0.f, C1 = 0.f, n = 0.f, m = 0.f;
        for (int i = 0; i < NSTEP; i += 12) {
            unsigned v[12]; float nv[12], g[12], am[12];
#pragma unroll
            for (int k = 0; k < 12; ++k) { v[k] = dc[(size_t)(i + k) * 4096]; g[k] = sc[(i + k) * 4]; am[k] = sc[(i + k) * 4 + 1]; nv[k] = has_n ? dn[(i + k) * 64] : 0.f; }
#pragma unroll
            for (int k = 0; k < 12; ++k) {
                const float mn = fmaxf(g[k] + m, am[k]), decay = expf(g[k] + m - mn), grow = expf(am[k] - mn);
                dc[(size_t)(i + k) * 4096] = pk2(C0, C1);
                C0 = decay * C0 + grow * bf2f(v[k] & 0xffffu); C1 = decay * C1 + grow * bf2f(v[k] >> 16);
                if (has_n) { dn[(i + k) * 64] = n; n = decay * n + grow * nv[k]; }
                if (rec_m) sc[(i + k) * 4 + 2] = m;
                m = mn;
            }
        }
    }
}
__device__ __forceinline__ void mlstm_c_phase(int u_first, int G, bool skip_ctx, const bf16* Z, const float* GATES, const float* gbias, const float* gh  , const bf16* DC, const float* DN, const float* SC,
                                              bf16* Y, LAS unsigned char* L, int tid) {
    const int wave = tid >> 6, lane = tid & 63, fr = lane & 15, fq = lane >> 4, dir = wave >> 2, w4 = wave & 3, t256 = tid & 255;
    LAS unsigned char* QS = L;
    LAS unsigned char* KS2 = L + 9216;
    LAS unsigned char* VS2 = L + 18432;
    LAS unsigned char* CS = L + 35840 + dir * 17408;
    LAS unsigned char* SS = L + 70656 + dir * 18432;
    LAS unsigned char* QW = SS + 9216;
    LAS float* HM = (LAS float*)(L + 70656);
    constexpr int HMS = 132;
    LAS float* VEC = (LAS float*)(L + 107520 + dir * 2048);
    LAS float* bq = VEC, *uu = VEC + 64, *iwv = VEC + 128, *emt = VEC + 192, *den = VEC + 256, *nin = VEC + 320;
    constexpr int NU = NB * 4 * NSTEP;
    v4u pq, pk, pv[2], pc[4]; float pig = 0.f, pfp = 0.f, pmin = 0.f, pnin = 0.f;
#define MC_DECODE(U) const int b = (U) / (4 * NSTEP), h = ((U) / NSTEP) & 3, cc0 = (U) % NSTEP, seg = cc0 >= 4, c = seg ? cc0 - 4 : cc0; \
    const int row0 = b * TB + (seg ? CTX : 0) + 64 * c; const int chain = (b * 4 + h) * 2 + dir; \
    const int step = dir == 0 ? (seg ? 4 + c : c) : (seg ? 4 + 127 - c : 3 - c); const size_t sidx = (size_t)chain * NSTEP + step
#define MC_NEXT(U) do { (U) += G; while (skip_ctx && (U) < NU && ((U) % NSTEP) < 4) (U) += G; } while (0)
#define MC_LOAD_A(U) do { MC_DECODE(U); (void)chain; (void)step; { const int row = tid >> 3, ch = tid & 7; const bf16* zr = Z + (size_t)(row0 + row) * DINP + h * 64 + ch * 8; pq = *(const v4u*)(zr + ZMQ); pk = *(const v4u*)(zr + ZMK); } \
        if (w4 == 0) { const size_t row = (size_t)(row0 + lane); pig = GATES[row * 16 + (2 * dir) * 4 + h] + gbias[(2 * dir) * 4 + h]; pfp = GATES[row * 16 + (2 * dir + 1) * 4 + h] + gbias[(2 * dir + 1) * 4 + h]; \
                       pmin = SC[sidx * 4 + 2]; pnin = DN[sidx * 64 + lane]; } } while (0)
#define MC_LOAD_C(U) do { MC_DECODE(U); (void)chain; (void)step; const bf16* cin = DC + sidx * 8192; \
        _Pragma("unroll") for (int i2 = 0; i2 < 2; ++i2) { const int c2 = tid + NTHR * i2; pv[i2] = *(const v4u*)(Z + (size_t)(row0 + (c2 >> 4)) * DINP + ZMV + h * 128 + (c2 & 15) * 8); } \
        _Pragma("unroll") for (int k = 0; k < 4; ++k) { const int c2 = t256 + 256 * k; pc[k] = *(const v4u*)(cin + (c2 >> 4) * 128 + (c2 & 15) * 8); } } while (0)
    int unit = u_first; while (skip_ctx && unit < NU && (unit % NSTEP) < 4) unit += G;
    if (unit < NU) { MC_LOAD_A(unit); MC_LOAD_C(unit); }
    for (; unit < NU; ) {
    int tl_ = tid; asm volatile("" : "+v"(tl_));
    const int wave = tl_ >> 6, lane = tl_ & 63, fr = lane & 15, fq = lane >> 4, dir = wave >> 2, w4 = wave & 3, t256 = tl_ & 255; const int tid = tl_;
    LAS unsigned char* CS = L + 35840 + dir * 17408; LAS unsigned char* SS = L + 70656 + dir * 18432; LAS unsigned char* QW = SS + 9216;
    LAS float* VEC = (LAS float*)(L + 107520 + dir * 2048); LAS float* bq = VEC, *uu = VEC + 64, *iwv = VEC + 128, *emt = VEC + 192, *den = VEC + 256, *nin = VEC + 320;
    MC_DECODE(unit); (void)chain; (void)step; (void)sidx;
    { const int row = tid >> 3, ch = tid & 7; v4u o;
#pragma unroll
      for (int e = 0; e < 4; ++e) o[e] = pk2(bf2f(pq[e] & 0xffffu) * 0.125f, bf2f(pq[e] >> 16) * 0.125f);
      *(LAS v4u*)(QS + row * 144 + ch * 16) = o;
      *(LAS v4u*)(KS2 + row * 144 + ch * 16) = pk; }
#pragma unroll
    for (int i2 = 0; i2 < 2; ++i2) { const int c2 = tid + NTHR * i2; *(LAS v4u*)(VS2 + (c2 >> 4) * 272 + (c2 & 15) * 16) = pv[i2]; }
#pragma unroll
    for (int k = 0; k < 4; ++k) { const int c2 = t256 + 256 * k; *(LAS v4u*)(CS + (c2 >> 4) * 272 + (c2 & 15) * 16) = pc[k]; }
    if (w4 == 0) {
        const float bs = scan_sum(logsigf_(pfp), dir, lane);
        const float u = pig - bs, pm = scan_max(u, dir, lane), m_in = pmin;
        const float mt = bs + fmaxf(m_in, pm);
        bq[lane] = bs - mt; uu[lane] = u; iwv[lane] = fexp(bs + m_in - mt); emt[lane] = fexp(-mt); nin[lane] = pnin;
    }
    __syncthreads();
    int unext = unit; MC_NEXT(unext);
    if (unext < NU) MC_LOAD_A(unext);
    v4u zo[2]; f32x4 ghv[2];
    { const int c8 = 8 * (lane & 15); const bf16* zp = Z + (size_t)(row0 + 8 * wave + (lane >> 4)) * DINP + ZMO + h * 128 + c8;
      zo[0] = *(const v4u*)zp; zo[1] = *(const v4u*)(zp + (size_t)4 * DINP); ghv[0] = *(const f32x4*)(gh + h * 128 + c8); ghv[1] = *(const f32x4*)(gh + h * 128 + c8 + 4); }
#pragma unroll
    for (int k = 0; k < 2; ++k) { const int c2 = t256 + 256 * k, row = c2 >> 3, ch = c2 & 7; const v4u rq = *(LAS const v4u*)(QS + row * 144 + ch * 16); const float w = iwv[row]; v4u o;
#pragma unroll
        for (int e = 0; e < 4; ++e) o[e] = pk2(bf2f(rq[e] & 0xffffu) * w, bf2f(rq[e] >> 16) * w);
        *(LAS v4u*)(QW + row * 144 + ch * 16) = o; }
    {
      const int lrow = 16 * w4 + fr; const float bql = bq[lrow]; float rsum = 0.f;
      bf16x8 qf[2];
#pragma unroll
      for (int ks = 0; ks < 2; ++ks) qf[ks] = *(LAS const bf16x8*)(QS + lrow * 144 + (32 * ks + 8 * fq) * 2);
#pragma unroll
      for (int st = 0; st < 4; ++st) { f32x4 acc = {0.f, 0.f, 0.f, 0.f};
#pragma unroll
          for (int ks = 0; ks < 2; ++ks) { const bf16x8 kf = *(LAS const bf16x8*)(KS2 + (16 * st + fr) * 144 + (32 * ks + 8 * fq) * 2); acc = MFMA16(kf, qf[ks], acc); }
          const f32x4 us4 = *(LAS const f32x4*)(uu + 16 * st + 4 * fq); float val[4];
#pragma unroll
          for (int rg = 0; rg < 4; ++rg) { const int scol = 16 * st + 4 * fq + rg; const bool valid = dir == 0 ? (scol <= lrow) : (scol >= lrow);
              val[rg] = valid ? acc[rg] * fexp(bql + us4[rg]) : 0.f; rsum += val[rg]; }
          *(LAS v2u*)(SS + lrow * 144 + (16 * st + 4 * fq) * 2) = (v2u){pk2(val[0], val[1]), pk2(val[2], val[3])}; }
      float dq = 0.f;
#pragma unroll
      for (int k2 = 0; k2 < 2; ++k2) { const v4u rq = *(LAS const v4u*)(QS + lrow * 144 + (16 * fq + 8 * k2) * 2); const f32x4 n0 = *(LAS const f32x4*)(nin + 16 * fq + 8 * k2), n1 = *(LAS const f32x4*)(nin + 16 * fq + 8 * k2 + 4);
          dq += (bf2f(rq.x & 0xffffu) * n0.x + bf2f(rq.x >> 16) * n0.y) + (bf2f(rq.y & 0xffffu) * n0.z + bf2f(rq.y >> 16) * n0.w) + (bf2f(rq.z & 0xffffu) * n1.x + bf2f(rq.z >> 16) * n1.y) + (bf2f(rq.w & 0xffffu) * n1.z + bf2f(rq.w >> 16) * n1.w); }
      float rs = rsum + iwv[lrow] * dq;
      { const auto r1 = __builtin_amdgcn_permlane16_swap(__float_as_uint(rs), __float_as_uint(rs), false, false); rs = __uint_as_float(r1[0]) + __uint_as_float(r1[1]);
        const auto r2 = __builtin_amdgcn_permlane32_swap(__float_as_uint(rs), __float_as_uint(rs), false, false); rs = __uint_as_float(r2[0]) + __uint_as_float(r2[1]); }
      if (fq == 0) den[lrow] = rs; }
    __syncthreads();
    f32x4 acc[2][4];
#pragma unroll
    for (int et = 0; et < 2; ++et) { bf16x8 bv[2], bc[2];
#pragma unroll
        for (int ks = 0; ks < 2; ++ks) { bv[ks] = colfrag8(VS2, 32 * ks, 16 * (2 * w4 + et), 272, lane); bc[ks] = colfrag8(CS, 32 * ks, 16 * (2 * w4 + et), 272, lane); }
#pragma unroll
        for (int lt = 0; lt < 4; ++lt) { acc[et][lt] = (f32x4){0.f, 0.f, 0.f, 0.f};
#pragma unroll
            for (int ks = 0; ks < 2; ++ks) { const bf16x8 a1 = *(LAS const bf16x8*)(SS + (16 * lt + fr) * 144 + (32 * ks + 8 * fq) * 2); acc[et][lt] = MFMA16(bv[ks], a1, acc[et][lt]); }
#pragma unroll
            for (int ks = 0; ks < 2; ++ks) { const bf16x8 a2 = *(LAS const bf16x8*)(QW + (16 * lt + fr) * 144 + (32 * ks + 8 * fq) * 2); acc[et][lt] = MFMA16(bc[ks], a2, acc[et][lt]); } } }
#pragma unroll
    for (int lt = 0; lt < 4; ++lt) { const int lrow = 16 * lt + fr; const float inv = __builtin_amdgcn_rcpf(fmaxf(fabsf(den[lrow]), emt[lrow]));
#pragma unroll
        for (int et = 0; et < 2; ++et) acc[et][lt] = acc[et][lt] * inv; }
    __syncthreads();
    if (dir == 1) {
#pragma unroll
        for (int et = 0; et < 2; ++et)
#pragma unroll
            for (int lt = 0; lt < 4; ++lt) *(LAS f32x4*)(HM + (16 * lt + fr) * HMS + 16 * (2 * w4 + et) + 4 * fq) = acc[et][lt];
    }
    __syncthreads();
    if (dir == 0) {
#pragma unroll
        for (int et = 0; et < 2; ++et)
#pragma unroll
            for (int lt = 0; lt < 4; ++lt) { LAS f32x4* hp = (LAS f32x4*)(HM + (16 * lt + fr) * HMS + 16 * (2 * w4 + et) + 4 * fq); *hp = *hp + acc[et][lt]; }
    }
    __syncthreads();
    if (unext < NU) MC_LOAD_C(unext);
#pragma unroll
    for (int ps = 0; ps < 2; ++ps) { const int lrow = 8 * wave + 4 * ps + (lane >> 4), c8 = 8 * (lane & 15);
        const f32x4 va = *(LAS const f32x4*)(HM + lrow * HMS + c8), vb = *(LAS const f32x4*)(HM + lrow * HMS + c8 + 4);
        const float rstd = rsqrtf(row16_sum((va.x * va.x + va.y * va.y) + (va.z * va.z + va.w * va.w) + (vb.x * vb.x + vb.y * vb.y) + (vb.z * vb.z + vb.w * vb.w)) * (1.f / 128.f) + NORM_EPS);
        const v4u z = zo[ps]; const f32x4 ga = ghv[0] * rstd, gb = ghv[1] * rstd;
        v4u o; o.x = pk2(va.x * ga.x * sigmoid_fast(bf2f(z.x & 0xffffu)), va.y * ga.y * sigmoid_fast(bf2f(z.x >> 16))); o.y = pk2(va.z * ga.z * sigmoid_fast(bf2f(z.y & 0xffffu)), va.w * ga.w * sigmoid_fast(bf2f(z.y >> 16)));
        o.z = pk2(vb.x * gb.x * sigmoid_fast(bf2f(z.z & 0xffffu)), vb.y * gb.y * sigmoid_fast(bf2f(z.z >> 16))); o.w = pk2(vb.z * gb.z * sigmoid_fast(bf2f(z.w & 0xffffu)), vb.w * gb.w * sigmoid_fast(bf2f(z.w >> 16)));
        *(v4u*)(Y + (size_t)(row0 + lrow) * DM + 1536 + h * 128 + c8) = o; }
    unit = unext;
    }
#undef MC_DECODE
#undef MC_NEXT
#undef MC_LOAD_A
#undef MC_LOAD_C
}

#define MFMA32(a, b, c) __builtin_amdgcn_mfma_f32_32x32x16_bf16((a), (b), (c), 0, 0, 0)
typedef short v4i16_t __attribute__((ext_vector_type(4)));
__device__ __forceinline__ s16x4 tr_read(LAS const unsigned char* p) { return __builtin_bit_cast(s16x4, __builtin_amdgcn_ds_read_tr16_b64_v4i16((LAS v4i16_t*)p)); }
constexpr float ATT_THR = 8.f;
#define SCHED_FENCE() __builtin_amdgcn_sched_barrier(0)
constexpr int NO_MASK = 0x40000000;
template <int DQK, int KSB>
__device__ __forceinline__ void attn_scores(LAS const unsigned char* Kt, const bf16x8 (&qf)[DQK / 16], f32x16 (&p)[2], int r32, int hi) {
    constexpr int NK = DQK / 16;
    LAS const unsigned char* kp = Kt + r32 * KSB + hi * 16;
    f32x16 p0, p1;
#pragma unroll
    for (int e = 0; e < 16; ++e) { p0[e] = 0.f; p1[e] = 0.f; }
    bf16x8 kr[3][2];
#define QK_LOAD(ks) do { kr[(ks) % 3][0] = *(LAS const bf16x8*)(kp + (ks) * 32); kr[(ks) % 3][1] = *(LAS const bf16x8*)(kp + 32 * KSB + (ks) * 32); } while (0)
    QK_LOAD(0); QK_LOAD(1); SCHED_FENCE();
#pragma unroll
    for (int ks = 0; ks < NK; ++ks) {
        if (ks + 2 < NK) QK_LOAD(ks + 2);
        p0 = MFMA32(kr[ks % 3][0], qf[ks], p0); p1 = MFMA32(kr[ks % 3][1], qf[ks], p1); SCHED_FENCE();
    }
#undef QK_LOAD
    p[0] = p0; p[1] = p1;
}
template <int DV, bool MASK>
__device__ __forceinline__ void attn_softmax(f32x16 (&p)[2], f32x16 (&o)[DV / 32], float& m, float& l, float cs, int hi, int dq) {
    if (MASK) { if (__builtin_amdgcn_readfirstlane(dq) != NO_MASK) {
#pragma unroll
        for (int kvb = 0; kvb < 2; ++kvb)
#pragma unroll
            for (int e = 0; e < 16; ++e) { const int rel = dq + 32 * kvb + (e & 3) + 8 * (e >> 2) + 4 * hi; if (rel > 128 || rel < -128) p[kvb][e] = -INFINITY; } } }
    float mx;
    {
        float a0 = fmaxf(fmaxf(p[0][0], p[0][1]), p[0][2]), a1 = fmaxf(fmaxf(p[0][8], p[0][9]), p[0][10]), a2 = fmaxf(fmaxf(p[1][0], p[1][1]), p[1][2]), a3 = fmaxf(fmaxf(p[1][8], p[1][9]), p[1][10]);
        a0 = fmaxf(fmaxf(a0, p[0][3]), p[0][4]); a1 = fmaxf(fmaxf(a1, p[0][11]), p[0][12]); a2 = fmaxf(fmaxf(a2, p[1][3]), p[1][4]); a3 = fmaxf(fmaxf(a3, p[1][11]), p[1][12]);
        a0 = fmaxf(fmaxf(a0, p[0][5]), p[0][6]); a1 = fmaxf(fmaxf(a1, p[0][13]), p[0][14]); a2 = fmaxf(fmaxf(a2, p[1][5]), p[1][6]); a3 = fmaxf(fmaxf(a3, p[1][13]), p[1][14]);
        a0 = fmaxf(a0, p[0][7]); a1 = fmaxf(a1, p[0][15]); a2 = fmaxf(a2, p[1][7]); a3 = fmaxf(a3, p[1][15]);
        mx = fmaxf(fmaxf(a0, a1), fmaxf(a2, a3));
        const auto rr = __builtin_amdgcn_permlane32_swap(__float_as_uint(mx), __float_as_uint(mx), false, false);
        mx = fmaxf(__uint_as_float(rr[0]), __uint_as_float(rr[1])); }
    const float mn = fmaxf(m, mx * cs);
    if (__any(mn - m > ATT_THR)) {
        const float alpha = fexp2(m - mn); m = mn; l *= alpha;
#pragma unroll
        for (int d = 0; d < DV / 32; ++d)
#pragma unroll
            for (int e = 0; e < 16; ++e) o[d][e] *= alpha;
    }
    float ls0 = 0.f, ls1 = 0.f, ls2 = 0.f, ls3 = 0.f;
#pragma unroll
    for (int kvb = 0; kvb < 2; ++kvb)
#pragma unroll
        for (int e = 0; e < 16; e += 4) {
            const float e0 = fexp2(fmaf(p[kvb][e], cs, -m)), e1 = fexp2(fmaf(p[kvb][e + 1], cs, -m)), e2 = fexp2(fmaf(p[kvb][e + 2], cs, -m)), e3 = fexp2(fmaf(p[kvb][e + 3], cs, -m));
            p[kvb][e] = e0; p[kvb][e + 1] = e1; p[kvb][e + 2] = e2; p[kvb][e + 3] = e3; ls0 += e0; ls1 += e1; ls2 += e2; ls3 += e3; }
    l += (ls0 + ls1) + (ls2 + ls3);
}
template <int DV, int VRB>
__device__ __forceinline__ void attn_pv(LAS const unsigned char* Vt, const f32x16 (&p)[2], f32x16 (&o)[DV / 32], int vtb) {
    constexpr int ND = DV / 32;
    LAS const unsigned char* vb = Vt + vtb;
    bf16x8 pf[4];
#pragma unroll
    for (int i = 0; i < 4; ++i) { const int kvb = i >> 1, s = i & 1;
        v4u pw; pw.x = pk2(p[kvb][8 * s + 0], p[kvb][8 * s + 1]); pw.y = pk2(p[kvb][8 * s + 2], p[kvb][8 * s + 3]); pw.z = pk2(p[kvb][8 * s + 4], p[kvb][8 * s + 5]); pw.w = pk2(p[kvb][8 * s + 6], p[kvb][8 * s + 7]);
        pf[i] = __builtin_bit_cast(bf16x8, pw); }
    s16x4 va[2 * ND], vbq[2 * ND];
#define PV_LOAD(dst, i) do { _Pragma("unroll") for (int d = 0; d < ND; ++d) { LAS const unsigned char* vp = vb + (16 * (i)) * VRB + d * 64; dst[2 * d] = tr_read(vp); dst[2 * d + 1] = tr_read(vp + 8 * VRB); } } while (0)
#define PV_MMA(src, i) do { _Pragma("unroll") for (int d = 0; d < ND; ++d) { const bf16x8 vf = __builtin_shufflevector(src[2 * d], src[2 * d + 1], 0, 1, 2, 3, 4, 5, 6, 7); o[d] = MFMA32(vf, pf[i], o[d]); } } while (0)
    PV_LOAD(va, 0); SCHED_FENCE();
    PV_LOAD(vbq, 1); PV_MMA(va, 0); SCHED_FENCE();
    PV_LOAD(va, 2); PV_MMA(vbq, 1); SCHED_FENCE();
    PV_LOAD(vbq, 3); PV_MMA(va, 2); SCHED_FENCE();
    PV_MMA(vbq, 3); SCHED_FENCE();
#undef PV_LOAD
#undef PV_MMA
}
template <int DQK, int DV, int KSB, int VRB, bool MASK>
__device__ __forceinline__ void attn_tile(LAS const unsigned char* Kt, LAS const unsigned char* Vt, const bf16x8 (&qf)[DQK / 16], f32x16 (&o)[DV / 32], float& m, float& l, float cs, int r32, int hi, int vtb, int dq) {
    __builtin_amdgcn_sched_barrier(0);
    f32x16 p[2];
    attn_scores<DQK, KSB>(Kt, qf, p, r32, hi);
    attn_softmax<DV, MASK>(p, o, m, l, cs, hi, dq);
    attn_pv<DV, VRB>(Vt, p, o, vtb);
}
template <int DV>
__device__ __forceinline__ void attn_store(bf16* yrow  , const f32x16 (&o)[DV / 32], float l, int hi) {
    const float lt = l + __shfl_xor(l, 32), inv = 1.f / lt;
    unsigned char* yb = (unsigned char*)yrow + 16 * hi;
#pragma unroll
    for (int d = 0; d < DV / 32; ++d)
#pragma unroll
        for (int kk = 0; kk < 2; ++kk) {
            unsigned ax = pk2(o[d][8 * kk] * inv, o[d][8 * kk + 1] * inv), ay = pk2(o[d][8 * kk + 2] * inv, o[d][8 * kk + 3] * inv);
            unsigned bx = pk2(o[d][8 * kk + 4] * inv, o[d][8 * kk + 5] * inv), by = pk2(o[d][8 * kk + 6] * inv, o[d][8 * kk + 7] * inv);
            const auto rx = __builtin_amdgcn_permlane32_swap(ax, bx, false, false); const auto ry = __builtin_amdgcn_permlane32_swap(ay, by, false, false);
            *(v4u*)(yb + 64 * d + 32 * kk) = (v4u){rx[0], ry[0], rx[1], ry[1]};
        }
}
constexpr int MLA_KSB = 400, MLA_KT = 64 * MLA_KSB  , MLA_VRB = 320, MLA_VT = 64 * MLA_VRB  , MLA_BUF = MLA_KT + MLA_VT;
__device__ __forceinline__ void mla_unit(const bf16* QM, const bf16* KVM, const bf16* KR, bf16* Y, int b, int h, int qrow0, int ntiles, bool latent, LAS unsigned char* L, int tid_in) {
    int tid = tid_in; asm volatile("" : "+v"(tid));
    const int wave = tid >> 6, lane = tid & 63, r32 = lane & 31, hi = lane >> 5;
    const int qrow = qrow0 + 32 * wave + r32;
    bf16x8 qf[12];
    { const bf16* qp = QM + (size_t)qrow * 768 + h * 192 + 8 * hi;
#pragma unroll
      for (int ks = 0; ks < 12; ++ks) qf[ks] = *(const bf16x8*)(qp + 16 * ks); }
    if (latent) {
        const int t = qrow - b * TB - CTX, prow = t >> 6, pcol = t & 63;
        int hl = hi; asm volatile("" : "+v"(hl));
#pragma unroll
        for (int j = 0; j < 8; ++j) { float cr, sr, cc, sc; rope_cs(prow, 8 * hl + j, cr, sr); rope_cs(pcol, 8 * hl + j, cc, sc);
            const float x1 = bf2f((unsigned short)qf[8][j]), x2 = bf2f((unsigned short)qf[9][j]), x3 = bf2f((unsigned short)qf[10][j]), x4 = bf2f((unsigned short)qf[11][j]);
            qf[8][j] = (short)(pk2(x1 * cr - x2 * sr, 0.f) & 0xffffu); qf[9][j] = (short)(pk2(x2 * cr + x1 * sr, 0.f) & 0xffffu);
            qf[10][j] = (short)(pk2(x3 * cc - x4 * sc, 0.f) & 0xffffu); qf[11][j] = (short)(pk2(x4 * cc + x3 * sc, 0.f) & 0xffffu); }
    }
    f32x16 o[4];
#pragma unroll
    for (int d = 0; d < 4; ++d)
#pragma unroll
        for (int e = 0; e < 16; ++e) o[d][e] = 0.f;
    float m = -INFINITY, l = 0.f;
    const float cs = 0.07216878364870322f * LOG2E;
    const unsigned kgo = (unsigned)(((tid >> 4) * 1024 + (tid & 15) * 8) * 2), klo = (unsigned)((tid >> 4) * MLA_KSB + (tid & 15) * 16);
    const unsigned rgo = (unsigned)(((tid >> 3) * 64 + (tid & 7) * 8) * 2), rlo = (unsigned)((tid >> 3) * MLA_KSB + 256 + (tid & 7) * 16);
    const unsigned vlo = (unsigned)((tid >> 4) * MLA_VRB + (tid & 15) * 16);
    const int vtb = (4 * hi + ((lane & 15) >> 2)) * MLA_VRB + (16 * ((lane >> 4) & 1) + 4 * (lane & 3)) * 2;
    const char* kvb0 = (const char*)(KVM + ((size_t)b * TB) * 1024 + h * 256);
    const char* krb0 = (const char*)(KR + ((size_t)b * TB) * 64);
    v4u kreg[3], vreg[2];
#define MLA_LOAD(t) do { const char* kb_ = kvb0 + (size_t)(t) * (64 * 1024 * 2); const char* rb_ = krb0 + (size_t)(t) * (64 * 64 * 2); \
        kreg[0] = *(const v4u*)(kb_ + kgo); kreg[1] = *(const v4u*)(kb_ + 32 * 1024 * 2 + kgo); kreg[2] = *(const v4u*)(rb_ + rgo); \
        vreg[0] = *(const v4u*)(kb_ + 256 + kgo); vreg[1] = *(const v4u*)(kb_ + 32 * 1024 * 2 + 256 + kgo); } while (0)
#define MLA_STORE(buf) do { LAS unsigned char* Kt_ = L + (buf) * MLA_BUF; LAS unsigned char* Vt_ = Kt_ + MLA_KT; \
        *(LAS v4u*)(Kt_ + klo) = kreg[0]; *(LAS v4u*)(Kt_ + 32 * MLA_KSB + klo) = kreg[1]; *(LAS v4u*)(Kt_ + rlo) = kreg[2]; \
        *(LAS v4u*)(Vt_ + vlo) = vreg[0]; *(LAS v4u*)(Vt_ + 32 * MLA_VRB + vlo) = vreg[1]; } while (0)
    const int half = wave >> 2;
    MLA_LOAD(0); MLA_STORE(0);
    if (ntiles > 1) { MLA_LOAD(1); MLA_STORE(1); }
    __syncthreads();
    if (half) __builtin_amdgcn_s_barrier();
    if (ntiles > 2) MLA_LOAD(2);
    int bcur = 0, bst = 2;
    for (int t = 0; t < ntiles; ++t) {
        LAS const unsigned char* Kt = L + bcur * MLA_BUF;
        f32x16 p[2];
        __builtin_amdgcn_sched_barrier(0);
        attn_scores<192, MLA_KSB>(Kt, qf, p, r32, hi);
        __syncthreads();
        attn_softmax<128, false>(p, o, m, l, cs, hi, 0);
        attn_pv<128, MLA_VRB>(Kt + MLA_KT, p, o, vtb);
        if (t + 2 < ntiles) { MLA_STORE(bst); if (t + 3 < ntiles) MLA_LOAD(t + 3); }
        __syncthreads();
        bcur = bcur == 2 ? 0 : bcur + 1; bst = bst == 2 ? 0 : bst + 1;
    }
    if (!half) __builtin_amdgcn_s_barrier();
#undef MLA_LOAD
#undef MLA_STORE
    attn_store<128>(Y + (size_t)qrow * DM + h * 128, o, l, hi);
}

constexpr int SWA_KSB = 144, SWA_KT = 64 * SWA_KSB  , SWA_VRB = 192, SWA_VT = 64 * SWA_VRB  , SWA_BUF = SWA_KT + SWA_VT;
__device__ __forceinline__ void swa_unit(const bf16* Z, const float* sink  , bf16* Y, int b, int g, int blk, int cblk, LAS unsigned char* L, int tid) {
    const int wave = tid >> 6, lane = tid & 63, r32 = lane & 31, hi = lane >> 5;
    const bool latent = blk >= 0;
    const int head = 8 * g + wave;
    const int qrow0 = b * TB + (latent ? CTX + 64 * blk : 64 * cblk);
    bf16x8 qf[2][4];
#pragma unroll
    for (int sb = 0; sb < 2; ++sb) { const bf16* qp = Z + (size_t)(qrow0 + 32 * sb + r32) * DINP + ZSQ + head * 64 + 8 * hi;
#pragma unroll
        for (int ks = 0; ks < 4; ++ks) qf[sb][ks] = *(const bf16x8*)(qp + 16 * ks); }
    f32x16 o[2][2];
#pragma unroll
    for (int sb = 0; sb < 2; ++sb)
#pragma unroll
        for (int d = 0; d < 2; ++d)
#pragma unroll
            for (int e = 0; e < 16; ++e) o[sb][d][e] = 0.f;
    const float sk = sink[head] * LOG2E;
    float m[2] = {sk, sk}, l[2] = {hi == 0 ? 1.f : 0.f, hi == 0 ? 1.f : 0.f};
    const float cs = 0.125f * LOG2E;
    int wlo = 0, nwin = 0;
    if (latent) { wlo = blk - 2 < 0 ? 0 : blk - 2; const int whi = blk + 2 > 127 ? 127 : blk + 2; nwin = whi - wlo + 1; }
    const int ntiles = 4 + nwin;
    const unsigned kgo = (unsigned)(((tid >> 3) * DINP + ZSK + (tid & 7) * 8) * 2), klo = (unsigned)((tid >> 3) * SWA_KSB + (tid & 7) * 16), vlo = (unsigned)((tid >> 3) * SWA_VRB + (tid & 7) * 16);
    const int vtb = (4 * hi + ((lane & 15) >> 2)) * SWA_VRB + (16 * ((lane >> 4) & 1) + 4 * (lane & 3)) * 2;
    const char* zb0 = (const char*)(Z + ((size_t)b * TB) * DINP + g * 64);
    v4u kreg, vreg;
#define SWA_ROW0(t) ((t) < 4 ? 64 * (t) : CTX + 64 * (wlo + (t) - 4))
#define SWA_LOAD(t) do { const char* zb_ = zb0 + (size_t)SWA_ROW0(t) * (DINP * 2); kreg = *(const v4u*)(zb_ + kgo); vreg = *(const v4u*)(zb_ + (ZSV - ZSK) * 2 + kgo); } while (0)
#define SWA_STORE(buf) do { LAS unsigned char* Kt_ = L + (buf) * SWA_BUF; *(LAS v4u*)(Kt_ + klo) = kreg; *(LAS v4u*)(Kt_ + SWA_KT + vlo) = vreg; } while (0)
    SWA_LOAD(0); SWA_STORE(0);
    __syncthreads();
    for (int t = 0; t < ntiles; ++t) {
        const bool more = t + 1 < ntiles;
        if (more) SWA_LOAD(t + 1);
        LAS const unsigned char* Kt = L + (t & 1) * SWA_BUF;
        const int kpos0 = 64 * (wlo + t - 4);
        const bool edge = t >= 4 && (wlo + t - 4 == blk - 2 || wlo + t - 4 == blk + 2);
#pragma unroll
        for (int sb = 0; sb < 2; ++sb) attn_tile<64, 64, SWA_KSB, SWA_VRB, true>(Kt, Kt + SWA_KT, qf[sb], o[sb], m[sb], l[sb], cs, r32, hi, vtb, edge ? kpos0 - (64 * blk + 32 * sb + r32) : NO_MASK);
        if (more) SWA_STORE((t + 1) & 1);
        __syncthreads();
    }
#undef SWA_ROW0
#undef SWA_LOAD
#undef SWA_STORE
#pragma unroll
    for (int sb = 0; sb < 2; ++sb) attn_store<64>(Y + (size_t)(qrow0 + 32 * sb + r32) * DM + 512 + head * 64, o[sb], l[sb], hi);
}

struct Args { const float* in[20]; float* out; unsigned char* ws; };
enum { IN_X = 0, IN_C, IN_CTX, IN_CCTX, IN_WMOD, IN_BMOD, IN_GN1, IN_GN2, IN_WIN, IN_GQ, IN_WUQ, IN_GKV, IN_WUKV, IN_SINK, IN_GBIAS, IN_GH, IN_WOUT, IN_W1, IN_W2, IN_GFINAL };

__global__ void __launch_bounds__(NTHR, 2) fwd_kernel(Args a) {
    extern __shared__ __attribute__((aligned(16))) unsigned char lds[];
    LAS unsigned char* L = (LAS unsigned char*)lds;
    const int tid0 = threadIdx.x;
    const int G = gridDim.x;
    for (int u = tid0; u < (LDS_BYTES - LDSCTL_OFF) / 4; u += NTHR) ((LAS unsigned*)(L + LDSCTL_OFF))[u] = 0u;
    __syncthreads();
    unsigned char* ws = a.ws;
    XcdBarrier bar = xcd_barrier_post((unsigned*)(ws + WS_CTL) + CW_BAR, (volatile LAS unsigned*)(L + MISC_OFF) + 8);

#define GRID_BAR(id_) do { XcdBarrier b2_ = bar; unsigned xx_ = bar.x; asm volatile("" : "+s"(xx_)); b2_.x = xx_; xcd_barrier(b2_); } while (0)
#define LAUNDER() int tid = tid0; asm volatile("" : "+v"(tid)); int wg = blockIdx.x; asm volatile("" : "+s"(wg)); const int lane = tid & 63, wave = __builtin_amdgcn_readfirstlane(tid >> 6), gw = wg * NWAVES + wave, NGW = G * NWAVES; (void)lane; (void)wave; (void)gw; (void)NGW
    float* MOD = (float*)(ws + WS_MOD);
    constexpr size_t WSET_STRIDE = WS_WSET1 - WS_WIN;
    bf16* X = (bf16*)(ws + WS_X); bf16* H = (bf16*)(ws + WS_H); float* SLAB = (float*)(ws + WS_SLAB);
    float *GATES = (float*)(ws + WS_GATES), *DN = (float*)(ws + WS_DN), *SC = (float*)(ws + WS_SC); bf16* DC = (bf16*)(ws + WS_DC);
    unsigned char* big = ws + WS_BIG;
    bf16 *Z = (bf16*)(big + BG_Z), *ZQN = (bf16*)(big + BG_ZQN), *ZKVN = (bf16*)(big + BG_ZKVN), *KR = (bf16*)(big + BG_KR), *QM = (bf16*)(big + BG_QM), *KVM = (bf16*)(big + BG_KVM), *Y = (bf16*)(big + BG_Y), *ACT = (bf16*)big;
    const ConvSrc csrc{a.in[IN_WIN], a.in[IN_WUQ], a.in[IN_WUKV], a.in[IN_WOUT], a.in[IN_W1], a.in[IN_W2], a.in[IN_GQ], a.in[IN_GKV]};

    unsigned long long* ROWSS = (unsigned long long*)(ws + WS_STAT); long long* BIAS = (long long*)(ws + WS_STAT + 3 * MiB);
    { LAUNDER(); for (int i = wg * NTHR + tid; i < (int)(8 * MiB / 8); i += G * NTHR) ROWSS[i] = 0ull;
      phase_mod(a.in[IN_C], a.in[IN_CCTX], a.in[IN_WMOD], a.in[IN_BMOD], MOD, L, wg, G, tid); }
    GRID_BAR(0);

    for (int l = 0; l < DEPTH; ++l) {
        const float* modl = MOD + (size_t)l * 5 * 12288;
        long long* biasl = BIAS + (size_t)l * 5 * BIASW;
        unsigned long long* rssA = ROWSS + (size_t)(2 * l) * MTOK;
        unsigned long long* rssB = ROWSS + (size_t)(2 * l + 1) * MTOK;
        unsigned long long* rs2 = (unsigned long long*)(ws + WS_RS2) + (size_t)(2 * l) * MTOK;
        const bool lastl = l == DEPTH - 1;
        unsigned char* wset = ws + (size_t)(l & 1) * WSET_STRIDE; unsigned char* wnext = ws + (size_t)((l + 1) & 1) * WSET_STRIDE;
        bf16 *WIN = (bf16*)(wset + WS_WIN), *WUQ = (bf16*)(wset + WS_WUQ), *WUKV = (bf16*)(wset + WS_WUKV), *WOUT = (bf16*)(wset + WS_WOUT), *W1 = (bf16*)(wset + WS_W1), *W2 = (bf16*)(wset + WS_W2);
        const ConvDst cdst{WIN, WUQ, WUKV, WOUT, W1, W2};
        const ConvDst cnext{(bf16*)(wnext + WS_WIN), (bf16*)(wnext + WS_WUQ), (bf16*)(wnext + WS_WUKV), (bf16*)(wnext + WS_WOUT), (bf16*)(wnext + WS_W1), (bf16*)(wnext + WS_W2)};
        const float* modn = MOD + (size_t)(l + 1) * 5 * 12288; long long* biasn = BIAS + (size_t)(l + 1) * 5 * BIASW;
        { LAUNDER(); LAS float* scr = (LAS float*)(L + wave * 8448); LAS float* tab = (LAS float*)(L + 8 * 8448);
          const bool g1tail = ((MTOK / 256) * (DINP / 256)) % G != 0, g4tail = ((MTOK / 256) * (DFF / 256)) % G != 0;
          const bool needA0 = l == 0 || !g1tail, needA1 = l == 0 || !g4tail;
          if (needA0 || needA1) { conv_load_tab(tab, modl, 3, tid);
              if (needA0) conv_A(csrc, cdst, l, 0, CV_A_SPLIT, gw, NGW, scr, tab, biasl, lane);
              if (needA1) { conv_A(csrc, cdst, l, CV_A_SPLIT, CV_I1, gw, NGW, scr, tab, biasl, lane); conv_B(csrc, cdst, l, 0, CV_B_SPLIT, gw, NGW, scr, lane); } }
          conv_B(csrc, cdst, l, CV_B_SPLIT, CV_I2, gw, NGW, scr, lane);
          conv_load_tab(tab, modl, 0, tid); conv_CD(csrc, cdst, l, gw, NGW, scr, tab, biasl, lane); __syncthreads(); }
        { LAUNDER();
          if (l == 0) phase_first(a.in[IN_X], a.in[IN_CTX], X, H, rssB, a.in[IN_GN1], modl, gw, NGW, lane);
          else phase_ctxfix(X, H, rssB, SLAB, MOD + (size_t)((l - 1) * 5 + 4) * 12288 + 5 * DM, a.in[IN_GN1] + l * DM, modl + (size_t)4 * 12288 + DM, gw, NGW, lane); }
        GRID_BAR(1);
        { LAUNDER(); pg8::Gemm g{H, WIN, MTOK, DINP, DM}; pg8::StaticOrder S; S.init(MTOK, DINP, DM, G, wg);
          pg8::EpiBf16<0, true, true> E{Z, DINP, GATES, rssB, biasl, BIASW, rs2, MTOK};
          pg8::gemm_phase<pg8::EpiBf16<0, true, true>, pg8::StaticOrder, true, true>(L, g, S, E);
          constexpr int NU = (MTOK / 256) * (DINP / 256); const int rem = NU % G;
          if (!lastl && rem != 0 && wg >= rem) { LAS float* scr = (LAS float*)(L + wave * 8448); LAS float* tab = (LAS float*)(L + 8 * 8448);
              conv_load_tab(tab, modn, 3, tid); conv_A(csrc, cnext, l + 1, 0, CV_A_SPLIT, (wg - rem) * NWAVES + wave, (G - rem) * NWAVES, scr, tab, biasn, lane); __syncthreads(); } }
        GRID_BAR(2);
        float* biasf = (float*)(ws + WS_BIASF) + (size_t)l * 5 * DFF;
        { LAUNDER(); phase_e1(Z, KR, wg, G, wave, lane);
          for (int i = wg * NTHR + tid; i < 5 * DFF; i += G * NTHR) { const int bp = i / DFF, cidx = i - bp * DFF; biasf[i] = (float)biasl[(size_t)bp * BIASW + DINP + cidx] * 2.3283064365386963e-10f; } }
        { LAUNDER(); mlstm_a(Z, GATES, a.in[IN_GBIAS] + l * 16, DC, DN, SC, L, wg, G, tid); }
        GRID_BAR(3);
        { LAUNDER(); mlstm_scan(DC, DN, SC, wg, G, tid); }
        __syncthreads();
        { LAUNDER(); pg8::Gemm g{Z + ZQ, WUQ, MTOK, 768, 512}; pg8::StaticOrder S; S.init(MTOK, 768, 512, G, wg);
          pg8::EpiBf16<0, false, true, 512, false> E{QM, 768, nullptr, rs2, nullptr, 0};
          pg8::gemm_phase<pg8::EpiBf16<0, false, true, 512, false>, pg8::StaticOrder, true, true, DINP>(L, g, S, E); }
        { LAUNDER(); pg8::Gemm g{Z + ZKV, WUKV, MTOK, 1024, 256}; pg8::StaticOrder S; S.init(MTOK, 1024, 256, G, (wg + 116) % G);
          pg8::EpiBf16<0, false, true, 256, false> E{KVM, 1024, nullptr, rs2 + MTOK, nullptr, 0};
          pg8::gemm_phase<pg8::EpiBf16<0, false, true, 256, false>, pg8::StaticOrder, true, true, DINP>(L, g, S, E); }
        GRID_BAR(4);
#ifndef ATT_SWAP_MASK
#define ATT_SWAP_MASK 4
#endif
        for (int stage = 0; stage < 2; ++stage) {
        bool mla_now; { int wgs = blockIdx.x; asm volatile("" : "+s"(wgs)); mla_now = (stage == 0) != ((wgs & ATT_SWAP_MASK) != 0); }
        if (mla_now) { LAUNDER();
          const int n_mla = lastl ? 512 : 512 + 16;
          for (int u = wg; u < n_mla; u += G) {
            if (u < 512) { const int pair = 2 * (u & 7) + (u >> 8), qb = (u >> 3) & 31, b = pair >> 2, h = pair & 3; mla_unit(QM, KVM, KR, Y, b, h, b * TB + CTX + 256 * qb, 132, true, L, tid); }
            else { const int i = u - 512, b = i >> 2, h = i & 3; mla_unit(QM, KVM, KR, Y, b, h, b * TB, 4, false, L, tid); }
          } }
        else {
        { LAUNDER();
          const int n_swa = lastl ? 1024 : 1024 + 32;
          for (int u = (wg + 64) % G; u < n_swa; u += G) {
            if (u < 1024) swa_unit(Z, a.in[IN_SINK] + l * 16, Y, u >> 8, (u >> 7) & 1, u & 127, 0, L, tid);
            else { const int i = u - 1024; swa_unit(Z, a.in[IN_SINK] + l * 16, Y, i >> 3, (i >> 2) & 1, -1, i & 3, L, tid); }
          } }
        { LAUNDER();
          mlstm_c_phase((wg + 128) % G, G, lastl, Z, GATES, a.in[IN_GBIAS] + l * 16, a.in[IN_GH] + l * 512, DC, DN, SC, Y, L, tid); }
        }
        __syncthreads();
        }
        GRID_BAR(5);
        { LAUNDER(); pg8::Gemm g{Y, WOUT, MTOK, DM, DM}; pg8::LatentOrder S; S.init(DM, DM, G, wg, lastl ? 0 : 2);
          pg8::EpiResid E{X, modl, 2 * DM, SLAB, DM / 64, H, a.in[IN_GN2] + l * DM, modl + 4 * DM, rssA};
          pg8::gemm_phase<pg8::EpiResid, pg8::LatentOrder, true, true>(L, g, S, E); }
        GRID_BAR(6);
        if (!lastl) {
            { LAUNDER(); phase_ctxfix(X, H, rssA, SLAB, modl + (size_t)4 * 12288 + 2 * DM, a.in[IN_GN2] + l * DM, modl + (size_t)4 * 12288 + 4 * DM, gw, NGW, lane); }
            GRID_BAR(7);
        }
        { LAUNDER(); pg8::Gemm g{H, W1, MTOK, DFF, DM}; pg8::LatentOrder S; S.init(DFF, DM, G, wg, lastl ? 0 : 1);
          pg8::EpiBf16<2, false, true, 2048, true, true> E{ACT, DFF, nullptr, rssA, (const long long*)biasf, DFF};
          pg8::gemm_phase<pg8::EpiBf16<2, false, true, 2048, true, true>, pg8::LatentOrder, true, true>(L, g, S, E);
          constexpr int NU = (MTOK / 256) * (DFF / 256); const int rem = NU % G;
          if (!lastl && rem != 0 && wg >= rem) { LAS float* scr = (LAS float*)(L + wave * 8448); LAS float* tab = (LAS float*)(L + 8 * 8448); const int worker = (wg - rem) * NWAVES + wave, nworkers = (G - rem) * NWAVES;
              conv_load_tab(tab, modn, 3, tid); conv_A(csrc, cnext, l + 1, CV_A_SPLIT, CV_I1, worker, nworkers, scr, tab, biasn, lane); conv_B(csrc, cnext, l + 1, 0, CV_B_SPLIT, worker, nworkers, scr, lane); __syncthreads(); } }
        GRID_BAR(8);
        { LAUNDER(); pg8::Gemm g{ACT, W2, MTOK, DM, DFF}; pg8::LatentOrder S; S.init(DM, DFF, G, wg, lastl ? 0 : 2);
          pg8::EpiResid E{X, modl, 5 * DM, SLAB, DFF / 64, lastl ? nullptr : H, a.in[IN_GN1] + (l + 1) * DM, MOD + (size_t)(l + 1) * 5 * 12288 + DM, ROWSS + (size_t)(2 * l + 3) * MTOK};
          pg8::gemm_phase<pg8::EpiResid, pg8::LatentOrder, true, true>(L, g, S, E); }
        GRID_BAR(9);
    }
    { LAUNDER(); phase_final(X, a.out, a.in[IN_GFINAL], gw, NGW, lane); }
}

extern "C" void kernel_launch(void* const* d_in, const int* in_sizes, int n_in, void* d_out, int out_size, void* d_ws, size_t ws_size, hipStream_t stream) {
    static int grid = 0;
    if (grid == 0) {
        if (n_in != 20 || in_sizes[0] != NB * SEQ * DM || out_size != NB * SEQ * DM || ws_size < WS_END) {
            fprintf(stderr, "kernel_launch: unexpected shapes (n_in %d, in0 %d, out %d, ws %zu, need %zu); nothing launched\n", n_in, n_in > 0 ? in_sizes[0] : -1, out_size, ws_size, (size_t)WS_END); grid = -1; return; }
        int dev = 0, cus = 0, per_cu = 0;
        if (hipGetDevice(&dev) != hipSuccess || hipDeviceGetAttribute(&cus, hipDeviceAttributeMultiprocessorCount, dev) != hipSuccess) { fprintf(stderr, "kernel_launch: device query failed\n"); grid = -1; return; }
        if (hipFuncSetAttribute((const void*)fwd_kernel, hipFuncAttributeMaxDynamicSharedMemorySize, LDS_BYTES) != hipSuccess) { fprintf(stderr, "kernel_launch: hipFuncSetAttribute failed\n"); grid = -1; return; }
        if (hipOccupancyMaxActiveBlocksPerMultiprocessor(&per_cu, (const void*)fwd_kernel, NTHR, LDS_BYTES) != hipSuccess || per_cu < 1)
            fprintf(stderr, "kernel_launch: note: occupancy query reports %d workgroups per CU\n", per_cu);
        (void)hipGetLastError();
        grid = cus;
    }
    if (grid < 0) return;
    if (hipMemsetAsync((char*)d_ws + WS_CTL, 0, CTL_ZERO_BYTES, stream) != hipSuccess) { fprintf(stderr, "kernel_launch: memset failed\n"); return; }
    Args a{};
    for (int i = 0; i < 20; ++i) a.in[i] = (const float*)d_in[i];
    a.out = (float*)d_out; a.ws = (unsigned char*)d_ws;
    hipLaunchKernelGGL(fwd_kernel, dim3(grid), dim3(NTHR), LDS_BYTES, stream, a);
    const hipError_t le = hipPeekAtLastError();
    if (le != hipSuccess) fprintf(stderr, "kernel_launch: launch failed: %s\n", hipGetErrorName(le));
}
```
